# Optimizing an MI355X kernel written in HIP

```python
import math
import jax, jax.numpy as jnp
from jax import lax
import numpy as np

D_MODEL = 1024
BATCH = 8
SEQ = 4096
DEPTH = 4

CHUNK = 64
Q_BLOCK = 128
N_A_LAYERS = DEPTH // 2
N_B_LAYERS = DEPTH - N_A_LAYERS
SSM_GROUP = 16
SSM_GROUPS = D_MODEL // SSM_GROUP
SSM_STATE = 64
DT_MIN = 0.001
DT_MAX = 0.1
N_HEADS = 16
QK_NOPE_DIM = 64
QK_ROPE_DIM = 32
V_HEAD_DIM = 64
Q_LORA_RANK = 256
KV_LORA_RANK = 256
ROPE_THETA = 10000.0
ATTN_SCALE = 1.0 / math.sqrt(QK_NOPE_DIM + QK_ROPE_DIM)
D_FF = ((8 * D_MODEL + 3 * 256 - 1) // (3 * 256)) * 256
EPS = 1e-6

kernel_name = "yoco_s5_mla_adaln_encoder"


def rms_norm(x, g):
    xf = x.astype(jnp.float32)
    y = xf * lax.rsqrt(jnp.mean(xf * xf, axis=-1, keepdims=True) + EPS)
    return (y * g.astype(jnp.float32)).astype(x.dtype)


def modulate(h, shift, scale):
    return h * (1.0 + scale[:, None, :]) + shift[:, None, :]


def rope_cos_sin(positions):
    inv = 1.0 / (ROPE_THETA ** (jnp.arange(0, QK_ROPE_DIM, 2, dtype=jnp.float32) / QK_ROPE_DIM))
    ang = positions.astype(jnp.float32)[..., None] * inv
    return jnp.cos(ang), jnp.sin(ang)


def apply_rope(x, cos, sin):
    shape = cos.shape[:2] + (1,) * (x.ndim - 3) + cos.shape[-1:]
    cos = cos.reshape(shape)
    sin = sin.reshape(shape)
    x1, x2 = jnp.split(x.astype(jnp.float32), 2, axis=-1)
    return jnp.concatenate([x1 * cos - x2 * sin, x1 * sin + x2 * cos], axis=-1).astype(x.dtype)


def _complex_linear_combine(e1, e2):
    a1r, a1i, b1r, b1i = e1
    a2r, a2i, b2r, b2i = e2
    ar = a1r * a2r - a1i * a2i
    ai = a1r * a2i + a1i * a2r
    br = a2r * b1r - a2i * b1i + b2r
    bi = a2r * b1i + a2i * b1r + b2i
    return (ar, ai, br, bi)


def s5_mixer(h, lam_re, lam_im, log_dt, b_re, b_im, c_re, c_im, d_skip, w_glu, b_glu):
    bsz, s_len, d = h.shape
    f32 = jnp.float32
    lr = lam_re.astype(f32)
    li = lam_im.astype(f32)
    dt = jnp.exp(log_dt.astype(f32))[:, None]
    mag = jnp.exp(lr * dt)
    ab_re = mag * jnp.cos(li * dt)
    ab_im = mag * jnp.sin(li * dt)
    den = lr * lr + li * li
    nr = ab_re - 1.0
    ni = ab_im
    f_re = (nr * lr + ni * li) / den
    f_im = (ni * lr - nr * li) / den
    br = b_re.astype(f32)
    bi = b_im.astype(f32)
    bb_re = f_re[..., None] * br - f_im[..., None] * bi
    bb_im = f_re[..., None] * bi + f_im[..., None] * br
    cr = c_re.astype(f32)
    ci = c_im.astype(f32)

    n_chunks = s_len // CHUNK
    u = h.astype(f32).reshape(bsz, n_chunks, CHUNK, SSM_GROUPS, SSM_GROUP).transpose(1, 0, 2, 3, 4)

    def chunk_step(carry, u_c):
        s_re, s_im = carry
        bu_re = jnp.einsum('blgp,gnp->blgn', u_c, bb_re)
        bu_im = jnp.einsum('blgp,gnp->blgn', u_c, bb_im)
        a_re = jnp.broadcast_to(ab_re, bu_re.shape)
        a_im = jnp.broadcast_to(ab_im, bu_im.shape)
        pa_re, pa_im, loc_re, loc_im = lax.associative_scan(
            _complex_linear_combine, (a_re, a_im, bu_re, bu_im), axis=1)
        st_re = loc_re + pa_re * s_re[:, None] - pa_im * s_im[:, None]
        st_im = loc_im + pa_re * s_im[:, None] + pa_im * s_re[:, None]
        y = jnp.einsum('blgn,gpn->blgp', st_re, cr) - jnp.einsum('blgn,gpn->blgp', st_im, ci)
        return (st_re[:, -1], st_im[:, -1]), y

    init = (jnp.zeros((bsz, SSM_GROUPS, SSM_STATE), f32), jnp.zeros((bsz, SSM_GROUPS, SSM_STATE), f32))
    _, y = lax.scan(chunk_step, init, u)
    y = y.transpose(1, 0, 2, 3, 4).reshape(bsz, s_len, d)
    y = (y + d_skip.astype(f32) * h.astype(f32)).astype(h.dtype)
    g = jax.nn.gelu(y)
    return g * jax.nn.sigmoid(g @ w_glu + b_glu)


def shared_mla_kv(hk, cos, sin, w_kv_a, kv_a_norm_g, w_kv_b, k_nope_norm_g, k_rope_norm_g):
    bsz, s_len, _ = hk.shape
    kv_a = hk @ w_kv_a
    c_kv, k_rope = jnp.split(kv_a, [KV_LORA_RANK], axis=-1)
    c_kv = rms_norm(c_kv, kv_a_norm_g)
    kv = (c_kv @ w_kv_b).reshape(bsz, s_len, N_HEADS, QK_NOPE_DIM + V_HEAD_DIM)
    k_nope, v = jnp.split(kv, [QK_NOPE_DIM], axis=-1)
    k_nope = rms_norm(k_nope, k_nope_norm_g)
    k_rope = apply_rope(rms_norm(k_rope, k_rope_norm_g), cos, sin)
    return k_nope, k_rope, v


def mla_attention(h, cos, sin, k_nope, k_rope, v, w_dq, q_norm_g, w_uq, q_nope_norm_g, q_rope_norm_g, w_o):
    bsz, s_len, _ = h.shape
    q = rms_norm(h @ w_dq, q_norm_g) @ w_uq
    q = q.reshape(bsz, s_len, N_HEADS, QK_NOPE_DIM + QK_ROPE_DIM)
    q_nope, q_rope = jnp.split(q, [QK_NOPE_DIM], axis=-1)
    q_nope = rms_norm(q_nope, q_nope_norm_g)
    q_rope = apply_rope(rms_norm(q_rope, q_rope_norm_g), cos, sin)
    n_blocks = s_len // Q_BLOCK
    qn_b = q_nope.reshape(bsz, n_blocks, Q_BLOCK, N_HEADS, QK_NOPE_DIM).transpose(1, 0, 2, 3, 4)
    qr_b = q_rope.reshape(bsz, n_blocks, Q_BLOCK, N_HEADS, QK_ROPE_DIM).transpose(1, 0, 2, 3, 4)
    key_chunk = jnp.arange(s_len) // CHUNK

    def block_attn(args):
        qn, qr, blk = args
        s = (jnp.einsum('bqhd,bkhd->bhqk', qn, k_nope, preferred_element_type=jnp.float32)
             + jnp.einsum('bqhr,bkr->bhqk', qr, k_rope, preferred_element_type=jnp.float32)) * ATTN_SCALE
        q_chunk = (blk * Q_BLOCK + jnp.arange(Q_BLOCK)) // CHUNK
        mask = q_chunk[:, None] >= key_chunk[None, :]
        s = jnp.where(mask[None, None], s, -1e30)
        p = jax.nn.softmax(s, axis=-1)
        return jnp.einsum('bhqk,bkhd->bqhd', p.astype(v.dtype), v)

    o = lax.map(block_attn, (qn_b, qr_b, jnp.arange(n_blocks)))
    o = o.transpose(1, 0, 2, 3, 4).reshape(bsz, s_len, N_HEADS * V_HEAD_DIM)
    return o @ w_o


def swiglu(h, w_gate, w_up, w_down):
    return (jax.nn.silu(h @ w_gate) * (h @ w_up)) @ w_down


def setup_inputs(seed: int = 0) -> dict:
    key = jax.random.key(seed)
    ks = iter(jax.random.split(key, 48))
    f32 = jnp.float32
    D, F, G, N, P = D_MODEL, D_FF, SSM_GROUPS, SSM_STATE, SSM_GROUP
    NA, NB = N_A_LAYERS, N_B_LAYERS

    def nrm(shape, scale):
        return jax.random.normal(next(ks), shape, f32) * scale

    def gain(shape):
        return 1.0 + 0.02 * jax.random.normal(next(ks), shape, f32)

    x = jax.random.normal(next(ks), (BATCH, SEQ, D), f32)
    c = jax.random.normal(next(ks), (BATCH, D), f32)
    offsets = jax.random.randint(next(ks), (BATCH, 1), 0, 4096, dtype=jnp.int32)
    positions = offsets + jnp.arange(SEQ, dtype=jnp.int32)[None, :]

    n_idx = jnp.arange(N, dtype=f32)
    inputs = {
        "x": x, "c": c, "positions": positions,
        "ada_w": nrm((DEPTH, D, 6 * D), 0.5 * D ** -0.5),
        "ada_b": nrm((DEPTH, 6 * D), 0.02),
        "norm1_g": gain((DEPTH, D)),
        "norm2_g": gain((DEPTH, D)),
        "ffn_w_gate": nrm((DEPTH, D, F), D ** -0.5),
        "ffn_w_up": nrm((DEPTH, D, F), D ** -0.5),
        "ffn_w_down": nrm((DEPTH, F, D), F ** -0.5),
        "s5_lam_re": -0.5 + 0.01 * jax.random.normal(next(ks), (NA, G, N), f32),
        "s5_lam_im": math.pi * n_idx[None, None, :] + 0.01 * jax.random.normal(next(ks), (NA, G, N), f32),
        "s5_log_dt": jax.random.uniform(next(ks), (NA, G), f32, math.log(DT_MIN), math.log(DT_MAX)),
        "s5_b_re": nrm((NA, G, N, P), P ** -0.5),
        "s5_b_im": nrm((NA, G, N, P), P ** -0.5),
        "s5_c_re": nrm((NA, G, P, N), N ** -0.5),
        "s5_c_im": nrm((NA, G, P, N), N ** -0.5),
        "s5_d": nrm((NA, D), 1.0),
        "s5_w_glu": nrm((NA, D, D), D ** -0.5),
        "s5_b_glu": nrm((NA, D), 0.02),
        "kv_ada_w": nrm((D, 2 * D), 0.5 * D ** -0.5),
        "kv_ada_b": nrm((2 * D,), 0.02),
        "kv_norm_g": gain((D,)),
        "w_kv_a": nrm((D, KV_LORA_RANK + QK_ROPE_DIM), D ** -0.5),
        "kv_a_norm_g": gain((KV_LORA_RANK,)),
        "w_kv_b": nrm((KV_LORA_RANK, N_HEADS * (QK_NOPE_DIM + V_HEAD_DIM)), KV_LORA_RANK ** -0.5),
        "k_nope_norm_g": gain((QK_NOPE_DIM,)),
        "k_rope_norm_g": gain((QK_ROPE_DIM,)),
        "mla_w_dq": nrm((NB, D, Q_LORA_RANK), D ** -0.5),
        "mla_q_norm_g": gain((NB, Q_LORA_RANK)),
        "mla_w_uq": nrm((NB, Q_LORA_RANK, N_HEADS * (QK_NOPE_DIM + QK_ROPE_DIM)), Q_LORA_RANK ** -0.5),
        "mla_q_nope_norm_g": gain((NB, QK_NOPE_DIM)),
        "mla_q_rope_norm_g": gain((NB, QK_ROPE_DIM)),
        "mla_w_o": nrm((NB, N_HEADS * V_HEAD_DIM, D), (N_HEADS * V_HEAD_DIM) ** -0.5),
    }
    return inputs


def reference(x, c, positions, ada_w, ada_b, norm1_g, norm2_g, ffn_w_gate, ffn_w_up, ffn_w_down,
              s5_lam_re, s5_lam_im, s5_log_dt, s5_b_re, s5_b_im, s5_c_re, s5_c_im, s5_d, s5_w_glu, s5_b_glu,
              kv_ada_w, kv_ada_b, kv_norm_g, w_kv_a, kv_a_norm_g, w_kv_b, k_nope_norm_g, k_rope_norm_g,
              mla_w_dq, mla_q_norm_g, mla_w_uq, mla_q_nope_norm_g, mla_q_rope_norm_g, mla_w_o):
    cos, sin = rope_cos_sin(positions)
    c_act = jax.nn.silu(c)
    k_nope = k_rope = v = None
    for l in range(DEPTH):
        shift1, scale1, gate1, shift2, scale2, gate2 = jnp.split(c_act @ ada_w[l] + ada_b[l], 6, axis=-1)
        if l == N_A_LAYERS:
            k_shift, k_scale = jnp.split(c_act @ kv_ada_w + kv_ada_b, 2, axis=-1)
            hk = modulate(rms_norm(x, kv_norm_g), k_shift, k_scale)
            k_nope, k_rope, v = shared_mla_kv(hk, cos, sin, w_kv_a, kv_a_norm_g, w_kv_b,
                                              k_nope_norm_g, k_rope_norm_g)
        h = modulate(rms_norm(x, norm1_g[l]), shift1, scale1)
        if l < N_A_LAYERS:
            mix = s5_mixer(h, s5_lam_re[l], s5_lam_im[l], s5_log_dt[l], s5_b_re[l], s5_b_im[l],
                           s5_c_re[l], s5_c_im[l], s5_d[l], s5_w_glu[l], s5_b_glu[l])
        else:
            j = l - N_A_LAYERS
            mix = mla_attention(h, cos, sin, k_nope, k_rope, v, mla_w_dq[j], mla_q_norm_g[j], mla_w_uq[j],
                                mla_q_nope_norm_g[j], mla_q_rope_norm_g[j], mla_w_o[j])
        x = x + gate1[:, None, :] * mix
        h = modulate(rms_norm(x, norm2_g[l]), shift2, scale2)
        x = x + gate2[:, None, :] * swiglu(h, ffn_w_gate[l], ffn_w_up[l], ffn_w_down[l])
    return x
```

```cpp
#include <hip/hip_runtime.h>
#include <hip/hip_cooperative_groups.h>
#include <cstdio>
#include <cstdint>
namespace cg = cooperative_groups;
namespace pg8 {
#define PG8_LAS __attribute__((address_space(3)))
typedef unsigned short bf16_t;
typedef short bf16x8 __attribute__((ext_vector_type(8)));
typedef float f32x4 __attribute__((ext_vector_type(4)));
typedef unsigned u32x4 __attribute__((ext_vector_type(4)));
constexpr int BM = 256, BK = 64, HALF = 128, HTB = HALF * BK * 2  , STAGE_BYTES = 8 * HTB, NXCD = 8, WGM = 8;

__host__ __device__ __forceinline__ int lds_byte(int r, int c) { const int st = (r >> 4) * 2 + (c >> 5), rr = r & 15, cc = c & 31, ob = rr * 64 + cc * 2; return st * 1024 + (ob ^ (((ob >> 9) & 1) << 5)); }
__host__ __device__ __forceinline__ void stage_rc(int b, int& R, int& C) { const int st = b / 1024, sb = b % 1024, swz = sb ^ (((sb >> 9) & 1) << 5); R = (st >> 1) * 16 + swz / 64; C = (st & 1) * 32 + (swz % 64) / 2; }
__host__ __device__ __forceinline__ int perm32(int rho) { const int n = rho >> 4, i = rho & 15; return 8 * (i >> 2) + 4 * n + (i & 3); }

struct Unit { int pm, pn; };
struct Gemm { const bf16_t* A; const bf16_t* Bt; int M, N, K, lda, ldb; };

struct StaticOrder {
    int nM, nN, nwg, G, c;
    __host__ __device__ void init(int M, int N, int G_, int c_) { nM = M / BM; nN = N / BM; nwg = nM * nN; G = G_; c = c_; }
    __host__ __device__ bool next(int i, Unit& u) const {
        const long L = (long)i * G + c; if (L >= nwg) return false;
        int wgid = (int)L; { const int q = nwg / NXCD, r = nwg % NXCD, xcd = wgid % NXCD, off = wgid / NXCD; wgid = (xcd < r ? xcd * (q + 1) : r * (q + 1) + (xcd - r) * q) + off; }
        const int nig = WGM * nN, gid = wgid / nig, fm = gid * WGM, gsz = (nM - fm) < WGM ? (nM - fm) : WGM;
        u.pm = fm + ((wgid % nig) % gsz); u.pn = (wgid % nig) / gsz; return true;
    }
    __device__ __forceinline__ void a_ready(const Unit&) const {}
    __device__ __forceinline__ void done(const Unit&) const {}
};

__device__ __forceinline__ unsigned cvt_pk_bf16(float lo, float hi) { unsigned r; asm volatile("v_cvt_pk_bf16_f32 %0, %1, %2" : "=v"(r) : "v"(lo), "v"(hi)); return r; }
typedef float f32x2 __attribute__((ext_vector_type(2)));
template <class Epi, class Sched, bool ALIGN_EPI = false, bool SP2 = false>
__device__ __forceinline__ void gemm_phase(PG8_LAS unsigned char* lds, const Gemm g, const Sched& S, const Epi& E) {
    int tid_l = threadIdx.x; asm volatile("" : "+v"(tid_l)); const int tid = tid_l, wid = __builtin_amdgcn_readfirstlane(tid >> 6), lane = tid & 63, wr = wid >> 2, wc = wid & 3, fr = lane & 15, fq = lane >> 4;
    int K_l = g.K; asm volatile("" : "+s"(K_l)); const int K = K_l, nt = K / BK;
    unsigned voffA[2], voffB[2];
#pragma unroll
    for (int i = 0; i < 2; ++i) { int R, C; stage_rc(tid * 16 + i * 8192, R, C); const int Rb = Epi::PERM ? ((R & ~31) + perm32(R & 31)) : R;
        voffA[i] = (unsigned)(R * g.lda + C) * 2u; voffB[i] = (unsigned)(Rb * g.ldb + C) * 2u; }
    const size_t kstep = (size_t)(BK * 2);
    const size_t hstepA = (size_t)HALF * g.lda * 2, hstepB = (size_t)HALF * g.ldb * 2;
    const size_t tstepA = 2 * hstepA, tstepB = 2 * hstepB;
    const unsigned ldsw = (unsigned)wid * 1024u;
    const int aoff = lds_byte(wr * 64 + fr, fq * 8), boff = lds_byte(wc * 32 + fr, fq * 8);
#define PG8_SA(b, h) (((b) * 2 + (h)) * HTB)
#define PG8_SB(b, h) ((4 + (b) * 2 + (h)) * HTB)
#define PG8_STAGE(bufoff, gbase, voff) do { _Pragma("unroll") for (int _i = 0; _i < 2; ++_i) \
        __builtin_amdgcn_global_load_lds((const unsigned*)((const char*)(gbase) + (voff)[_i]), (PG8_LAS unsigned*)(lds + (bufoff) + ldsw + _i * 8192), 16, 0, 0); } while (0)
#define PG8_LDA(dst, b, h) do { _Pragma("unroll") for (int m = 0; m < 4; ++m) _Pragma("unroll") for (int k = 0; k < 2; ++k) dst[m][k] = *(const PG8_LAS bf16x8*)(lds + PG8_SA(b, h) + aoff + m * 2048 + k * 1024); } while (0)
#define PG8_LDB(dst, b, h) do { _Pragma("unroll") for (int n = 0; n < 2; ++n) _Pragma("unroll") for (int k = 0; k < 2; ++k) dst[n][k] = *(const PG8_LAS bf16x8*)(lds + PG8_SB(b, h) + boff + n * 2048 + k * 1024); } while (0)
#define PG8_MMA(ai, bj, At, Bt) do { __builtin_amdgcn_s_setprio(1); _Pragma("unroll") for (int m = 0; m < 4; ++m) _Pragma("unroll") for (int n = 0; n < 2; ++n) _Pragma("unroll") for (int k = 0; k < 2; ++k) \
        acc[ai][bj][m][n] = __builtin_amdgcn_mfma_f32_16x16x32_bf16(Bt[n][k], At[m][k], acc[ai][bj][m][n], 0, 0, 0); __builtin_amdgcn_s_setprio(0); } while (0)
#define PG8_WAIT_V(n) asm volatile("s_waitcnt vmcnt(" #n ")" ::: "memory")
#define PG8_WAIT_L(n) asm volatile("s_waitcnt lgkmcnt(" #n ")" ::: "memory")
#define PG8_BAR __builtin_amdgcn_s_barrier()
#define PG8_SCHED __builtin_amdgcn_sched_barrier(0)
    Unit cur, nxt; int ui = 0;
    if (!S.next(0, cur)) return;
    f32x4 acc[2][2][4][2];
#pragma unroll
    for (int a = 0; a < 2; ++a)
#pragma unroll
        for (int b = 0; b < 2; ++b)
#pragma unroll
            for (int m = 0; m < 4; ++m)
#pragma unroll
                for (int n = 0; n < 2; ++n) acc[a][b][m][n] = (f32x4){0.f, 0.f, 0.f, 0.f};
    bf16x8 At[4][2], B0[2][2], B1[2][2];
    const char* cA = (const char*)g.A + (size_t)cur.pm * tstepA; const char* cB = (const char*)g.Bt + (size_t)cur.pn * tstepB;
    S.a_ready(cur);
    if constexpr (SP2) {
        PG8_STAGE(PG8_SB(0, 0), cB, voffB); PG8_STAGE(PG8_SB(0, 1), cB + hstepB, voffB); PG8_STAGE(PG8_SA(0, 0), cA, voffA); PG8_STAGE(PG8_SA(0, 1), cA + hstepA, voffA);
        if (wr == 1) PG8_BAR;
        PG8_WAIT_V(2); PG8_BAR;
        PG8_STAGE(PG8_SB(1, 0), cB + kstep, voffB); PG8_STAGE(PG8_SA(1, 0), cA + kstep, voffA); PG8_STAGE(PG8_SB(1, 1), cB + hstepB + kstep, voffB);
        PG8_WAIT_V(6); PG8_BAR;
    } else {
        PG8_STAGE(PG8_SB(0, 0), cB, voffB); PG8_STAGE(PG8_SA(0, 0), cA, voffA); PG8_STAGE(PG8_SB(0, 1), cB + hstepB, voffB); PG8_STAGE(PG8_SA(0, 1), cA + hstepA, voffA);
        if (wr == 1) PG8_BAR;
        PG8_WAIT_V(4); PG8_BAR;
        PG8_STAGE(PG8_SB(1, 0), cB + kstep, voffB); PG8_STAGE(PG8_SA(1, 0), cA + kstep, voffA); PG8_STAGE(PG8_SB(1, 1), cB + hstepB + kstep, voffB);
        PG8_WAIT_V(6); PG8_BAR;
    }
    for (;;) {
        const bool has_next = S.next(ui + 1, nxt);
        const char* nA = has_next ? (const char*)g.A + (size_t)nxt.pm * tstepA : cA; const char* nB = has_next ? (const char*)g.Bt + (size_t)nxt.pn * tstepB : cB;
        for (int t = 0; t < nt; t += 2) {
            const bool last = (t == nt - 2);
            const char* a1 = cA + (size_t)(t + 1) * kstep;
            const char* a2 = last ? nA : cA + (size_t)(t + 2) * kstep; const char* b2 = last ? nB : cB + (size_t)(t + 2) * kstep;
            const char* a3 = a2 + kstep; const char* b3 = b2 + kstep;
            if (last && has_next) S.a_ready(nxt);
            if constexpr (SP2) {
            PG8_LDB(B0, 0, 0); PG8_LDB(B1, 0, 1); PG8_SCHED; PG8_LDA(At, 0, 0); PG8_STAGE(PG8_SA(1, 1), a1 + hstepA, voffA);
            PG8_WAIT_V(8); PG8_WAIT_L(0); PG8_BAR; PG8_MMA(0, 0, At, B0); PG8_MMA(0, 1, At, B1); PG8_BAR; PG8_SCHED;
            PG8_LDA(At, 0, 1); PG8_STAGE(PG8_SB(0, 0), b2, voffB); PG8_STAGE(PG8_SB(0, 1), b2 + hstepB, voffB); PG8_STAGE(PG8_SA(0, 0), a2, voffA);
            PG8_WAIT_V(8); PG8_WAIT_L(0); PG8_BAR; PG8_MMA(1, 0, At, B0); PG8_MMA(1, 1, At, B1); PG8_BAR; PG8_SCHED;
            PG8_LDB(B0, 1, 0); PG8_LDB(B1, 1, 1); PG8_SCHED; PG8_LDA(At, 1, 0); PG8_STAGE(PG8_SA(0, 1), a2 + hstepA, voffA);
            PG8_WAIT_V(8); PG8_WAIT_L(0); PG8_BAR; PG8_MMA(0, 0, At, B0); PG8_MMA(0, 1, At, B1); PG8_BAR; PG8_SCHED;
            PG8_LDA(At, 1, 1); PG8_STAGE(PG8_SB(1, 0), b3, voffB); PG8_STAGE(PG8_SB(1, 1), b3 + hstepB, voffB); PG8_STAGE(PG8_SA(1, 0), a3, voffA);
            PG8_WAIT_V(8); PG8_WAIT_L(0); PG8_BAR; PG8_MMA(1, 0, At, B0); PG8_MMA(1, 1, At, B1); PG8_BAR; PG8_SCHED;
            } else {
            PG8_LDB(B0, 0, 0); PG8_SCHED; PG8_LDA(At, 0, 0); PG8_STAGE(PG8_SA(1, 1), a1 + hstepA, voffA);
            PG8_WAIT_L(8); PG8_BAR; PG8_WAIT_L(0); PG8_MMA(0, 0, At, B0); PG8_BAR; PG8_SCHED;
            PG8_LDB(B1, 0, 1); PG8_STAGE(PG8_SB(0, 0), b2, voffB);
            PG8_BAR; PG8_WAIT_L(0); PG8_MMA(0, 1, At, B1); PG8_BAR;
            PG8_LDA(At, 0, 1); PG8_STAGE(PG8_SA(0, 0), a2, voffA);
            PG8_BAR; PG8_WAIT_L(0); PG8_MMA(1, 0, At, B0); PG8_BAR; PG8_SCHED;
            PG8_STAGE(PG8_SB(0, 1), b2 + hstepB, voffB);
            PG8_WAIT_V(6); PG8_BAR; PG8_MMA(1, 1, At, B1); PG8_BAR;
            PG8_LDB(B0, 1, 0); PG8_SCHED; PG8_LDA(At, 1, 0); PG8_STAGE(PG8_SA(0, 1), a2 + hstepA, voffA);
            PG8_WAIT_L(8); PG8_BAR; PG8_WAIT_L(0); PG8_MMA(0, 0, At, B0); PG8_BAR; PG8_SCHED;
            PG8_LDB(B1, 1, 1); PG8_STAGE(PG8_SB(1, 0), b3, voffB);
            PG8_BAR; PG8_WAIT_L(0); PG8_MMA(0, 1, At, B1); PG8_BAR;
            PG8_LDA(At, 1, 1); PG8_STAGE(PG8_SA(1, 0), a3, voffA);
            PG8_BAR; PG8_WAIT_L(0); PG8_MMA(1, 0, At, B0); PG8_BAR; PG8_SCHED;
            PG8_STAGE(PG8_SB(1, 1), b3 + hstepB, voffB);
            PG8_WAIT_V(6); PG8_BAR; PG8_MMA(1, 1, At, B1); PG8_BAR;
            }
        }
        if constexpr (ALIGN_EPI) { if (wr == 0) PG8_BAR; }
        if constexpr (!Epi::AFTER_DRAIN) { E(acc, cur, wr, wc, fr, fq); S.done(cur); }
        if (!has_next) break;
#pragma unroll
        for (int a = 0; a < 2; ++a)
#pragma unroll
            for (int b = 0; b < 2; ++b)
#pragma unroll
                for (int m = 0; m < 4; ++m)
#pragma unroll
                    for (int n = 0; n < 2; ++n) acc[a][b][m][n] = (f32x4){0.f, 0.f, 0.f, 0.f};
        cur = nxt; cA = nA; cB = nB; ++ui;
        if constexpr (ALIGN_EPI) { if (wr == 1) PG8_BAR; }
    }
    PG8_WAIT_V(0);
    if constexpr (!ALIGN_EPI) { if (wr == 0) PG8_BAR; }
    PG8_BAR;
    if constexpr (Epi::AFTER_DRAIN) { E.fused(acc, cur, wr, wc, fr, fq, lds, wid, lane); S.done(cur); }
#undef PG8_SA
#undef PG8_SB
#undef PG8_STAGE
#undef PG8_LDA
#undef PG8_LDB
#undef PG8_MMA
#undef PG8_WAIT_V
#undef PG8_WAIT_L
#undef PG8_BAR
#undef PG8_SCHED
}
}

constexpr int NB = 8, SEQ = 4096, DM = 1024, T = NB * SEQ, FF = 2816, NH = 16;
constexpr int SUB = 16, NSUB = SEQ / SUB, AUGK = 384;
constexpr float EPS = 1e-6f;
constexpr size_t MiB = 1u << 20;
constexpr size_t WS_ADA = 1 * MiB;
constexpr size_t WS_KVADA = WS_ADA + 800 * 1024;
constexpr size_t WS_COS = 2 * MiB, WS_SIN = 4 * MiB;
constexpr size_t WS_QSS = 6 * MiB;
constexpr size_t WS_KSS = WS_QSS + 2 * T * 4, WS_A16 = WS_KSS + T * 4;
constexpr size_t WS_KR = 7 * MiB;
constexpr size_t WS_WGU = 10 * MiB;
constexpr size_t WS_WD = WS_WGU + 44 * MiB;
constexpr size_t WS_WGLU = WS_WD + 22 * MiB;
constexpr size_t WS_WDQ = WS_WGLU + 4 * MiB;
constexpr size_t WS_WKVA = WS_WDQ + 1 * MiB;
constexpr size_t WS_WUQ = WS_WKVA + 1 * MiB;
constexpr size_t WS_WKVB = WS_WUQ + 3 * MiB / 2;
constexpr size_t WS_WO = WS_WKVB + 1 * MiB;
constexpr size_t WS_S5WT = 89 * MiB;
constexpr size_t WS_S5WE = WS_S5WT + 24 * MiB;
constexpr size_t WS_CKV = WS_S5WT, WS_QA = WS_S5WT + 16 * MiB;
constexpr size_t WS_XN = 129 * MiB;
constexpr size_t WS_HB = 193 * MiB;
constexpr size_t WS_AUG = WS_HB, WS_EBUF = WS_HB + 96 * MiB;
constexpr size_t WS_QB = WS_HB, WS_XK = WS_HB + 96 * MiB, WS_OB = WS_XK;
constexpr size_t WS_KB = 369 * MiB, WS_VB = 433 * MiB, WS_END = 497 * MiB;
static_assert(WS_WO + 4 * MiB <= WS_S5WT && WS_S5WE + 16 * MiB <= WS_XN, "ws map");

constexpr int LDS_BYTES = 147456;
constexpr int NPHASE = 33;

typedef unsigned short bf16;
typedef unsigned v4u __attribute__((ext_vector_type(4)));
typedef unsigned v2u __attribute__((ext_vector_type(2)));
typedef float f32x4 __attribute__((ext_vector_type(4)));
typedef float f32x2 __attribute__((ext_vector_type(2)));

__device__ __forceinline__ unsigned f2bf(float f) { unsigned u = __builtin_bit_cast(unsigned, f); return (u + 0x7fffu + ((u >> 16) & 1u)) >> 16; }
__device__ __forceinline__ unsigned pk2(float lo, float hi) { return f2bf(lo) | (f2bf(hi) << 16); }
__device__ __forceinline__ float bflo(unsigned w) { return __builtin_bit_cast(float, w << 16); }
__device__ __forceinline__ float bfhi(unsigned w) { return __builtin_bit_cast(float, w & 0xffff0000u); }
__device__ __forceinline__ float shx(float v, int lane, int o) { return __builtin_bit_cast(float, __builtin_amdgcn_ds_bpermute((lane ^ o) << 2, __builtin_bit_cast(int, v))); }
__device__ __forceinline__ float wave_sum(float v, int lane) {
#pragma unroll
    for (int o = 1; o < 64; o <<= 1) v += shx(v, lane, o);
    return v;
}
__device__ __forceinline__ float sigm(float z) { return __builtin_amdgcn_rcpf(1.f + __expf(-z)); }
__device__ __forceinline__ float gelu_tanh(float x) { const float u = 0.7978845608028654f * (x + 0.044715f * x * x * x); return x * __builtin_amdgcn_rcpf(1.f + __expf(-2.f * u)); }
__device__ __forceinline__ f32x2 cmul(f32x2 a, f32x2 b) { return (f32x2){a.x * b.x - a.y * b.y, a.x * b.y + a.y * b.x}; }
__device__ __forceinline__ void dsincos(double x, double& s, double& c) {
    const double q = __builtin_rint(x * 0.63661977236758134308);
    double r = __builtin_fma(-q, 1.57079632679489655800, x); r = __builtin_fma(-q, 6.12323399573676603587e-17, r);
    const double r2 = r * r;
    double sp = 1.0 / 6227020800.0; sp = -1.0 / 39916800.0 + r2 * sp; sp = 1.0 / 362880.0 + r2 * sp; sp = -1.0 / 5040.0 + r2 * sp; sp = 1.0 / 120.0 + r2 * sp; sp = -1.0 / 6.0 + r2 * sp;
    const double s0 = r + r * r2 * sp;
    double cp = 1.0 / 479001600.0; cp = -1.0 / 3628800.0 + r2 * cp; cp = 1.0 / 40320.0 + r2 * cp; cp = -1.0 / 720.0 + r2 * cp; cp = 1.0 / 24.0 + r2 * cp; cp = -0.5 + r2 * cp;
    const double c0 = 1.0 + r2 * cp;
    const int n = ((int)q) & 3;
    s = (n == 0) ? s0 : (n == 1) ? c0 : (n == 2) ? -s0 : -c0;
    c = (n == 0) ? c0 : (n == 1) ? -s0 : (n == 2) ? -c0 : s0;
}

__device__ __forceinline__ int lv(int v) { asm volatile("" : "+v"(v)); return v; }
__device__ __forceinline__ int lsi(int v) { asm volatile("" : "+s"(v)); return v; }
template <class TP> __device__ __forceinline__ TP* ls(TP* p) { asm volatile("" : "+s"(p)); return p; }
struct Args { const float* in[34]; float* out; unsigned char* ws; int ph_lo, ph_hi, coop, pad; };
typedef const __attribute__((address_space(4))) Args* KArgs;
__device__ __forceinline__ KArgs kargs() { KArgs p = (KArgs)__builtin_amdgcn_kernarg_segment_ptr(); asm volatile("" : "+s"(p)); return p; }

__device__ __forceinline__ void tr_item(const float* W, int ldw, int k0, int n0, bf16* dst, int ldd, const float* kscale, float* scr, int lane) {
#pragma unroll 8
    for (int i = 0; i < 32; ++i) { const int kk = 2 * i + (lane >> 5); float v = W[(size_t)(k0 + kk) * ldw + n0 + (lane & 31)]; if (kscale) v *= kscale[k0 + kk]; scr[kk * 33 + (lane & 31)] = v; }
    const int c = lane & 7;
#pragma unroll
    for (int j = 0; j < 4; ++j) { const int n = (lane >> 3) + 8 * j; const float* s = scr + (8 * c) * 33 + n;
        v4u o; o.x = pk2(s[0 * 33], s[1 * 33]); o.y = pk2(s[2 * 33], s[3 * 33]); o.z = pk2(s[4 * 33], s[5 * 33]); o.w = pk2(s[6 * 33], s[7 * 33]);
        *(v4u*)(dst + (size_t)n * ldd + k0 + 8 * c) = o; }
}

__device__ __forceinline__ void ada_item(KArgs a, int it, float* cact, float* part, int tid) {
    const int lane = tid & 63, wave = tid >> 6;
    const int col0 = it * 128;
    const float* W; const float* bias; float* out; int ldw;
    if (col0 < 4 * 6144) { const int l = col0 / 6144, cc = col0 - l * 6144; W = a->in[3] + (size_t)l * 1024 * 6144 + cc; ldw = 6144; bias = a->in[4] + l * 6144 + cc; out = (float*)(a->ws + WS_ADA) + (size_t)l * 8 * 6144 + cc; }
    else { const int cc = col0 - 4 * 6144; W = a->in[20] + cc; ldw = 2048; bias = a->in[21] + cc; out = (float*)(a->ws + WS_KVADA) + cc; }
    float acc[8][2];
#pragma unroll
    for (int b = 0; b < 8; ++b) { acc[b][0] = 0.f; acc[b][1] = 0.f; }
    const float* wp = W + (size_t)(wave * 128) * ldw + 2 * lane;
    const float* cp = cact + wave * 128 * 8;
#pragma unroll 8
    for (int k = 0; k < 128; ++k) {
        const f32x2 w2 = *(const f32x2*)(wp + (size_t)k * ldw);
        const f32x4 c0 = *(const f32x4*)(cp + k * 8), c1 = *(const f32x4*)(cp + k * 8 + 4);
        acc[0][0] += c0.x * w2.x; acc[0][1] += c0.x * w2.y; acc[1][0] += c0.y * w2.x; acc[1][1] += c0.y * w2.y;
        acc[2][0] += c0.z * w2.x; acc[2][1] += c0.z * w2.y; acc[3][0] += c0.w * w2.x; acc[3][1] += c0.w * w2.y;
        acc[4][0] += c1.x * w2.x; acc[4][1] += c1.x * w2.y; acc[5][0] += c1.y * w2.x; acc[5][1] += c1.y * w2.y;
        acc[6][0] += c1.z * w2.x; acc[6][1] += c1.z * w2.y; acc[7][0] += c1.w * w2.x; acc[7][1] += c1.w * w2.y;
    }
#pragma unroll
    for (int b = 0; b < 8; ++b) *(f32x2*)(part + (wave * 8 + b) * 128 + 2 * lane) = (f32x2){acc[b][0], acc[b][1]};
    __syncthreads();
    for (int o = tid; o < 1024; o += 512) { const int b = o >> 7, col = o & 127; float s = bias[col];
#pragma unroll
        for (int w = 0; w < 8; ++w) s += part[(w * 8 + b) * 128 + col];
        out[(size_t)b * ldw + col] = s; }
    __syncthreads();
}

__device__ __forceinline__ void s5prep_item(KArgs a, int l, int g, unsigned char* sm, int tid) {
    f32x2* apw = (f32x2*)sm;
    f32x2* bbv = (f32x2*)(sm + 8704);
    f32x2* ccv = (f32x2*)(sm + 16896);
    float* Kt = (float*)(sm + 25088);
    f32x2* fv = (f32x2*)(sm + 41472);
    const int lg = l * 64 + g;
    const float* lam_re = a->in[10] + lg * 64; const float* lam_im = a->in[11] + lg * 64;
    const float* b_re = a->in[13] + (size_t)lg * 64 * 16; const float* b_im = a->in[14] + (size_t)lg * 64 * 16;
    const float* c_re = a->in[15] + (size_t)lg * 16 * 64; const float* c_im = a->in[16] + (size_t)lg * 16 * 64;
    const float* dsk = a->in[17] + l * 1024 + g * 16;
    if (tid < 64) {
        const int n = tid; const double dt = exp((double)a->in[12][lg]); const double lr = lam_re[n], li = lam_im[n];
        const double mag = exp(lr * dt); double s, c; dsincos(li * dt, s, c); const double ar = mag * c, ai = mag * s;
        double pr = 1.0, pi = 0.0;
        for (int k = 0; k <= 16; ++k) { apw[k * 64 + n] = (f32x2){(float)pr, (float)pi}; const double tr = pr * ar - pi * ai, ti = pr * ai + pi * ar; pr = tr; pi = ti; }
        ((f32x2*)(a->ws + WS_A16))[lg * 64 + n] = apw[16 * 64 + n];
        const double den = lr * lr + li * li, nr = ar - 1.0, ni = ai;
        fv[n] = (f32x2){(float)((nr * lr + ni * li) / den), (float)((ni * lr - nr * li) / den)};
    }
    __syncthreads();
    for (int i = tid; i < 1024; i += 512) { const int n = i >> 4; bbv[i] = cmul(fv[n], (f32x2){b_re[i], b_im[i]}); ccv[i] = (f32x2){c_re[i], c_im[i]}; }
    __syncthreads();
    { const int lag = tid >> 5, p = (tid >> 1) & 15, qh = tid & 1; float acc[8];
#pragma unroll
        for (int q = 0; q < 8; ++q) acc[q] = 0.f;
        for (int n = 0; n < 64; ++n) { const f32x2 w = cmul(ccv[p * 64 + n], apw[lag * 64 + n]);
#pragma unroll
            for (int q = 0; q < 8; ++q) { const f32x2 bq = bbv[n * 16 + qh * 8 + q]; acc[q] += w.x * bq.x - w.y * bq.y; } }
#pragma unroll
        for (int q = 0; q < 8; ++q) Kt[(lag * 16 + p) * 16 + qh * 8 + q] = acc[q]; }
    __syncthreads();
    bf16* WT = (bf16*)(a->ws + WS_S5WT) + (size_t)lg * 256 * AUGK;
    for (int ch = tid; ch < 256 * 48; ch += 512) { const int row = ch / 48, cc = ch - row * 48, t = row >> 4, p = row & 15; float v[8];
        if (cc < 32) { const int s = cc >> 1, qh = cc & 1;
#pragma unroll
            for (int q = 0; q < 8; ++q) { float x = (s <= t) ? Kt[((t - s) * 16 + p) * 16 + qh * 8 + q] : 0.f; if (s == t && qh * 8 + q == p) x += dsk[p]; v[q] = x; } }
        else { const int n0 = (cc - 32) * 4;
#pragma unroll
            for (int k = 0; k < 4; ++k) { const f32x2 w = cmul(ccv[p * 64 + n0 + k], apw[(t + 1) * 64 + n0 + k]); v[2 * k] = w.x; v[2 * k + 1] = -w.y; } }
        v4u o; o.x = pk2(v[0], v[1]); o.y = pk2(v[2], v[3]); o.z = pk2(v[4], v[5]); o.w = pk2(v[6], v[7]);
        *(v4u*)(WT + (size_t)row * AUGK + cc * 8) = o; }
    bf16* WE = (bf16*)(a->ws + WS_S5WE) + (size_t)lg * 256 * 256;
    for (int ch = tid; ch < 256 * 32; ch += 512) { const int row = ch >> 5, cc = ch & 31, s = cc >> 1, qh = cc & 1; float v[8];
        if (row < 128) { const int n = row >> 1, im = row & 1; const f32x2 ap = apw[(15 - s) * 64 + n];
#pragma unroll
            for (int q = 0; q < 8; ++q) { const f32x2 pr = cmul(ap, bbv[n * 16 + qh * 8 + q]); v[q] = im ? pr.y : pr.x; } }
        else {
#pragma unroll
            for (int q = 0; q < 8; ++q) v[q] = 0.f; }
        v4u o; o.x = pk2(v[0], v[1]); o.y = pk2(v[2], v[3]); o.z = pk2(v[4], v[5]); o.w = pk2(v[6], v[7]);
        *(v4u*)(WE + (size_t)row * 256 + cc * 8) = o; }
    __syncthreads();
}

__device__ __forceinline__ void phase0(KArgs a, unsigned char* lds, int G_) { const int G = lsi(G_);
    const int tid = lv(threadIdx.x), lane = tid & 63, wave = tid >> 6;
    float* cact = (float*)lds; float* part = (float*)(lds + 32768);
    for (int i = tid; i < 8192; i += 512) { const int b = i >> 10, k = i & 1023; const float v = a->in[1][i]; cact[k * 8 + b] = v / (1.f + __expf(-v)); }
    __syncthreads();
    for (int it = lsi(blockIdx.x); it < 208 + 128; it += G) {
        if (it < 208) ada_item(a, it, cact, part, tid);
        else { const int r = it - 208; s5prep_item(a, r >> 6, r & 63, lds + 65536, tid); }
    }
    __syncthreads();
    float* scr = (float*)(lds + wave * 16384);
    const int gw = lsi(blockIdx.x) * 8 + wave, NGW = G * 8;
    unsigned char* ws = a->ws;
    constexpr int I_GU = 16 * 88, I_D = 44 * 32, I_SQ = 16 * 32, I_DQ = 16 * 8, I_KVA = 16 * 9, I_UQ = 4 * 48, I_KVB = 4 * 64;
    constexpr int NTR = 8 * I_GU + 4 * I_D + 2 * I_SQ + 2 * I_DQ + I_KVA + 2 * I_UQ + I_KVB + 2 * I_SQ;
    for (int it = gw; it < NTR; it += NGW) {
        int r = it;
        if (r < 8 * I_GU) { const int up = r >= 4 * I_GU; if (up) r -= 4 * I_GU; const int l = r / I_GU; r -= l * I_GU; const int kb = r / 88, n0 = (r % 88) * 32;
            tr_item(a->in[up ? 8 : 7] + (size_t)l * 1024 * FF, FF, kb * 64, n0, (bf16*)(ws + WS_WGU) + ((size_t)l * 5632 + (n0 >> 7) * 256 + up * 128 + (n0 & 127)) * 1024, 1024, nullptr, scr, lane); continue; }
        r -= 8 * I_GU;
        if (r < 4 * I_D) { const int l = r / I_D; r -= l * I_D; const int kb = r / 32, n0 = (r % 32) * 32;
            tr_item(a->in[9] + (size_t)l * FF * 1024, 1024, kb * 64, n0, (bf16*)(ws + WS_WD) + ((size_t)l * 1024 + n0) * FF, FF, nullptr, scr, lane); continue; }
        r -= 4 * I_D;
        if (r < 2 * I_SQ) { const int l = r / I_SQ; r -= l * I_SQ; const int kb = r / 32, n0 = (r % 32) * 32;
            tr_item(a->in[18] + (size_t)l * 1024 * 1024, 1024, kb * 64, n0, (bf16*)(ws + WS_WGLU) + ((size_t)l * 1024 + n0) * 1024, 1024, nullptr, scr, lane); continue; }
        r -= 2 * I_SQ;
        if (r < 2 * I_DQ) { const int l = r / I_DQ; r -= l * I_DQ; const int kb = r / 8, n0 = (r % 8) * 32;
            tr_item(a->in[28] + (size_t)l * 1024 * 256, 256, kb * 64, n0, (bf16*)(ws + WS_WDQ) + ((size_t)l * 256 + n0) * 1024, 1024, nullptr, scr, lane); continue; }
        r -= 2 * I_DQ;
        if (r < I_KVA) { const int kb = r / 9, n0 = (r % 9) * 32;
            tr_item(a->in[23], 288, kb * 64, n0, (bf16*)(ws + WS_WKVA) + (size_t)n0 * 1024, 1024, nullptr, scr, lane); continue; }
        r -= I_KVA;
        if (r < 2 * I_UQ) { const int l = r / I_UQ; r -= l * I_UQ; const int kb = r / 48, n0 = (r % 48) * 32; const int hh = n0 / 96, db = (n0 - hh * 96) >> 5;
            const int drow = (db < 2) ? (256 * (hh >> 2) + 128 * db + 32 * (hh & 3)) : (1024 + 256 * (hh >> 3) + 128 * ((hh & 7) >> 2) + 32 * (hh & 3));
            tr_item(a->in[30] + (size_t)l * 256 * 1536, 1536, kb * 64, n0, (bf16*)(ws + WS_WUQ) + ((size_t)l * 1536 + drow) * 256, 256, a->in[29] + l * 256, scr, lane); continue; }
        r -= 2 * I_UQ;
        if (r < I_KVB) { const int kb = r / 64, n0 = (r % 64) * 32; const int hh = n0 >> 7, db = (n0 & 127) >> 5;
            const int drow = (db < 2) ? (256 * (hh >> 2) + 128 * db + 32 * (hh & 3)) : (1024 + hh * 64 + (db - 2) * 32);
            tr_item(a->in[25], 2048, kb * 64, n0, (bf16*)(ws + WS_WKVB) + (size_t)drow * 256, 256, a->in[24], scr, lane); continue; }
        r -= I_KVB;
        { const int l = r / I_SQ; r -= l * I_SQ; const int kb = r / 32, n0 = (r % 32) * 32;
            tr_item(a->in[33] + (size_t)l * 1024 * 1024, 1024, kb * 64, n0, (bf16*)(ws + WS_WO) + ((size_t)l * 1024 + n0) * 1024, 1024, nullptr, scr, lane); }
    }
    const int gt = lsi(blockIdx.x) * 512 + tid, NT_ = G * 512;
    const int* pos = (const int*)a->in[2];
    for (int idx = gt; idx < T * 16; idx += NT_) { const int row = idx >> 4, i = idx & 15;
        const double b4 = (i & 3) == 0 ? 1.0 : (i & 3) == 1 ? 0.56234132519034908 : (i & 3) == 2 ? 0.31622776601683794 : 0.17782794100389228;
        const double p10 = (i >> 2) == 0 ? 1.0 : (i >> 2) == 1 ? 0.1 : (i >> 2) == 2 ? 0.01 : 0.001;
        double s, c; dsincos((double)pos[row] * (b4 * p10), s, c);
        ((float*)(ws + WS_COS))[idx] = (float)c; ((float*)(ws + WS_SIN))[idx] = (float)s; }
    for (int idx = gt; idx < 3 * T; idx += NT_) ((float*)(ws + WS_QSS))[idx] = 0.f;
    for (int idx = gt; idx < 224 * 1024 / 2; idx += NT_) ((unsigned*)((bf16*)(ws + WS_WKVA) + 288 * 1024))[idx] = 0u;
}

__device__ __forceinline__ void s5_norm_phase(KArgs a, int l, const float* xin, unsigned char* lds, int G_) { const int G = lsi(G_);
    const int tid = lv(threadIdx.x), lane = tid & 63, wave = tid >> 6;
    bf16* stage = (bf16*)lds;
    const float* ng = a->in[5] + l * 1024;
    bf16* AUG = (bf16*)(a->ws + WS_AUG);
    for (int it = lsi(blockIdx.x); it < NB * NSUB; it += G) {
        const int b = it >> 8, c = it & 255;
        const float* ada = (const float*)(a->ws + WS_ADA) + ((size_t)l * 8 + b) * 6144;
        f32x4 mul[4], add[4];
#pragma unroll
        for (int j = 0; j < 4; ++j) { const int ch = 4 * lane + 256 * j; const f32x4 gg = *(const f32x4*)(ng + ch), sc = *(const f32x4*)(ada + 1024 + ch); mul[j] = gg * (sc + 1.0f); add[j] = *(const f32x4*)(ada + ch); }
#pragma unroll
        for (int tt = 0; tt < 2; ++tt) { const int tok = 2 * wave + tt; const float* xr = xin + ((size_t)b * SEQ + c * 16 + tok) * 1024;
            f32x4 v[4]; float ss = 0.f;
#pragma unroll
            for (int j = 0; j < 4; ++j) { v[j] = *(const f32x4*)(xr + 4 * lane + 256 * j); ss += (v[j].x * v[j].x + v[j].y * v[j].y) + (v[j].z * v[j].z + v[j].w * v[j].w); }
            const float rstd = rsqrtf(wave_sum(ss, lane) * (1.f / 1024.f) + EPS);
#pragma unroll
            for (int j = 0; j < 4; ++j) { const f32x4 h = v[j] * rstd * mul[j] + add[j]; *(v2u*)(stage + tok * 1024 + 4 * lane + 256 * j) = (v2u){pk2(h.x, h.y), pk2(h.z, h.w)}; } }
        __syncthreads();
        { const int g = tid >> 3, part = tid & 7; bf16* dst = AUG + ((size_t)g * 2048 + b * 256 + c) * AUGK;
#pragma unroll
            for (int k = 0; k < 4; ++k) { const int chunk = part * 4 + k, s = chunk >> 1, qh = chunk & 1; *(v4u*)(dst + chunk * 8) = *(const v4u*)(stage + s * 1024 + g * 16 + qh * 8); } }
        __syncthreads();
    }
}
__device__ __forceinline__ void norm_phase(const float* x, const float* g1, const float* sh1, const float* sc1, int bstride1, bf16* out1,
                                           const float* g2, const float* sh2, const float* sc2, int bstride2, bf16* out2, int G_) { const int G = lsi(G_);
    const int tid = lv(threadIdx.x), lane = tid & 63, wave = tid >> 6;
    for (int rb = lsi(blockIdx.x) * 8 + wave; rb < T / 16; rb += G * 8) {
        const int b = rb >> 8;
        f32x4 mul[4], add[4], mul2[4], add2[4];
#pragma unroll
        for (int j = 0; j < 4; ++j) { const int ch = 4 * lane + 256 * j; mul[j] = *(const f32x4*)(g1 + ch) * (*(const f32x4*)(sc1 + (size_t)b * bstride1 + ch) + 1.0f); add[j] = *(const f32x4*)(sh1 + (size_t)b * bstride1 + ch);
            if (out2) { mul2[j] = *(const f32x4*)(g2 + ch) * (*(const f32x4*)(sc2 + (size_t)b * bstride2 + ch) + 1.0f); add2[j] = *(const f32x4*)(sh2 + (size_t)b * bstride2 + ch); } }
        for (int r4 = 0; r4 < 16; r4 += 4) {
            f32x4 v[4][4]; float ss[4];
#pragma unroll
            for (int q = 0; q < 4; ++q) { const float* xr = x + ((size_t)rb * 16 + r4 + q) * 1024; ss[q] = 0.f;
#pragma unroll
                for (int j = 0; j < 4; ++j) v[q][j] = *(const f32x4*)(xr + 4 * lane + 256 * j); }
#pragma unroll
            for (int q = 0; q < 4; ++q)
#pragma unroll
                for (int j = 0; j < 4; ++j) ss[q] += (v[q][j].x * v[q][j].x + v[q][j].y * v[q][j].y) + (v[q][j].z * v[q][j].z + v[q][j].w * v[q][j].w);
#pragma unroll
            for (int o = 1; o < 64; o <<= 1) {
                const float t0 = shx(ss[0], lane, o), t1 = shx(ss[1], lane, o), t2 = shx(ss[2], lane, o), t3 = shx(ss[3], lane, o);
                ss[0] += t0; ss[1] += t1; ss[2] += t2; ss[3] += t3; }
#pragma unroll
            for (int q = 0; q < 4; ++q) { const size_t row = (size_t)rb * 16 + r4 + q; const float rstd = rsqrtf(ss[q] * (1.f / 1024.f) + EPS);
#pragma unroll
                for (int j = 0; j < 4; ++j) { const f32x4 h = v[q][j] * rstd * mul[j] + add[j]; *(v2u*)(out1 + row * 1024 + 4 * lane + 256 * j) = (v2u){pk2(h.x, h.y), pk2(h.z, h.w)}; }
                if (out2) {
#pragma unroll
                    for (int j = 0; j < 4; ++j) { const f32x4 h = v[q][j] * rstd * mul2[j] + add2[j]; *(v2u*)(out2 + row * 1024 + 4 * lane + 256 * j) = (v2u){pk2(h.x, h.y), pk2(h.z, h.w)}; } } }
        }
    }
}
__device__ __forceinline__ void carry_phase(KArgs a, int l, int G_) { const int G = lsi(G_);
    const int tid = lv(threadIdx.x), lane = tid & 63, wave = tid >> 6;
    const float* EB = (const float*)(a->ws + WS_EBUF); bf16* AUG = (bf16*)(a->ws + WS_AUG);
    const int nn = lane >> 4, j = lane & 15;
    for (int L = lsi(blockIdx.x); L < 512; L += G)
    for (int nq = wave; nq < 16; nq += 8) {
        const int b = L & 7, g = L >> 3, n = nq * 4 + nn;
        const f32x2 a16 = ((const f32x2*)(a->ws + WS_A16))[(l * 64 + g) * 64 + n];
        const f32x4* ep = (const f32x4*)(EB + ((((size_t)(g * 8 + b) * 64 + n) * 256) + j * 16) * 2);
        f32x4 e[8];
#pragma unroll
        for (int i = 0; i < 8; ++i) e[i] = ep[i];
        f32x2 t = {0.f, 0.f};
#pragma unroll
        for (int i = 0; i < 8; ++i) { t = cmul(a16, t) + (f32x2){e[i].x, e[i].y}; t = cmul(a16, t) + (f32x2){e[i].z, e[i].w}; }
        f32x2 Ad = a16;
#pragma unroll
        for (int k = 0; k < 4; ++k) Ad = cmul(Ad, Ad);
#pragma unroll
        for (int d = 1; d < 16; d <<= 1) { const int sl = ((j >= d) ? lane - d : lane) << 2; const float tx_ = t.x, ty_ = t.y; const float orr = __builtin_bit_cast(float, __builtin_amdgcn_ds_bpermute(sl, __builtin_bit_cast(int, tx_))), oi = __builtin_bit_cast(float, __builtin_amdgcn_ds_bpermute(sl, __builtin_bit_cast(int, ty_)));
            if (j >= d) { t.x += Ad.x * orr - Ad.y * oi; t.y += Ad.x * oi + Ad.y * orr; }
            Ad = cmul(Ad, Ad); }
        f32x2 cur; { const int sl = ((j >= 1) ? lane - 1 : lane) << 2; const float tx_ = t.x, ty_ = t.y; cur.x = __builtin_bit_cast(float, __builtin_amdgcn_ds_bpermute(sl, __builtin_bit_cast(int, tx_))); cur.y = __builtin_bit_cast(float, __builtin_amdgcn_ds_bpermute(sl, __builtin_bit_cast(int, ty_))); } if (j == 0) cur = (f32x2){0.f, 0.f};
        bf16* op = AUG + ((size_t)g * 2048 + b * 256 + j * 16) * AUGK + 256 + 2 * n;
#pragma unroll
        for (int i = 0; i < 8; ++i) {
            *(unsigned*)(op + (size_t)(2 * i) * AUGK) = pk2(cur.x, cur.y); cur = cmul(a16, cur) + (f32x2){e[i].x, e[i].y};
            *(unsigned*)(op + (size_t)(2 * i + 1) * AUGK) = pk2(cur.x, cur.y); cur = cmul(a16, cur) + (f32x2){e[i].z, e[i].w}; }
    }
}

using pg8::Unit;
typedef const f32x4 (&AccRef)[2][2][4][2];
struct GroupOrder {
    int G, c;
    __device__ __forceinline__ bool next(int i, Unit& u) const { const int L = i * G + c; if (L >= 512) return false; u.pm = L; u.pn = L >> 3; return true; }
    __device__ __forceinline__ void a_ready(const Unit&) const {}
    __device__ __forceinline__ void done(const Unit&) const {}
};
struct EpiE { static constexpr bool PERM = false, AFTER_DRAIN = false; float* E;
    __device__ __forceinline__ void operator()(AccRef acc, const Unit& u, int wr, int wc, int fr, int fq) const { fr = lv(fr); fq = lv(fq);
        float* base = E + (size_t)((u.pn * 8 + (u.pm & 7)) * 64) * 512;
#pragma unroll
        for (int ai = 0; ai < 2; ++ai)
#pragma unroll
            for (int m = 0; m < 4; ++m) { const int c = ai * 128 + wr * 64 + m * 16 + fr;
#pragma unroll
                for (int n = 0; n < 2; ++n) { const int ns = 16 * wc + 8 * n + 2 * fq; const f32x4 v = acc[ai][0][m][n];
                    *(f32x2*)(base + ((size_t)ns * 256 + c) * 2) = (f32x2){v.x, v.y}; *(f32x2*)(base + ((size_t)(ns + 1) * 256 + c) * 2) = (f32x2){v.z, v.w}; } }
    }
};
struct EpiY { static constexpr bool PERM = true, AFTER_DRAIN = false; bf16* Gd;
    __device__ __forceinline__ void operator()(AccRef acc, const Unit& u, int wr, int wc, int fr, int fq) const { fr = lv(fr); fq = lv(fq);
        const int g = u.pn, b = u.pm & 7;
#pragma unroll
        for (int bj = 0; bj < 2; ++bj) { const int tc0 = 128 * bj + 32 * wc + 8 * fq, t = tc0 >> 4, p0 = tc0 & 15;
#pragma unroll
            for (int ai = 0; ai < 2; ++ai)
#pragma unroll
                for (int m = 0; m < 4; ++m) { const int r = ai * 128 + wr * 64 + m * 16 + fr; const size_t tok = (size_t)b * SEQ + r * 16 + t;
                    const f32x4 v0 = acc[ai][bj][m][0], v1 = acc[ai][bj][m][1];
                    v4u w; w.x = pk2(gelu_tanh(v0.x), gelu_tanh(v0.y)); w.y = pk2(gelu_tanh(v0.z), gelu_tanh(v0.w)); w.z = pk2(gelu_tanh(v1.x), gelu_tanh(v1.y)); w.w = pk2(gelu_tanh(v1.z), gelu_tanh(v1.w));
                    *(v4u*)(Gd + tok * 1024 + g * 16 + p0) = w; } }
    }
};
struct EpiGlu { static constexpr bool PERM = false, AFTER_DRAIN = false; const bf16* Gd; const float* bglu; const float* gate; const float* xin; float* xout;
    __device__ __forceinline__ void operator()(AccRef acc, const Unit& u, int wr, int wc, int fr, int fq) const { fr = lv(fr); fq = lv(fq);
        const int b = u.pm >> 4;
#pragma unroll
        for (int bj = 0; bj < 2; ++bj)
#pragma unroll
            for (int n = 0; n < 2; ++n) { const int col = u.pn * 256 + 128 * bj + 32 * wc + 16 * n + 4 * fq; const f32x4 bg = *(const f32x4*)(bglu + col), gt = *(const f32x4*)(gate + (size_t)b * 6144 + col);
#pragma unroll
                for (int ai = 0; ai < 2; ++ai)
#pragma unroll
                    for (int m = 0; m < 4; ++m) { const size_t off = (size_t)(u.pm * 256 + ai * 128 + wr * 64 + m * 16 + fr) * 1024 + col;
                        const v2u gw = *(const v2u*)(Gd + off); const f32x4 gv = {bflo(gw.x), bfhi(gw.x), bflo(gw.y), bfhi(gw.y)};
                        const f32x4 z = acc[ai][bj][m][n] + bg; const f32x4 mix = {gv.x * sigm(z.x), gv.y * sigm(z.y), gv.z * sigm(z.z), gv.w * sigm(z.w)};
                        *(f32x4*)(xout + off) = *(const f32x4*)(xin + off) + gt * mix; } }
    }
};
struct EpiRes { static constexpr bool PERM = false, AFTER_DRAIN = false; const float* gate; float* x;
    __device__ __forceinline__ void operator()(AccRef acc, const Unit& u, int wr, int wc, int fr, int fq) const { fr = lv(fr); fq = lv(fq);
        const int b = u.pm >> 4;
#pragma unroll
        for (int bj = 0; bj < 2; ++bj)
#pragma unroll
            for (int n = 0; n < 2; ++n) { const int col = u.pn * 256 + 128 * bj + 32 * wc + 16 * n + 4 * fq; const f32x4 gt = *(const f32x4*)(gate + (size_t)b * 6144 + col);
#pragma unroll
                for (int ai = 0; ai < 2; ++ai)
#pragma unroll
                    for (int m = 0; m < 4; ++m) { const size_t off = (size_t)(u.pm * 256 + ai * 128 + wr * 64 + m * 16 + fr) * 1024 + col;
                        *(f32x4*)(x + off) = *(const f32x4*)(x + off) + gt * acc[ai][bj][m][n]; } }
    }
};
__device__ __forceinline__ float sq4(f32x4 v);
struct EpiNone { static constexpr bool PERM = false, AFTER_DRAIN = false; float* sink;
    __device__ __forceinline__ void operator()(AccRef acc, const Unit& u, int wr, int wc, int fr, int fq) const { if (sink) { float s = 0.f;
#pragma unroll
        for (int ai = 0; ai < 2; ++ai)
#pragma unroll
            for (int bj = 0; bj < 2; ++bj)
#pragma unroll
                for (int m = 0; m < 4; ++m)
#pragma unroll
                    for (int n = 0; n < 2; ++n) s += sq4(acc[ai][bj][m][n]);
        if (s == 123.456f) sink[0] = s; } }
};
__device__ __forceinline__ float sq4(f32x4 v);
__device__ __forceinline__ void silu2(float g1, float g2, float u1, float u2, float& o1, float& o2) {
    const float a = 1.f + fminf(__expf(-g1), 1e18f), b = 1.f + fminf(__expf(-g2), 1e18f);
    const float r = __builtin_amdgcn_rcpf(a * b);
    o1 = g1 * u1 * (r * b); o2 = g2 * u2 * (r * a);
}
struct EpiGU { static constexpr bool PERM = true, AFTER_DRAIN = false; bf16* H;
    __device__ __forceinline__ void operator()(AccRef acc, const Unit& u, int wr, int wc, int fr, int fq) const { fr = lv(fr); fq = lv(fq);
#pragma unroll
        for (int ai = 0; ai < 2; ++ai)
#pragma unroll
            for (int m = 0; m < 4; ++m) { const size_t row = (size_t)(u.pm * 256 + ai * 128 + wr * 64 + m * 16 + fr);
                const f32x4 g0 = acc[ai][0][m][0], g1 = acc[ai][0][m][1], u0 = acc[ai][1][m][0], u1 = acc[ai][1][m][1];
                float h[8];
                silu2(g0.x, g0.y, u0.x, u0.y, h[0], h[1]); silu2(g0.z, g0.w, u0.z, u0.w, h[2], h[3]);
                silu2(g1.x, g1.y, u1.x, u1.y, h[4], h[5]); silu2(g1.z, g1.w, u1.z, u1.w, h[6], h[7]);
                v4u w; w.x = pk2(h[0], h[1]); w.y = pk2(h[2], h[3]); w.z = pk2(h[4], h[5]); w.w = pk2(h[6], h[7]);
                *(v4u*)(H + row * FF + u.pn * 128 + 32 * wc + 8 * fq) = w; }
    }
};
__device__ __forceinline__ float sq4(f32x4 v) { return (v.x * v.x + v.y * v.y) + (v.z * v.z + v.w * v.w); }
__device__ __forceinline__ float quad_sum_(float s, int lane) { s += shx(s, lane, 16); s += shx(s, lane, 32); return s; }
#define quad_sum(s) quad_sum_((s), fr + 16 * fq)
struct EpiDq { static constexpr bool PERM = true, AFTER_DRAIN = false; bf16* QA; float* SS;
    __device__ __forceinline__ void operator()(AccRef acc, const Unit& u, int wr, int wc, int fr, int fq) const { fr = lv(fr); fq = lv(fq);
#pragma unroll
        for (int ai = 0; ai < 2; ++ai)
#pragma unroll
            for (int m = 0; m < 4; ++m) { const size_t row = (size_t)(u.pm * 256 + ai * 128 + wr * 64 + m * 16 + fr); float ss = 0.f;
#pragma unroll
                for (int bj = 0; bj < 2; ++bj) { const f32x4 v0 = acc[ai][bj][m][0], v1 = acc[ai][bj][m][1]; ss += sq4(v0) + sq4(v1);
                    *(v4u*)(QA + row * 256 + 128 * bj + 32 * wc + 8 * fq) = (v4u){pk2(v0.x, v0.y), pk2(v0.z, v0.w), pk2(v1.x, v1.y), pk2(v1.z, v1.w)}; }
                ss = quad_sum(ss); if (fq == 0) atomicAdd(SS + row, ss); }
    }
};
struct EpiKva { static constexpr bool PERM = false, AFTER_DRAIN = false; bf16* CKV; float* SS; bf16* KR; const float* gkr; const float* COS; const float* SIN;
    __device__ __forceinline__ void operator()(AccRef acc, const Unit& u, int wr, int wc, int fr, int fq) const { fr = lv(fr); fq = lv(fq);
        if (u.pn == 0) {
#pragma unroll
            for (int ai = 0; ai < 2; ++ai)
#pragma unroll
                for (int m = 0; m < 4; ++m) { const size_t row = (size_t)(u.pm * 256 + ai * 128 + wr * 64 + m * 16 + fr); float ss = 0.f;
#pragma unroll
                    for (int bj = 0; bj < 2; ++bj)
#pragma unroll
                        for (int n = 0; n < 2; ++n) { const f32x4 v = acc[ai][bj][m][n]; ss += sq4(v); *(v2u*)(CKV + row * 256 + 128 * bj + 32 * wc + 16 * n + 4 * fq) = (v2u){pk2(v.x, v.y), pk2(v.z, v.w)}; }
                    ss = quad_sum(ss); if (fq == 0) atomicAdd(SS + row, ss); }
        } else if (wc == 0) {
            const f32x4 g1 = *(const f32x4*)(gkr + 4 * fq), g2 = *(const f32x4*)(gkr + 16 + 4 * fq);
#pragma unroll
            for (int ai = 0; ai < 2; ++ai)
#pragma unroll
                for (int m = 0; m < 4; ++m) { const size_t row = (size_t)(u.pm * 256 + ai * 128 + wr * 64 + m * 16 + fr);
                    const f32x4 x1 = acc[ai][0][m][0], x2 = acc[ai][0][m][1];
                    const float rstd = rsqrtf(quad_sum(sq4(x1) + sq4(x2)) * (1.f / 32.f) + EPS);
                    const f32x4 cs = *(const f32x4*)(COS + row * 16 + 4 * fq), sn = *(const f32x4*)(SIN + row * 16 + 4 * fq);
                    const f32x4 y1 = x1 * rstd * g1, y2 = x2 * rstd * g2, o1 = y1 * cs - y2 * sn, o2 = y1 * sn + y2 * cs;
                    *(v2u*)(KR + row * 32 + 4 * fq) = (v2u){pk2(o1.x, o1.y), pk2(o1.z, o1.w)}; *(v2u*)(KR + row * 32 + 16 + 4 * fq) = (v2u){pk2(o2.x, o2.y), pk2(o2.z, o2.w)}; }
        }
    }
};
constexpr float QSC = 0.10206207261596577f * 1.4426950408889634f;
struct EpiUq { static constexpr bool PERM = false, AFTER_DRAIN = false; const float* SS; const float* gn; const float* gr; const float* COS; const float* SIN; bf16* QB;
    __device__ __forceinline__ void operator()(AccRef acc, const Unit& u, int wr, int wc, int fr, int fq) const { fr = lv(fr); fq = lv(fq);
        const int b = u.pm >> 4; float ssv[2][4];
#pragma unroll
        for (int ai = 0; ai < 2; ++ai)
#pragma unroll
            for (int m = 0; m < 4; ++m) ssv[ai][m] = SS[(size_t)(u.pm * 256 + ai * 128 + wr * 64 + m * 16 + fr)];
#pragma unroll
        for (int ai = 0; ai < 2; ++ai)
#pragma unroll
            for (int m = 0; m < 4; ++m) { const int rowi = u.pm * 256 + ai * 128 + wr * 64 + m * 16 + fr; const size_t row = (size_t)rowi; const int s = rowi & (SEQ - 1);
                const float rq = rsqrtf(ssv[ai][m] * (1.f / 256.f) + EPS);
                if (u.pn < 4) { const int hh = 4 * u.pn + wc; float ss = 0.f; f32x4 v[2][2];
#pragma unroll
                    for (int bj = 0; bj < 2; ++bj)
#pragma unroll
                        for (int n = 0; n < 2; ++n) { v[bj][n] = acc[ai][bj][m][n] * rq; ss += sq4(v[bj][n]); }
                    const float rh = rsqrtf(quad_sum(ss) * (1.f / 64.f) + EPS);
                    bf16* dst = QB + (((size_t)b * NH + hh) * SEQ + s) * 96;
#pragma unroll
                    for (int bj = 0; bj < 2; ++bj)
#pragma unroll
                        for (int n = 0; n < 2; ++n) { const int d = 32 * bj + 16 * n + 4 * fq; const f32x4 o = v[bj][n] * (rh * QSC) * *(const f32x4*)(gn + d); *(v2u*)(dst + d) = (v2u){pk2(o.x, o.y), pk2(o.z, o.w)}; }
                } else {
                    const f32x4 cs = *(const f32x4*)(COS + row * 16 + 4 * fq), sn = *(const f32x4*)(SIN + row * 16 + 4 * fq);
                    const f32x4 g1 = *(const f32x4*)(gr + 4 * fq), g2 = *(const f32x4*)(gr + 16 + 4 * fq);
#pragma unroll
                    for (int bj = 0; bj < 2; ++bj) { const int hh = 8 * (u.pn - 4) + 4 * bj + wc;
                        const f32x4 x1 = acc[ai][bj][m][0] * rq, x2 = acc[ai][bj][m][1] * rq;
                        const float rh = rsqrtf(quad_sum(sq4(x1) + sq4(x2)) * (1.f / 32.f) + EPS);
                        const f32x4 y1 = x1 * (rh * QSC) * g1, y2 = x2 * (rh * QSC) * g2, o1 = y1 * cs - y2 * sn, o2 = y1 * sn + y2 * cs;
                        bf16* dst = QB + (((size_t)b * NH + hh) * SEQ + s) * 96 + 64;
                        *(v2u*)(dst + 4 * fq) = (v2u){pk2(o1.x, o1.y), pk2(o1.z, o1.w)}; *(v2u*)(dst + 16 + 4 * fq) = (v2u){pk2(o2.x, o2.y), pk2(o2.z, o2.w)}; }
                } }
    }
};
struct EpiKvb { static constexpr bool PERM = false, AFTER_DRAIN = false; const float* SS; const float* gk; bf16* KB; bf16* VB;
    __device__ __forceinline__ void operator()(AccRef acc, const Unit& u, int wr, int wc, int fr, int fq) const { fr = lv(fr); fq = lv(fq);
        const int b = u.pm >> 4; float ssv[2][4];
#pragma unroll
        for (int ai = 0; ai < 2; ++ai)
#pragma unroll
            for (int m = 0; m < 4; ++m) ssv[ai][m] = SS[(size_t)(u.pm * 256 + ai * 128 + wr * 64 + m * 16 + fr)];
#pragma unroll
        for (int ai = 0; ai < 2; ++ai)
#pragma unroll
            for (int m = 0; m < 4; ++m) { const int rowi = u.pm * 256 + ai * 128 + wr * 64 + m * 16 + fr; const size_t row = (size_t)rowi; const int s = rowi & (SEQ - 1);
                const float rc = rsqrtf(ssv[ai][m] * (1.f / 256.f) + EPS);
                if (u.pn < 4) { const int hh = 4 * u.pn + wc; float ss = 0.f; f32x4 v[2][2];
#pragma unroll
                    for (int bj = 0; bj < 2; ++bj)
#pragma unroll
                        for (int n = 0; n < 2; ++n) { v[bj][n] = acc[ai][bj][m][n] * rc; ss += sq4(v[bj][n]); }
                    const float rh = rsqrtf(quad_sum(ss) * (1.f / 64.f) + EPS);
                    bf16* dst = KB + (((size_t)b * NH + hh) * SEQ + s) * 64;
#pragma unroll
                    for (int bj = 0; bj < 2; ++bj)
#pragma unroll
                        for (int n = 0; n < 2; ++n) { const int d = 32 * bj + 16 * n + 4 * fq; const f32x4 o = v[bj][n] * rh * *(const f32x4*)(gk + d); *(v2u*)(dst + d) = (v2u){pk2(o.x, o.y), pk2(o.z, o.w)}; }
                } else {
#pragma unroll
                    for (int bj = 0; bj < 2; ++bj)
#pragma unroll
                        for (int n = 0; n < 2; ++n) { const int col = 256 * (u.pn - 4) + 128 * bj + 32 * wc + 16 * n + 4 * fq, hh = col >> 6, dv = col & 63;
                            const f32x4 o = acc[ai][bj][m][n] * rc; *(v2u*)(VB + (((size_t)b * NH + hh) * SEQ + s) * 64 + dv) = (v2u){pk2(o.x, o.y), pk2(o.z, o.w)}; }
                } }
    }
};

namespace att {
using bf16x8 = __attribute__((ext_vector_type(8))) short;
using s16x4 = __attribute__((ext_vector_type(4))) short;
using f32x16 = __attribute__((ext_vector_type(16))) float;
using u32x4 = __attribute__((ext_vector_type(4))) unsigned;
constexpr int QBLK = 32, KVBLK = 64;
constexpr float SCALE = 0.10206207261596577f;
constexpr float THR = 6.f;
constexpr int SHM_V = 64 * 64 * 2, SHM_K = 64 * 256;
#define KSWZ(row, colB) ((row) * 256 + ((colB) ^ (((row) & 7) << 4)))
#define SBAR() __builtin_amdgcn_sched_barrier(0)
__device__ __forceinline__ int crow(int r, int hi) { return (r & 3) + 8 * (r >> 2) + 4 * hi; }
__device__ __forceinline__ unsigned cvtpk(float lo, float hi) { unsigned r; asm volatile("v_cvt_pk_bf16_f32 %0, %1, %2" : "=v"(r) : "v"(lo), "v"(hi)); return r; }
__device__ __forceinline__ void partialSM(f32x16& p0, f32x16& p1, float& m_reg, f32x16& negm, float& alpha) {
    constexpr float THRL = THR * 1.4426950408889634f;
    float pmax = p0[0];
#pragma unroll
    for (int r = 1; r < 16; ++r) pmax = fmaxf(pmax, p0[r]);
#pragma unroll
    for (int r = 0; r < 16; ++r) pmax = fmaxf(pmax, p1[r]);
    { auto rr = __builtin_amdgcn_permlane32_swap(__float_as_uint(pmax), __float_as_uint(pmax), false, false); pmax = fmaxf(__uint_as_float(rr[0]), __uint_as_float(rr[1])); }
    if (__builtin_expect(__all(pmax <= THRL), 1)) { alpha = 1.f; }
    else { const float dl = fmaxf(pmax, 0.f); m_reg += dl; alpha = __builtin_amdgcn_exp2f(-dl);
#pragma unroll
        for (int r = 0; r < 16; ++r) { p0[r] -= dl; p1[r] -= dl; }
#pragma unroll
        for (int r = 0; r < 16; ++r) negm[r] = -m_reg; }
#pragma unroll
    for (int r = 0; r < 16; ++r) p0[r] = __builtin_amdgcn_exp2f(p0[r]);
}
__device__ __forceinline__ void finishSM(f32x16& p0, f32x16& p1, float alpha, float& l_reg, bf16x8& pa0, bf16x8& pa1, bf16x8& pa2, bf16x8& pa3) {
#pragma unroll
    for (int r = 0; r < 16; ++r) p1[r] = __builtin_amdgcn_exp2f(p1[r]);
    float ps = 0;
#pragma unroll
    for (int r = 0; r < 16; ++r) ps += p0[r];
#pragma unroll
    for (int r = 0; r < 16; ++r) ps += p1[r];
    { auto rr = __builtin_amdgcn_permlane32_swap(__float_as_uint(ps), __float_as_uint(ps), false, false); ps = __uint_as_float(rr[0]) + __uint_as_float(rr[1]); }
    l_reg = l_reg * alpha + ps;
#define PK4(P, BASE, OUT) do { unsigned a0 = cvtpk(P[BASE + 0], P[BASE + 1]), a1 = cvtpk(P[BASE + 2], P[BASE + 3]);   \
    unsigned b0 = cvtpk(P[BASE + 4], P[BASE + 5]), b1 = cvtpk(P[BASE + 6], P[BASE + 7]);                              \
    auto r0 = __builtin_amdgcn_permlane32_swap(a0, b0, false, false); auto r1 = __builtin_amdgcn_permlane32_swap(a1, b1, false, false); \
    u32x4 w = {r0[0], r1[0], r0[1], r1[1]}; OUT = *reinterpret_cast<bf16x8*>(&w); } while (0)
    PK4(p0, 0, pa0); PK4(p0, 8, pa1); PK4(p1, 0, pa2); PK4(p1, 8, pa3);
#undef PK4
}
__device__ __forceinline__ void qkt(f32x16& p0, f32x16& p1, const char* Ks, const bf16x8* qr, int r32, int hi, const f32x16& cin) {
    p0 = cin; p1 = cin;
#pragma unroll
    for (int d0 = 0; d0 < 6; ++d0) { const int cb = (d0 * 16 + hi * 8) * 2;
        const bf16x8 b0 = *reinterpret_cast<const bf16x8*>(Ks + KSWZ(r32, cb));
        const bf16x8 b1 = *reinterpret_cast<const bf16x8*>(Ks + KSWZ(32 + r32, cb));
        p0 = __builtin_amdgcn_mfma_f32_32x32x16_bf16(b0, qr[d0], p0, 0, 0, 0);
        p1 = __builtin_amdgcn_mfma_f32_32x32x16_bf16(b1, qr[d0], p1, 0, 0, 0); }
}
__device__ __forceinline__ int v_st(int k, int c) { const int kk = (k & ~0xC) | ((k & 4) << 1) | ((k & 8) >> 1); return ((kk >> 3) * 2 + (c >> 5)) * 512 + ((kk & 7) * 32 + (c & 31)) * 2; }
__device__ __forceinline__ int v_rd_base(int lane) { return ((lane & 3) << 3) | (((lane >> 2) & 3) << 6) | (((lane >> 4) & 1) << 5) | (((lane >> 5) & 1) << 8); }
constexpr int v_rd_off(int d0, int ks, int half) { return d0 * 512 + ks * 2048 + half * 1024; }
template <int OFF> __device__ __forceinline__ s16x4 tr_read(int vb) { s16x4 r; asm volatile("ds_read_b64_tr_b16 %0, %1 offset:%2" : "=&v"(r) : "v"(vb), "i"(OFF) : "memory"); return r; }
template <int D0> __device__ __forceinline__ void pv_one(f32x16& od, int vb, bf16x8 pa0, bf16x8 pa1, bf16x8 pa2, bf16x8 pa3) {
    const s16x4 l0 = tr_read<v_rd_off(D0, 0, 0)>(vb), h0 = tr_read<v_rd_off(D0, 0, 1)>(vb), l1 = tr_read<v_rd_off(D0, 1, 0)>(vb), h1 = tr_read<v_rd_off(D0, 1, 1)>(vb);
    const s16x4 l2 = tr_read<v_rd_off(D0, 2, 0)>(vb), h2 = tr_read<v_rd_off(D0, 2, 1)>(vb), l3 = tr_read<v_rd_off(D0, 3, 0)>(vb), h3 = tr_read<v_rd_off(D0, 3, 1)>(vb);
    asm volatile("s_waitcnt lgkmcnt(0)" ::: "memory"); SBAR();
#define PK(L, H) (bf16x8){L[0], L[1], L[2], L[3], H[0], H[1], H[2], H[3]}
    od = __builtin_amdgcn_mfma_f32_32x32x16_bf16(pa0, PK(l0, h0), od, 0, 0, 0);
    od = __builtin_amdgcn_mfma_f32_32x32x16_bf16(pa1, PK(l1, h1), od, 0, 0, 0);
    od = __builtin_amdgcn_mfma_f32_32x32x16_bf16(pa2, PK(l2, h2), od, 0, 0, 0);
    od = __builtin_amdgcn_mfma_f32_32x32x16_bf16(pa3, PK(l3, h3), od, 0, 0, 0);
#undef PK
}
__device__ __forceinline__ void pv_d0(f32x16* o, int vb, bf16x8 pa0, bf16x8 pa1, bf16x8 pa2, bf16x8 pa3) { pv_one<0>(o[0], vb, pa0, pa1, pa2, pa3); pv_one<1>(o[1], vb, pa0, pa1, pa2, pa3); }

__device__ __forceinline__ void attn_unit(const bf16* __restrict__ Qb, const bf16* __restrict__ Kh, const bf16* __restrict__ KRb, const bf16* __restrict__ Vh, bf16* __restrict__ Ob, int NT, char* lds) {
    const int tid = lv(threadIdx.x), wid = tid >> 6, lane = tid & 63, r32 = lane & 31, hi = lane >> 5;
    char* V_lds = lds; char* K_lds = lds + 2 * SHM_V;
    float* ws = (float*)(lds + 2 * SHM_V + 2 * SHM_K) + wid * 64; float* li_l = ws; float* al_l = ws + 32;
    float m_reg = 0.f, l_reg = 0; f32x16 o[2] = {}; bf16x8 qr[6]; f32x16 negm = {}; f32x16 negbig; _Pragma("unroll") for (int r = 0; r < 16; ++r) negbig[r] = -1e30f;
    const bf16* Qw = Qb + (long)(wid * QBLK + r32) * 96 + hi * 8;
#pragma unroll
    for (int d0 = 0; d0 < 6; ++d0) qr[d0] = *reinterpret_cast<const bf16x8*>(Qw + d0 * 16);
    const int sr = tid >> 4, kc = tid & 15; const bool kact = kc < 12;
    const bf16* ksrc = (kc < 8) ? (Kh + kc * 8) : (KRb + (kc - 8) * 8); const int kstr = (kc < 8) ? 64 : 32;
    const int vr = tid >> 3, vc = (tid & 7) * 8; const int vst = v_st(vr, vc);
    const int kw0 = KSWZ(sr, kc * 16), kw1 = KSWZ(32 + sr, kc * 16);
    const int vb0 = (int)(uintptr_t)V_lds + v_rd_base(lane);
    struct { bf16x8 vs, ks0, ks1; } sr_[2];
#define SLOAD(i, k0) do { sr_[i].vs = *reinterpret_cast<const bf16x8*>(Vh + (long)((k0) + vr) * 64 + vc); \
    if (kact) { sr_[i].ks0 = *reinterpret_cast<const bf16x8*>(ksrc + (long)((k0) + sr) * kstr); sr_[i].ks1 = *reinterpret_cast<const bf16x8*>(ksrc + (long)((k0) + 32 + sr) * kstr); } } while (0)
#define SWRITE(b, i) do { *(bf16x8*)(V_lds + (b) * SHM_V + vst) = sr_[i].vs; \
    if (kact) { *(bf16x8*)(K_lds + (b) * SHM_K + kw0) = sr_[i].ks0; *(bf16x8*)(K_lds + (b) * SHM_K + kw1) = sr_[i].ks1; } } while (0)
#define SWAIT() asm volatile("s_waitcnt vmcnt(3)" ::: "memory")
#define RESC(a) do { if (__any((a) < 1.f)) { if (hi == 0) al_l[r32] = (a); asm volatile("s_waitcnt lgkmcnt(0)" ::: "memory"); \
    _Pragma("unroll") for (int d = 0; d < 2; ++d) _Pragma("unroll") for (int r = 0; r < 16; ++r) o[d][r] *= al_l[crow(r, hi)]; } } while (0)
#define MASKED(t) ((t) - (NT - 4) > wq)
#define CIN(t) (MASKED(t) ? negbig : negm)
    f32x16 pA0, pA1, pB0, pB1; float alA, alB; bf16x8 pa0, pa1, pa2, pa3; const int wq = __builtin_amdgcn_readfirstlane(wid >> 1);
    sr_[0].ks0 = bf16x8{}; sr_[0].ks1 = bf16x8{}; sr_[1].ks0 = bf16x8{}; sr_[1].ks1 = bf16x8{};
    SLOAD(0, 0); asm volatile("s_waitcnt vmcnt(0)" ::: "memory"); SWRITE(0, 0); __syncthreads();
    qkt(pA0, pA1, K_lds, qr, r32, hi, negm); partialSM(pA0, pA1, m_reg, negm, alA);
    SLOAD(1, KVBLK); if (2 < NT) SLOAD(0, 2 * KVBLK);
    SWAIT(); SWRITE(1, 1); __syncthreads();
#define BODY(j, CINB, CINA) do { \
        SBAR(); qkt(pB0, pB1, K_lds + SHM_K, qr, r32, hi, CINB); \
        finishSM(pA0, pA1, alA, l_reg, pa0, pa1, pa2, pa3); SBAR(); \
        SLOAD(1, ((j) + 2) * KVBLK); SBAR(); \
        pv_d0(o, vb0, pa0, pa1, pa2, pa3); partialSM(pB0, pB1, m_reg, negm, alB); \
        __syncthreads(); SWAIT(); SWRITE(0, 0); \
        RESC(alB); __syncthreads(); \
        SBAR(); qkt(pA0, pA1, K_lds, qr, r32, hi, CINA); \
        finishSM(pB0, pB1, alB, l_reg, pa0, pa1, pa2, pa3); SBAR(); \
        if ((j) + 3 < NT) SLOAD(0, ((j) + 3) * KVBLK); SBAR(); \
        pv_d0(o, vb0 + SHM_V, pa0, pa1, pa2, pa3); partialSM(pA0, pA1, m_reg, negm, alA); \
        __syncthreads(); SWAIT(); SWRITE(1, 1); \
        RESC(alA); __syncthreads(); } while (0)
    int j = 1;
    for (; j + 5 < NT; j += 2) BODY(j, negm, negm);
    for (; j + 1 < NT; j += 2) BODY(j, CIN(j), CIN(j + 1));
#undef BODY
    SBAR(); qkt(pB0, pB1, K_lds + SHM_K, qr, r32, hi, CIN(NT - 1));
    finishSM(pA0, pA1, alA, l_reg, pa0, pa1, pa2, pa3); SBAR();
    pv_d0(o, vb0, pa0, pa1, pa2, pa3); partialSM(pB0, pB1, m_reg, negm, alB);
    __syncthreads(); RESC(alB);
    finishSM(pB0, pB1, alB, l_reg, pa0, pa1, pa2, pa3); SBAR();
    pv_d0(o, vb0 + SHM_V, pa0, pa1, pa2, pa3);
    if (hi == 0) li_l[r32] = l_reg; asm volatile("s_waitcnt lgkmcnt(0)" ::: "memory");
    float rli[16];
#pragma unroll
    for (int r = 0; r < 16; ++r) rli[r] = __builtin_amdgcn_rcpf(li_l[crow(r, hi)]);
    bf16* Ow = Ob + (long)(wid * QBLK) * 1024;
#pragma unroll
    for (int r = 0; r < 16; ++r) { const int orow = crow(r, hi);
#pragma unroll
        for (int d0 = 0; d0 < 2; ++d0) Ow[(long)orow * 1024 + d0 * 32 + r32] = (bf16)f2bf(o[d0][r] * rli[r]); }
    asm volatile("s_waitcnt vmcnt(0)" ::: "memory");
    __syncthreads();
#undef SLOAD
#undef SWRITE
#undef SWAIT
#undef RESC
#undef MASKED
#undef CIN
}
#undef KSWZ
#undef SBAR
}

__device__ __forceinline__ void attn_phase(KArgs a, unsigned char* lds, int G_) { const int G = lsi(G_);
    const int bx = lsi(blockIdx.x); const int vcu = (G % 8 == 0) ? (bx % 8) * (G / 8) + bx / 8 : bx;
    const bf16* QB = (const bf16*)(a->ws + WS_QB); const bf16* KB = (const bf16*)(a->ws + WS_KB); const bf16* VB = (const bf16*)(a->ws + WS_VB);
    const bf16* KR = (const bf16*)(a->ws + WS_KR); bf16* OB = (bf16*)(a->ws + WS_OB);
    for (int p = vcu; p < 1024; p += G) { const int bh = p >> 3, s = p & 7, b = bh >> 4, h = bh & 15;
        for (int half = 0; half < 2; ++half) { const int qb = half ? 15 - s : s;
            att::attn_unit(QB + ((size_t)bh * SEQ + qb * 256) * 96, KB + (size_t)bh * SEQ * 64, KR + (size_t)b * SEQ * 32, VB + (size_t)bh * SEQ * 64,
                           OB + ((size_t)b * SEQ + qb * 256) * 1024 + h * 64, 4 * (qb + 1), (char*)lds); } }
}

#define LAS __attribute__((address_space(3)))
#define XB_TMO      128
#define XB_XCNT(j)  (256  + 64 * (j))
#define XB_XSUB(j)  (1280 + 64 * (j))
#define XB_XGEN(j)  (2304 + 64 * (j))
#define XB_TOP      3328
#define XB_TOPGEN   3392
#define XCD_BAR_WORDS 3456
#define XB_SPIN_CAP (1u << 18)

__device__ __forceinline__ unsigned xb_ld(unsigned* p)              { return __hip_atomic_load(p, __ATOMIC_RELAXED, __HIP_MEMORY_SCOPE_AGENT); }
__device__ __forceinline__ unsigned xb_add(unsigned* p, unsigned v) { return __hip_atomic_fetch_add(p, v, __ATOMIC_RELAXED, __HIP_MEMORY_SCOPE_AGENT); }
__device__ __forceinline__ unsigned xb_xcc_id() { return (unsigned)__builtin_amdgcn_s_getreg((3 << 11) | 20) & 0xFu; }
#define XB_SPIN(cond, bar) do { unsigned _sp = 0; while (cond) { __builtin_amdgcn_s_sleep(1); \
    if ((++_sp & 255u) == 0u) { if (xb_ld(&(bar)[XB_TMO])) break; if (_sp > XB_SPIN_CAP) { atomicAdd(&(bar)[XB_TMO], 1u); break; } } } } while (0)

struct XcdBarrier {
    unsigned* bar; unsigned x;
    volatile LAS unsigned* st;
};

__device__ __forceinline__ XcdBarrier xcd_barrier_post(unsigned* bar, volatile LAS unsigned* st) {
    XcdBarrier b; b.bar = bar; b.x = xb_xcc_id(); b.st = st;
    if (threadIdx.x == 0) (void)xb_add(&bar[XB_XCNT(b.x)], 1u);
    return b;
}
__device__ __forceinline__ void xcd_barrier_complete(unsigned* bar, unsigned x, unsigned& nloc, unsigned& nx) {
    const unsigned G = gridDim.x * gridDim.y * gridDim.z;
    unsigned sum, cnt, mine, sp = 0u;
    for (;;) {
        sum = 0u; cnt = 0u; mine = 0u;
#pragma unroll
        for (unsigned j = 0; j < 16; ++j) { const unsigned c = xb_ld(&bar[XB_XCNT(j)]); sum += c; cnt += (c > 0u) ? 1u : 0u; mine = (j == x) ? c : mine; }
        if (sum == G) break;
        __builtin_amdgcn_s_sleep(1);
        if ((++sp & 255u) == 0u) { if (xb_ld(&bar[XB_TMO])) break; if (sp > XB_SPIN_CAP) { atomicAdd(&bar[XB_TMO], 1u); break; } }
    }
    nloc = mine > 0u ? mine : 1u; nx = cnt > 0u ? cnt : 1u;
}

__device__ __forceinline__ void xcd_barrier(const XcdBarrier& b) {
    asm volatile("s_waitcnt vmcnt(0)" ::: "memory");
    __syncthreads();
    if (threadIdx.x == 0) {
        unsigned* bar = b.bar;
        __builtin_amdgcn_s_waitcnt(0);
        unsigned nloc = b.st[0], nx = b.st[1];
        if (nloc == 0u) { xcd_barrier_complete(bar, b.x, nloc, nx); b.st[0] = nloc; b.st[1] = nx; }
        const unsigned old = xb_add(&bar[XB_XSUB(b.x)], 1u);
        const unsigned gen = old / nloc;
        if (old + 1u == (gen + 1u) * nloc) {
            __builtin_amdgcn_fence(__ATOMIC_RELEASE, "agent");
            asm volatile("s_waitcnt vmcnt(0)" ::: "memory");
            const unsigned og = xb_add(&bar[XB_TOP], 1u);
            const unsigned tg = og / nx;
            if (og + 1u == (tg + 1u) * nx) xb_add(&bar[XB_TOPGEN], 1u);
            else XB_SPIN(xb_ld(&bar[XB_TOPGEN]) == tg, bar);
            __builtin_amdgcn_fence(__ATOMIC_ACQUIRE, "agent");
            xb_add(&bar[XB_XGEN(b.x)], 1u);
            asm volatile("s_waitcnt vmcnt(0)" ::: "memory");
        } else {
            XB_SPIN(xb_ld(&bar[XB_XGEN(b.x)]) == gen, bar);
            __builtin_amdgcn_fence(__ATOMIC_ACQUIRE, "agent");
            asm volatile("s_waitcnt vmcnt(0)" ::: "memory");
        }
    }
    __syncthreads();
}

__global__ void __launch_bounds__(512, 2) yoco_fwd(Args a_unused) {
    extern __shared__ __attribute__((aligned(16))) unsigned char lds[];
    cg::grid_group grid = cg::this_grid();
    KArgs a0 = kargs();
    volatile LAS unsigned* MISC = (volatile LAS unsigned*)((LAS unsigned char*)lds + 131072 + 320);
    if (threadIdx.x < 32) MISC[threadIdx.x] = 0u;
    __syncthreads();
    XcdBarrier xbar = xcd_barrier_post((unsigned*)(a0->ws) + 4096, MISC + 8);
    const int G = gridDim.x, lo = a0->ph_lo, hi = a0->ph_hi;
    PG8_LAS unsigned char* ldsl = (PG8_LAS unsigned char*)lds;
#define WSL() KArgs a = kargs(); unsigned char* ws = a->ws; float* xo = a->out; const float* ada = (const float*)(ws + WS_ADA) + (size_t)l * 8 * 6144; const float* xin = (l == 0) ? a->in[0] : xo; (void)ada; (void)xin; (void)xo; const int Gl = lsi(G), bxl = lsi((int)blockIdx.x); (void)Gl; (void)bxl
#ifndef REP_ATT
#define REP_ATT 1
#endif
#ifndef REP_UP
#define REP_UP 1
#endif
#ifndef REP_NORM
#define REP_NORM 1
#endif
#ifndef REP_SYNC
#define REP_SYNC 1
#endif
#ifndef REP_S5
#define REP_S5 1
#endif
#ifndef REP_PROJ
#define REP_PROJ 1
#endif
#ifndef REP_RES
#define REP_RES 1
#endif
#ifndef REP_KL
#define REP_KL 0
#endif
#ifndef REP_P0
#define REP_P0 1
#endif
#define IN(k) (lo <= (k) && (k) < hi)
#define SEAM(k) do { if (IN(k) && IN((k) + 1)) for (int rep_ = 0; rep_ < REP_SYNC; ++rep_) { if (a0->coop == 2) grid.sync(); xcd_barrier(xbar); } } while (0)
    if (IN(0)) for (int rep = 0; rep < REP_P0; ++rep) { phase0(kargs(), lds, G); __syncthreads(); }
    SEAM(0);
    for (int l = 0; l < 4; ++l) {
        const int pb = 1 + 8 * l;
        if (l < 2) {
            if (IN(pb + 0)) for (int rep = 0; rep < REP_NORM; ++rep) { WSL(); s5_norm_phase(a, l, xin, lds, G); }
            SEAM(pb + 0);
            if (IN(pb + 1)) for (int rep = 0; rep < REP_S5; ++rep) { WSL(); pg8::Gemm g{(const bf16*)(ws + WS_AUG), (const bf16*)(ws + WS_S5WE) + (size_t)l * 64 * 256 * 256, 64 * 2048, 256, 256, AUGK, 256};
                GroupOrder S{Gl, bxl}; EpiE E{(float*)(ws + WS_EBUF)};
                pg8::gemm_phase<EpiE, GroupOrder, true, true>(ldsl, g, S, E); }
            if (IN(pb + 1)) { asm volatile("s_waitcnt vmcnt(0)" ::: "memory"); __syncthreads(); carry_phase(kargs(), l, G); asm volatile("s_waitcnt vmcnt(0)" ::: "memory"); __syncthreads(); }
            if (IN(pb + 1)) for (int rep = 0; rep < REP_S5; ++rep) { WSL(); pg8::Gemm g{(const bf16*)(ws + WS_AUG), (const bf16*)(ws + WS_S5WT) + (size_t)l * 64 * 256 * AUGK, 64 * 2048, 256, AUGK, AUGK, AUGK};
                GroupOrder S{Gl, bxl}; EpiY E{(bf16*)(ws + WS_XN)};
                pg8::gemm_phase<EpiY, GroupOrder, true, true>(ldsl, g, S, E); }
            SEAM(pb + 3);
            if (IN(pb + 4)) for (int rep = 0; rep < REP_RES; ++rep) { WSL(); pg8::Gemm g{(const bf16*)(ws + WS_XN), (const bf16*)(ws + WS_WGLU) + (size_t)l * 1024 * 1024, T, 1024, 1024, 1024, 1024};
                pg8::StaticOrder S; S.init(T, 1024, Gl, bxl); EpiGlu E{(const bf16*)(ws + WS_XN), a->in[19] + l * 1024, rep ? (const float*)(ws + 262144) : ada + 2048, rep ? xo : xin, xo};
                pg8::gemm_phase<EpiGlu, pg8::StaticOrder, true, true>(ldsl, g, S, E); }
            SEAM(pb + 4);
        } else {
            const int j = l - 2;
            if (IN(pb + 0)) for (int rep = 0; rep < REP_NORM; ++rep) { WSL(); const float* kva = (const float*)(ws + WS_KVADA);
                norm_phase(xo, a->in[5] + l * 1024, ada, ada + 1024, 6144, (bf16*)(ws + WS_XN), a->in[22], kva, kva + 1024, 2048, (j == 0) ? (bf16*)(ws + WS_XK) : nullptr, G); }
            SEAM(pb + 0);
            if (IN(pb + 1)) { WSL();
                { pg8::Gemm g{(const bf16*)(ws + WS_XN), (const bf16*)(ws + WS_WDQ) + (size_t)j * 256 * 1024, T, 256, 1024, 1024, 1024};
                  pg8::StaticOrder S; S.init(T, 256, Gl, bxl); EpiDq E{(bf16*)(ws + WS_QA), (float*)(ws + WS_QSS) + (size_t)j * T};
                  pg8::gemm_phase<EpiDq, pg8::StaticOrder, true, true>(ldsl, g, S, E); }
                if (j == 0) { pg8::Gemm g{(const bf16*)(ws + WS_XK), (const bf16*)(ws + WS_WKVA), T, 512, 1024, 1024, 1024};
                  pg8::StaticOrder S; S.init(T, 512, Gl, bxl); EpiKva E{(bf16*)(ws + WS_CKV), (float*)(ws + WS_KSS), (bf16*)(ws + WS_KR), a->in[27], (const float*)(ws + WS_COS), (const float*)(ws + WS_SIN)};
                  pg8::gemm_phase<EpiKva, pg8::StaticOrder, true, true>(ldsl, g, S, E); }
            }
            SEAM(pb + 1);
            if (IN(pb + 2)) for (int rep = 0; rep < REP_PROJ; ++rep) { WSL();
                { pg8::Gemm g{(const bf16*)(ws + WS_QA), (const bf16*)(ws + WS_WUQ) + (size_t)j * 1536 * 256, T, 1536, 256, 256, 256};
                  pg8::StaticOrder S; S.init(T, 1536, Gl, bxl);
                  EpiUq E{(const float*)(ws + WS_QSS) + (size_t)j * T, a->in[31] + j * 64, a->in[32] + j * 32, (const float*)(ws + WS_COS), (const float*)(ws + WS_SIN), (bf16*)(ws + WS_QB)};
                  pg8::gemm_phase<EpiUq, pg8::StaticOrder, true, true>(ldsl, g, S, E); }
                if (j == 0) { pg8::Gemm g{(const bf16*)(ws + WS_CKV), (const bf16*)(ws + WS_WKVB), T, 2048, 256, 256, 256};
                  pg8::StaticOrder S; S.init(T, 2048, Gl, bxl); EpiKvb E{(const float*)(ws + WS_KSS), a->in[26], (bf16*)(ws + WS_KB), (bf16*)(ws + WS_VB)};
                  pg8::gemm_phase<EpiKvb, pg8::StaticOrder, true, true>(ldsl, g, S, E); }
            }
            SEAM(pb + 2);
            if (IN(pb + 3)) for (int rep = 0; rep < REP_ATT; ++rep) attn_phase(kargs(), lds, G);
            SEAM(pb + 3);
            if (IN(pb + 4)) for (int rep = 0; rep < REP_RES; ++rep) { WSL(); pg8::Gemm g{(const bf16*)(ws + WS_OB), (const bf16*)(ws + WS_WO) + (size_t)j * 1024 * 1024, T, 1024, 1024, 1024, 1024};
                pg8::StaticOrder S; S.init(T, 1024, Gl, bxl); EpiRes E{rep ? (const float*)(ws + 262144) : ada + 2048, xo};
                pg8::gemm_phase<EpiRes, pg8::StaticOrder, true, true>(ldsl, g, S, E); }
            SEAM(pb + 4);
        }
        if (IN(pb + 5)) for (int rep = 0; rep < REP_NORM; ++rep) { WSL(); norm_phase(xo, a->in[6] + l * 1024, ada + 3072, ada + 4096, 6144, (bf16*)(ws + WS_XN), nullptr, nullptr, nullptr, 0, nullptr, G); }
        SEAM(pb + 5);
        if (IN(pb + 6)) for (int rep = 0; rep < REP_UP; ++rep) { WSL(); pg8::Gemm g{(const bf16*)(ws + WS_XN), (const bf16*)(ws + WS_WGU) + (size_t)l * 5632 * 1024, T, 5632, 1024, 1024, 1024};
            pg8::StaticOrder S; S.init(T, 5632, Gl, bxl); EpiGU E{(bf16*)(ws + WS_HB)};
            pg8::gemm_phase<EpiGU, pg8::StaticOrder, true, true>(ldsl, g, S, E); }
        SEAM(pb + 6);
        if (IN(pb + 7)) for (int rep = 0; rep < REP_RES; ++rep) { WSL(); pg8::Gemm g{(const bf16*)(ws + WS_HB), (const bf16*)(ws + WS_WD) + (size_t)l * 1024 * FF, T, 1024, FF, FF, FF};
            pg8::StaticOrder S; S.init(T, 1024, Gl, bxl); EpiRes E{rep ? (const float*)(ws + 262144) : ada + 5120, xo};
            pg8::gemm_phase<EpiRes, pg8::StaticOrder, true, true>(ldsl, g, S, E); }
        if (IN(pb + 7)) for (int rep = 0; rep < REP_KL; ++rep) { WSL(); pg8::Gemm g{(const bf16*)(ws + WS_HB), (const bf16*)(ws + WS_WD) + (size_t)l * 1024 * FF, T, 1024, FF, FF, FF};
            pg8::StaticOrder S; S.init(T, 1024, Gl, bxl); EpiNone E{(float*)(ws + 262144)};
            pg8::gemm_phase<EpiNone, pg8::StaticOrder, true, true>(ldsl, g, S, E); }
        SEAM(pb + 7);
    }
#undef IN
#undef SEAM
}

#ifndef MK_PER_PHASE
#define MK_PER_PHASE 0
#endif
extern "C" void kernel_launch(void* const* d_in, const int* in_sizes, int n_in, void* d_out, int out_size, void* d_ws, size_t ws_size, hipStream_t stream) {
    static int grid = 0;
    if (grid == 0) {
        if (n_in != 34 || out_size != T * DM || ws_size < WS_END) { fprintf(stderr, "kernel_launch: unexpected shapes (n_in %d out %d ws %zu)\n", n_in, out_size, ws_size); grid = -1; return; }
        int dev = 0, cus = 0, per_cu = 0;
        if (hipGetDevice(&dev) != hipSuccess || hipDeviceGetAttribute(&cus, hipDeviceAttributeMultiprocessorCount, dev) != hipSuccess) { grid = -1; return; }
        if (hipFuncSetAttribute((const void*)yoco_fwd, hipFuncAttributeMaxDynamicSharedMemorySize, LDS_BYTES) != hipSuccess) { fprintf(stderr, "kernel_launch: hipFuncSetAttribute failed\n"); grid = -1; return; }
        if (hipOccupancyMaxActiveBlocksPerMultiprocessor(&per_cu, (const void*)yoco_fwd, 512, LDS_BYTES) != hipSuccess || per_cu < 1) per_cu = 1;
        (void)hipGetLastError();
        grid = cus * per_cu;
    }
    if (grid < 0) return;
    Args ha{};
    for (int i = 0; i < 34; ++i) ha.in[i] = (const float*)d_in[i];
    ha.out = (float*)d_out; ha.ws = (unsigned char*)d_ws;
#if MK_PER_PHASE
    for (int ph = 0; ph < NPHASE; ++ph) { ha.ph_lo = ph; ha.ph_hi = ph + 1; ha.coop = 0;
        hipLaunchKernelGGL(yoco_fwd, dim3(grid), dim3(512), LDS_BYTES, stream, ha); }
#else
    (void)hipMemsetAsync(d_ws, 0, 524288, stream);
    ha.ph_lo = 0; ha.ph_hi = NPHASE; ha.coop = 1;
    void* args[] = {&ha};
    const hipError_t e = hipLaunchCooperativeKernel((const void*)yoco_fwd, dim3(grid), dim3(512), args, LDS_BYTES, stream);
    if (e != hipSuccess) fprintf(stderr, "kernel_launch: cooperative launch failed: %s (grid %d)\n", hipGetErrorString(e), grid);
#endif
}
```

```cpp
#include <hip/hip_runtime.h>
#include <hip/hip_cooperative_groups.h>
#include <cstdio>
#include <cstdint>
namespace cg = cooperative_groups;
namespace pg8 {
#define PG8_LAS __attribute__((address_space(3)))
typedef unsigned short bf16_t;
typedef short bf16x8 __attribute__((ext_vector_type(8)));
typedef float f32x4 __attribute__((ext_vector_type(4)));
typedef unsigned u32x4 __attribute__((ext_vector_type(4)));
constexpr int BM = 256, BK = 64, HALF = 128, HTB = HALF * BK * 2  , STAGE_BYTES = 8 * HTB, NXCD = 8, WGM = 8;

__host__ __device__ __forceinline__ int lds_byte(int r, int c) { const int st = (r >> 4) * 2 + (c >> 5), rr = r & 15, cc = c & 31, ob = rr * 64 + cc * 2; return st * 1024 + (ob ^ (((ob >> 9) & 1) << 5)); }
__host__ __device__ __forceinline__ void stage_rc(int b, int& R, int& C) { const int st = b / 1024, sb = b % 1024, swz = sb ^ (((sb >> 9) & 1) << 5); R = (st >> 1) * 16 + swz / 64; C = (st & 1) * 32 + (swz % 64) / 2; }
__host__ __device__ __forceinline__ int perm32(int rho) { const int n = rho >> 4, i = rho & 15; return 8 * (i >> 2) + 4 * n + (i & 3); }

struct Unit { int pm, pn; };
struct Gemm { const bf16_t* A; const bf16_t* Bt; int M, N, K, lda, ldb; };

struct StaticOrder {
    int nM, nN, nwg, G, c;
    __host__ __device__ void init(int M, int N, int G_, int c_) { nM = M / BM; nN = N / BM; nwg = nM * nN; G = G_; c = c_; }
    __host__ __device__ bool next(int i, Unit& u) const {
        const long L = (long)i * G + c; if (L >= nwg) return false;
        int wgid = (int)L; { const int q = nwg / NXCD, r = nwg % NXCD, xcd = wgid % NXCD, off = wgid / NXCD; wgid = (xcd < r ? xcd * (q + 1) : r * (q + 1) + (xcd - r) * q) + off; }
        const int nig = WGM * nN, gid = wgid / nig, fm = gid * WGM, gsz = (nM - fm) < WGM ? (nM - fm) : WGM;
        u.pm = fm + ((wgid % nig) % gsz); u.pn = (wgid % nig) / gsz; return true;
    }
    __device__ __forceinline__ void a_ready(const Unit&) const {}
    __device__ __forceinline__ void done(const Unit&) const {}
};

__device__ __forceinline__ unsigned cvt_pk_bf16(float lo, float hi) { unsigned r; asm volatile("v_cvt_pk_bf16_f32 %0, %1, %2" : "=v"(r) : "v"(lo), "v"(hi)); return r; }
typedef float f32x2 __attribute__((ext_vector_type(2)));
template <class Epi, class Sched, bool ALIGN_EPI = false, bool SP2 = false>
__device__ __forceinline__ void gemm_phase(PG8_LAS unsigned char* lds, const Gemm g, const Sched& S, const Epi& E) {
    int tid_l = threadIdx.x; asm volatile("" : "+v"(tid_l)); const int tid = tid_l, wid = __builtin_amdgcn_readfirstlane(tid >> 6), lane = tid & 63, wr = wid >> 2, wc = wid & 3, fr = lane & 15, fq = lane >> 4;
    int K_l = g.K; asm volatile("" : "+s"(K_l)); const int K = K_l, nt = K / BK;
    unsigned voffA[2], voffB[2];
#pragma unroll
    for (int i = 0; i < 2; ++i) { int R, C; stage_rc(tid * 16 + i * 8192, R, C); const int Rb = Epi::PERM ? ((R & ~31) + perm32(R & 31)) : R;
        voffA[i] = (unsigned)(R * g.lda + C) * 2u; voffB[i] = (unsigned)(Rb * g.ldb + C) * 2u; }
    const size_t kstep = (size_t)(BK * 2);
    const size_t hstepA = (size_t)HALF * g.lda * 2, hstepB = (size_t)HALF * g.ldb * 2;
    const size_t tstepA = 2 * hstepA, tstepB = 2 * hstepB;
    const unsigned ldsw = (unsigned)wid * 1024u;
    const int aoff = lds_byte(wr * 64 + fr, fq * 8), boff = lds_byte(wc * 32 + fr, fq * 8);
#define PG8_SA(b, h) (((b) * 2 + (h)) * HTB)
#define PG8_SB(b, h) ((4 + (b) * 2 + (h)) * HTB)
#define PG8_STAGE(bufoff, gbase, voff) do { _Pragma("unroll") for (int _i = 0; _i < 2; ++_i) \
        __builtin_amdgcn_global_load_lds((const unsigned*)((const char*)(gbase) + (voff)[_i]), (PG8_LAS unsigned*)(lds + (bufoff) + ldsw + _i * 8192), 16, 0, 0); } while (0)
#define PG8_LDA(dst, b, h) do { _Pragma("unroll") for (int m = 0; m < 4; ++m) _Pragma("unroll") for (int k = 0; k < 2; ++k) dst[m][k] = *(const PG8_LAS bf16x8*)(lds + PG8_SA(b, h) + aoff + m * 2048 + k * 1024); } while (0)
#define PG8_LDB(dst, b, h) do { _Pragma("unroll") for (int n = 0; n < 2; ++n) _Pragma("unroll") for (int k = 0; k < 2; ++k) dst[n][k] = *(const PG8_LAS bf16x8*)(lds + PG8_SB(b, h) + boff + n * 2048 + k * 1024); } while (0)
#define PG8_MMA(ai, bj, At, Bt) do { __builtin_amdgcn_s_setprio(1); _Pragma("unroll") for (int m = 0; m < 4; ++m) _Pragma("unroll") for (int n = 0; n < 2; ++n) _Pragma("unroll") for (int k = 0; k < 2; ++k) \
        acc[ai][bj][m][n] = __builtin_amdgcn_mfma_f32_16x16x32_bf16(Bt[n][k], At[m][k], acc[ai][bj][m][n], 0, 0, 0); __builtin_amdgcn_s_setprio(0); } while (0)
#define PG8_WAIT_V(n) asm volatile("s_waitcnt vmcnt(" #n ")" ::: "memory")
#define PG8_WAIT_L(n) asm volatile("s_waitcnt lgkmcnt(" #n ")" ::: "memory")
#define PG8_BAR __builtin_amdgcn_s_barrier()
#define PG8_SCHED __builtin_amdgcn_sched_barrier(0)
    Unit cur, nxt; int ui = 0;
    if (!S.next(0, cur)) return;
    f32x4 acc[2][2][4][2];
#pragma unroll
    for (int a = 0; a < 2; ++a)
#pragma unroll
        for (int b = 0; b < 2; ++b)
#pragma unroll
            for (int m = 0; m < 4; ++m)
#pragma unroll
                for (int n = 0; n < 2; ++n) acc[a][b][m][n] = (f32x4){0.f, 0.f, 0.f, 0.f};
    bf16x8 At[4][2], B0[2][2], B1[2][2];
    const char* cA = (const char*)g.A + (size_t)cur.pm * tstepA; const char* cB = (const char*)g.Bt + (size_t)cur.pn * tstepB;
    S.a_ready(cur);
    if constexpr (SP2) {
        PG8_STAGE(PG8_SB(0, 0), cB, voffB); PG8_STAGE(PG8_SB(0, 1), cB + hstepB, voffB); PG8_STAGE(PG8_SA(0, 0), cA, voffA); PG8_STAGE(PG8_SA(0, 1), cA + hstepA, voffA);
        if (wr == 1) PG8_BAR;
        PG8_WAIT_V(2); PG8_BAR;
        PG8_STAGE(PG8_SB(1, 0), cB + kstep, voffB); PG8_STAGE(PG8_SA(1, 0), cA + kstep, voffA); PG8_STAGE(PG8_SB(1, 1), cB + hstepB + kstep, voffB);
        PG8_WAIT_V(6); PG8_BAR;
    } else {
        PG8_STAGE(PG8_SB(0, 0), cB, voffB); PG8_STAGE(PG8_SA(0, 0), cA, voffA); PG8_STAGE(PG8_SB(0, 1), cB + hstepB, voffB); PG8_STAGE(PG8_SA(0, 1), cA + hstepA, voffA);
        if (wr == 1) PG8_BAR;
        PG8_WAIT_V(4); PG8_BAR;
        PG8_STAGE(PG8_SB(1, 0), cB + kstep, voffB); PG8_STAGE(PG8_SA(1, 0), cA + kstep, voffA); PG8_STAGE(PG8_SB(1, 1), cB + hstepB + kstep, voffB);
        PG8_WAIT_V(6); PG8_BAR;
    }
    for (;;) {
        const bool has_next = S.next(ui + 1, nxt);
        const char* nA = has_next ? (const char*)g.A + (size_t)nxt.pm * tstepA : cA; const char* nB = has_next ? (const char*)g.Bt + (size_t)nxt.pn * tstepB : cB;
        for (int t = 0; t < nt; t += 2) {
            const bool last = (t == nt - 2);
            const char* a1 = cA + (size_t)(t + 1) * kstep;
            const char* a2 = last ? nA : cA + (size_t)(t + 2) * kstep; const char* b2 = last ? nB : cB + (size_t)(t + 2) * kstep;
            const char* a3 = a2 + kstep; const char* b3 = b2 + kstep;
            if (last && has_next) S.a_ready(nxt);
            if constexpr (SP2) {
            PG8_LDB(B0, 0, 0); PG8_LDB(B1, 0, 1); PG8_SCHED; PG8_LDA(At, 0, 0); PG8_STAGE(PG8_SA(1, 1), a1 + hstepA, voffA);
            PG8_WAIT_V(8); PG8_WAIT_L(0); PG8_BAR; PG8_MMA(0, 0, At, B0); PG8_MMA(0, 1, At, B1); PG8_BAR; PG8_SCHED;
            PG8_LDA(At, 0, 1); PG8_STAGE(PG8_SB(0, 0), b2, voffB); PG8_STAGE(PG8_SB(0, 1), b2 + hstepB, voffB); PG8_STAGE(PG8_SA(0, 0), a2, voffA);
            PG8_WAIT_V(8); PG8_WAIT_L(0); PG8_BAR; PG8_MMA(1, 0, At, B0); PG8_MMA(1, 1, At, B1); PG8_BAR; PG8_SCHED;
            PG8_LDB(B0, 1, 0); PG8_LDB(B1, 1, 1); PG8_SCHED; PG8_LDA(At, 1, 0); PG8_STAGE(PG8_SA(0, 1), a2 + hstepA, voffA);
            PG8_WAIT_V(8); PG8_WAIT_L(0); PG8_BAR; PG8_MMA(0, 0, At, B0); PG8_MMA(0, 1, At, B1); PG8_BAR; PG8_SCHED;
            PG8_LDA(At, 1, 1); PG8_STAGE(PG8_SB(1, 0), b3, voffB); PG8_STAGE(PG8_SB(1, 1), b3 + hstepB, voffB); PG8_STAGE(PG8_SA(1, 0), a3, voffA);
            PG8_WAIT_V(8); PG8_WAIT_L(0); PG8_BAR; PG8_MMA(1, 0, At, B0); PG8_MMA(1, 1, At, B1); PG8_BAR; PG8_SCHED;
            } else {
            PG8_LDB(B0, 0, 0); PG8_SCHED; PG8_LDA(At, 0, 0); PG8_STAGE(PG8_SA(1, 1), a1 + hstepA, voffA);
            PG8_WAIT_L(8); PG8_BAR; PG8_WAIT_L(0); PG8_MMA(0, 0, At, B0); PG8_BAR; PG8_SCHED;
            PG8_LDB(B1, 0, 1); PG8_STAGE(PG8_SB(0, 0), b2, voffB);
            PG8_BAR; PG8_WAIT_L(0); PG8_MMA(0, 1, At, B1); PG8_BAR;
            PG8_LDA(At, 0, 1); PG8_STAGE(PG8_SA(0, 0), a2, voffA);
            PG8_BAR; PG8_WAIT_L(0); PG8_MMA(1, 0, At, B0); PG8_BAR; PG8_SCHED;
            PG8_STAGE(PG8_SB(0, 1), b2 + hstepB, voffB);
            PG8_WAIT_V(6); PG8_BAR; PG8_MMA(1, 1, At, B1); PG8_BAR;
            PG8_LDB(B0, 1, 0); PG8_SCHED; PG8_LDA(At, 1, 0); PG8_STAGE(PG8_SA(0, 1), a2 + hstepA, voffA);
            PG8_WAIT_L(8); PG8_BAR; PG8_WAIT_L(0); PG8_MMA(0, 0, At, B0); PG8_BAR; PG8_SCHED;
            PG8_LDB(B1, 1, 1); PG8_STAGE(PG8_SB(1, 0), b3, voffB);
            PG8_BAR; PG8_WAIT_L(0); PG8_MMA(0, 1, At, B1); PG8_BAR;
            PG8_LDA(At, 1, 1); PG8_STAGE(PG8_SA(1, 0), a3, voffA);
            PG8_BAR; PG8_WAIT_L(0); PG8_MMA(1, 0, At, B0); PG8_BAR; PG8_SCHED;
            PG8_STAGE(PG8_SB(1, 1), b3 + hstepB, voffB);
            PG8_WAIT_V(6); PG8_BAR; PG8_MMA(1, 1, At, B1); PG8_BAR;
            }
        }
        if constexpr (ALIGN_EPI) { if (wr == 0) PG8_BAR; }
        if constexpr (!Epi::AFTER_DRAIN) { E(acc, cur, wr, wc, fr, fq); S.done(cur); }
        if (!has_next) break;
#pragma unroll
        for (int a = 0; a < 2; ++a)
#pragma unroll
            for (int b = 0; b < 2; ++b)
#pragma unroll
                for (int m = 0; m < 4; ++m)
#pragma unroll
                    for (int n = 0; n < 2; ++n) acc[a][b][m][n] = (f32x4){0.f, 0.f, 0.f, 0.f};
        cur = nxt; cA = nA; cB = nB; ++ui;
        if constexpr (ALIGN_EPI) { if (wr == 1) PG8_BAR; }
    }
    PG8_WAIT_V(0);
    if constexpr (!ALIGN_EPI) { if (wr == 0) PG8_BAR; }
    PG8_BAR;
    if constexpr (Epi::AFTER_DRAIN) { E.fused(acc, cur, wr, wc, fr, fq, lds, wid, lane); S.done(cur); }
#undef PG8_SA
#undef PG8_SB
#undef PG8_STAGE
#undef PG8_LDA
#undef PG8_LDB
#undef PG8_MMA
#undef PG8_WAIT_V
#undef PG8_WAIT_L
#undef PG8_BAR
#undef PG8_SCHED
}
}

constexpr int NB = 8, SEQ = 4096, DM = 1024, T = NB * SEQ, FF = 2816, NH = 16;
constexpr int SUB = 16, NSUB = SEQ / SUB, AUGK = 384;
constexpr float EPS = 1e-6f;
constexpr size_t MiB = 1u << 20;
constexpr size_t WS_ADA = 1 * MiB;
constexpr size_t WS_KVADA = WS_ADA + 800 * 1024;
constexpr size_t WS_COS = 2 * MiB, WS_SIN = 4 * MiB;
constexpr size_t WS_QSS = 6 * MiB;
constexpr size_t WS_KSS = WS_QSS + 2 * T * 4, WS_A16 = WS_KSS + T * 4;
constexpr size_t WS_KR = 7 * MiB;
constexpr size_t WS_WGU = 10 * MiB;
constexpr size_t WS_WD = WS_WGU + 44 * MiB;
constexpr size_t WS_WGLU = WS_WD + 22 * MiB;
constexpr size_t WS_WDQ = WS_WGLU + 4 * MiB;
constexpr size_t WS_WKVA = WS_WDQ + 1 * MiB;
constexpr size_t WS_WUQ = WS_WKVA + 1 * MiB;
constexpr size_t WS_WKVB = WS_WUQ + 3 * MiB / 2;
constexpr size_t WS_WO = WS_WKVB + 1 * MiB;
constexpr size_t WS_S5WT = 89 * MiB;
constexpr size_t WS_S5WE = WS_S5WT + 24 * MiB;
constexpr size_t WS_CKV = WS_S5WT, WS_QA = WS_S5WT + 16 * MiB;
constexpr size_t WS_XN = 129 * MiB;
constexpr size_t WS_HB = 193 * MiB;
constexpr size_t WS_AUG = WS_HB, WS_EBUF = WS_HB + 96 * MiB;
constexpr size_t WS_QB = WS_HB, WS_XK = WS_HB + 96 * MiB, WS_OB = WS_XK;
constexpr size_t WS_KB = 369 * MiB, WS_VB = 433 * MiB, WS_END = 497 * MiB;
static_assert(WS_WO + 4 * MiB <= WS_S5WT && WS_S5WE + 16 * MiB <= WS_XN, "ws map");

constexpr int LDS_BYTES = 147456;
constexpr int NPHASE = 33;

typedef unsigned short bf16;
typedef unsigned v4u __attribute__((ext_vector_type(4)));
typedef unsigned v2u __attribute__((ext_vector_type(2)));
typedef float f32x4 __attribute__((ext_vector_type(4)));
typedef float f32x2 __attribute__((ext_vector_type(2)));

__device__ __forceinline__ unsigned f2bf(float f) { unsigned u = __builtin_bit_cast(unsigned, f); return (u + 0x7fffu + ((u >> 16) & 1u)) >> 16; }
__device__ __forceinline__ unsigned pk2(float lo, float hi) { return f2bf(lo) | (f2bf(hi) << 16); }
__device__ __forceinline__ float bflo(unsigned w) { return __builtin_bit_cast(float, w << 16); }
__device__ __forceinline__ float bfhi(unsigned w) { return __builtin_bit_cast(float, w & 0xffff0000u); }
__device__ __forceinline__ float shx(float v, int lane, int o) { return __builtin_bit_cast(float, __builtin_amdgcn_ds_bpermute((lane ^ o) << 2, __builtin_bit_cast(int, v))); }
__device__ __forceinline__ float wave_sum(float v, int lane) {
#pragma unroll
    for (int o = 1; o < 64; o <<= 1) v += shx(v, lane, o);
    return v;
}
__device__ __forceinline__ float sigm(float z) { return __builtin_amdgcn_rcpf(1.f + __expf(-z)); }
__device__ __forceinline__ float gelu_tanh(float x) { const float u = 0.7978845608028654f * (x + 0.044715f * x * x * x); return x * __builtin_amdgcn_rcpf(1.f + __expf(-2.f * u)); }
__device__ __forceinline__ f32x2 cmul(f32x2 a, f32x2 b) { return (f32x2){a.x * b.x - a.y * b.y, a.x * b.y + a.y * b.x}; }
__device__ __forceinline__ void dsincos(double x, double& s, double& c) {
    const double q = __builtin_rint(x * 0.63661977236758134308);
    double r = __builtin_fma(-q, 1.57079632679489655800, x); r = __builtin_fma(-q, 6.12323399573676603587e-17, r);
    const double r2 = r * r;
    double sp = 1.0 / 6227020800.0; sp = -1.0 / 39916800.0 + r2 * sp; sp = 1.0 / 362880.0 + r2 * sp; sp = -1.0 / 5040.0 + r2 * sp; sp = 1.0 / 120.0 + r2 * sp; sp = -1.0 / 6.0 + r2 * sp;
    const double s0 = r + r * r2 * sp;
    double cp = 1.0 / 479001600.0; cp = -1.0 / 3628800.0 + r2 * cp; cp = 1.0 / 40320.0 + r2 * cp; cp = -1.0 / 720.0 + r2 * cp; cp = 1.0 / 24.0 + r2 * cp; cp = -0.5 + r2 * cp;
    const double c0 = 1.0 + r2 * cp;
    const int n = ((int)q) & 3;
    s = (n == 0) ? s0 : (n == 1) ? c0 : (n == 2) ? -s0 : -c0;
    c = (n == 0) ? c0 : (n == 1) ? -s0 : (n == 2) ? -c0 : s0;
}

__device__ __forceinline__ int lv(int v) { asm volatile("" : "+v"(v)); return v; }
__device__ __forceinline__ int lsi(int v) { asm volatile("" : "+s"(v)); return v; }
template <class TP> __device__ __forceinline__ TP* ls(TP* p) { asm volatile("" : "+s"(p)); return p; }
struct Args { const float* in[34]; float* out; unsigned char* ws; int ph_lo, ph_hi, coop, pad; };
typedef const __attribute__((address_space(4))) Args* KArgs;
__device__ __forceinline__ KArgs kargs() { KArgs p = (KArgs)__builtin_amdgcn_kernarg_segment_ptr(); asm volatile("" : "+s"(p)); return p; }

__device__ __forceinline__ void tr_item(const float* W, int ldw, int k0, int n0, bf16* dst, int ldd, const float* kscale, float* scr, int lane) {
#pragma unroll 8
    for (int i = 0; i < 32; ++i) { const int kk = 2 * i + (lane >> 5); float v = W[(size_t)(k0 + kk) * ldw + n0 + (lane & 31)]; if (kscale) v *= kscale[k0 + kk]; scr[kk * 33 + (lane & 31)] = v; }
    const int c = lane & 7;
#pragma unroll
    for (int j = 0; j < 4; ++j) { const int n = (lane >> 3) + 8 * j; const float* s = scr + (8 * c) * 33 + n;
        v4u o; o.x = pk2(s[0 * 33], s[1 * 33]); o.y = pk2(s[2 * 33], s[3 * 33]); o.z = pk2(s[4 * 33], s[5 * 33]); o.w = pk2(s[6 * 33], s[7 * 33]);
        *(v4u*)(dst + (size_t)n * ldd + k0 + 8 * c) = o; }
}

__device__ __forceinline__ void ada_item(KArgs a, int it, float* cact, float* part, int tid) {
    const int lane = tid & 63, wave = tid >> 6;
    const int col0 = it * 128;
    const float* W; const float* bias; float* out; int ldw;
    if (col0 < 4 * 6144) { const int l = col0 / 6144, cc = col0 - l * 6144; W = a->in[3] + (size_t)l * 1024 * 6144 + cc; ldw = 6144; bias = a->in[4] + l * 6144 + cc; out = (float*)(a->ws + WS_ADA) + (size_t)l * 8 * 6144 + cc; }
    else { const int cc = col0 - 4 * 6144; W = a->in[20] + cc; ldw = 2048; bias = a->in[21] + cc; out = (float*)(a->ws + WS_KVADA) + cc; }
    float acc[8][2];
#pragma unroll
    for (int b = 0; b < 8; ++b) { acc[b][0] = 0.f; acc[b][1] = 0.f; }
    const float* wp = W + (size_t)(wave * 128) * ldw + 2 * lane;
    const float* cp = cact + wave * 128 * 8;
#pragma unroll 8
    for (int k = 0; k < 128; ++k) {
        const f32x2 w2 = *(const f32x2*)(wp + (size_t)k * ldw);
        const f32x4 c0 = *(const f32x4*)(cp + k * 8), c1 = *(const f32x4*)(cp + k * 8 + 4);
        acc[0][0] += c0.x * w2.x; acc[0][1] += c0.x * w2.y; acc[1][0] += c0.y * w2.x; acc[1][1] += c0.y * w2.y;
        acc[2][0] += c0.z * w2.x; acc[2][1] += c0.z * w2.y; acc[3][0] += c0.w * w2.x; acc[3][1] += c0.w * w2.y;
        acc[4][0] += c1.x * w2.x; acc[4][1] += c1.x * w2.y; acc[5][0] += c1.y * w2.x; acc[5][1] += c1.y * w2.y;
        acc[6][0] += c1.z * w2.x; acc[6][1] += c1.z * w2.y; acc[7][0] += c1.w * w2.x; acc[7][1] += c1.w * w2.y;
    }
#pragma unroll
    for (int b = 0; b < 8; ++b) *(f32x2*)(part + (wave * 8 + b) * 128 + 2 * lane) = (f32x2){acc[b][0], acc[b][1]};
    __syncthreads();
    for (int o = tid; o < 1024; o += 512) { const int b = o >> 7, col = o & 127; float s = bias[col];
#pragma unroll
        for (int w = 0; w < 8; ++w) s += part[(w * 8 + b) * 128 + col];
        out[(size_t)b * ldw + col] = s; }
    __syncthreads();
}

__device__ __forceinline__ void s5prep_item(KArgs a, int l, int g, unsigned char* sm, int tid) {
    f32x2* apw = (f32x2*)sm;
    f32x2* bbv = (f32x2*)(sm + 8704);
    f32x2* ccv = (f32x2*)(sm + 16896);
    float* Kt = (float*)(sm + 25088);
    f32x2* fv = (f32x2*)(sm + 41472);
    const int lg = l * 64 + g;
    const float* lam_re = a->in[10] + lg * 64; const float* lam_im = a->in[11] + lg * 64;
    const float* b_re = a->in[13] + (size_t)lg * 64 * 16; const float* b_im = a->in[14] + (size_t)lg * 64 * 16;
    const float* c_re = a->in[15] + (size_t)lg * 16 * 64; const float* c_im = a->in[16] + (size_t)lg * 16 * 64;
    const float* dsk = a->in[17] + l * 1024 + g * 16;
    if (tid < 64) {
        const int n = tid; const double dt = exp((double)a->in[12][lg]); const double lr = lam_re[n], li = lam_im[n];
        const double mag = exp(lr * dt); double s, c; dsincos(li * dt, s, c); const double ar = mag * c, ai = mag * s;
        double pr = 1.0, pi = 0.0;
        for (int k = 0; k <= 16; ++k) { apw[k * 64 + n] = (f32x2){(float)pr, (float)pi}; const double tr = pr * ar - pi * ai, ti = pr * ai + pi * ar; pr = tr; pi = ti; }
        ((f32x2*)(a->ws + WS_A16))[lg * 64 + n] = apw[16 * 64 + n];
        const double den = lr * lr + li * li, nr = ar - 1.0, ni = ai;
        fv[n] = (f32x2){(float)((nr * lr + ni * li) / den), (float)((ni * lr - nr * li) / den)};
    }
    __syncthreads();
    for (int i = tid; i < 1024; i += 512) { const int n = i >> 4; bbv[i] = cmul(fv[n], (f32x2){b_re[i], b_im[i]}); ccv[i] = (f32x2){c_re[i], c_im[i]}; }
    __syncthreads();
    { const int lag = tid >> 5, p = (tid >> 1) & 15, qh = tid & 1; float acc[8];
#pragma unroll
        for (int q = 0; q < 8; ++q) acc[q] = 0.f;
        for (int n = 0; n < 64; ++n) { const f32x2 w = cmul(ccv[p * 64 + n], apw[lag * 64 + n]);
#pragma unroll
            for (int q = 0; q < 8; ++q) { const f32x2 bq = bbv[n * 16 + qh * 8 + q]; acc[q] += w.x * bq.x - w.y * bq.y; } }
#pragma unroll
        for (int q = 0; q < 8; ++q) Kt[(lag * 16 + p) * 16 + qh * 8 + q] = acc[q]; }
    __syncthreads();
    bf16* WT = (bf16*)(a->ws + WS_S5WT) + (size_t)lg * 256 * AUGK;
    for (int ch = tid; ch < 256 * 48; ch += 512) { const int row = ch / 48, cc = ch - row * 48, t = row >> 4, p = row & 15; float v[8];
        if (cc < 32) { const int s = cc >> 1, qh = cc & 1;
#pragma unroll
            for (int q = 0; q < 8; ++q) { float x = (s <= t) ? Kt[((t - s) * 16 + p) * 16 + qh * 8 + q] : 0.f; if (s == t && qh * 8 + q == p) x += dsk[p]; v[q] = x; } }
        else { const int n0 = (cc - 32) * 4;
#pragma unroll
            for (int k = 0; k < 4; ++k) { const f32x2 w = cmul(ccv[p * 64 + n0 + k], apw[(t + 1) * 64 + n0 + k]); v[2 * k] = w.x; v[2 * k + 1] = -w.y; } }
        v4u o; o.x = pk2(v[0], v[1]); o.y = pk2(v[2], v[3]); o.z = pk2(v[4], v[5]); o.w = pk2(v[6], v[7]);
        *(v4u*)(WT + (size_t)row * AUGK + cc * 8) = o; }
    bf16* WE = (bf16*)(a->ws + WS_S5WE) + (size_t)lg * 256 * 256;
    for (int ch = tid; ch < 256 * 32; ch += 512) { const int row = ch >> 5, cc = ch & 31, s = cc >> 1, qh = cc & 1; float v[8];
        if (row < 128) { const int n = row >> 1, im = row & 1; const f32x2 ap = apw[(15 - s) * 64 + n];
#pragma unroll
            for (int q = 0; q < 8; ++q) { const f32x2 pr = cmul(ap, bbv[n * 16 + qh * 8 + q]); v[q] = im ? pr.y : pr.x; } }
        else {
#pragma unroll
            for (int q = 0; q < 8; ++q) v[q] = 0.f; }
        v4u o; o.x = pk2(v[0], v[1]); o.y = pk2(v[2], v[3]); o.z = pk2(v[4], v[5]); o.w = pk2(v[6], v[7]);
        *(v4u*)(WE + (size_t)row * 256 + cc * 8) = o; }
    __syncthreads();
}

__device__ __forceinline__ void phase0(KArgs a, unsigned char* lds, int G_) { const int G = lsi(G_);
    const int tid = lv(threadIdx.x), lane = tid & 63, wave = tid >> 6;
    float* cact = (float*)lds; float* part = (float*)(lds + 32768);
    for (int i = tid; i < 8192; i += 512) { const int b = i >> 10, k = i & 1023; const float v = a->in[1][i]; cact[k * 8 + b] = v / (1.f + __expf(-v)); }
    __syncthreads();
    for (int it = lsi(blockIdx.x); it < 208 + 128; it += G) {
        if (it < 208) ada_item(a, it, cact, part, tid);
        else { const int r = it - 208; s5prep_item(a, r >> 6, r & 63, lds + 65536, tid); }
    }
    __syncthreads();
    float* scr = (float*)(lds + wave * 16384);
    const int gw = lsi(blockIdx.x) * 8 + wave, NGW = G * 8;
    unsigned char* ws = a->ws;
    constexpr int I_GU = 16 * 88, I_D = 44 * 32, I_SQ = 16 * 32, I_DQ = 16 * 8, I_KVA = 16 * 9, I_UQ = 4 * 48, I_KVB = 4 * 64;
    constexpr int NTR = 8 * I_GU + 4 * I_D + 2 * I_SQ + 2 * I_DQ + I_KVA + 2 * I_UQ + I_KVB + 2 * I_SQ;
    for (int it = gw; it < NTR; it += NGW) {
        int r = it;
        if (r < 8 * I_GU) { const int up = r >= 4 * I_GU; if (up) r -= 4 * I_GU; const int l = r / I_GU; r -= l * I_GU; const int kb = r / 88, n0 = (r % 88) * 32;
            tr_item(a->in[up ? 8 : 7] + (size_t)l * 1024 * FF, FF, kb * 64, n0, (bf16*)(ws + WS_WGU) + ((size_t)l * 5632 + (n0 >> 7) * 256 + up * 128 + (n0 & 127)) * 1024, 1024, nullptr, scr, lane); continue; }
        r -= 8 * I_GU;
        if (r < 4 * I_D) { const int l = r / I_D; r -= l * I_D; const int kb = r / 32, n0 = (r % 32) * 32;
            tr_item(a->in[9] + (size_t)l * FF * 1024, 1024, kb * 64, n0, (bf16*)(ws + WS_WD) + ((size_t)l * 1024 + n0) * FF, FF, nullptr, scr, lane); continue; }
        r -= 4 * I_D;
        if (r < 2 * I_SQ) { const int l = r / I_SQ; r -= l * I_SQ; const int kb = r / 32, n0 = (r % 32) * 32;
            tr_item(a->in[18] + (size_t)l * 1024 * 1024, 1024, kb * 64, n0, (bf16*)(ws + WS_WGLU) + ((size_t)l * 1024 + n0) * 1024, 1024, nullptr, scr, lane); continue; }
        r -= 2 * I_SQ;
        if (r < 2 * I_DQ) { const int l = r / I_DQ; r -= l * I_DQ; const int kb = r / 8, n0 = (r % 8) * 32;
            tr_item(a->in[28] + (size_t)l * 1024 * 256, 256, kb * 64, n0, (bf16*)(ws + WS_WDQ) + ((size_t)l * 256 + n0) * 1024, 1024, nullptr, scr, lane); continue; }
        r -= 2 * I_DQ;
        if (r < I_KVA) { const int kb = r / 9, n0 = (r % 9) * 32;
            tr_item(a->in[23], 288, kb * 64, n0, (bf16*)(ws + WS_WKVA) + (size_t)n0 * 1024, 1024, nullptr, scr, lane); continue; }
        r -= I_KVA;
        if (r < 2 * I_UQ) { const int l = r / I_UQ; r -= l * I_UQ; const int kb = r / 48, n0 = (r % 48) * 32; const int hh = n0 / 96, db = (n0 - hh * 96) >> 5;
            const int drow = (db < 2) ? (256 * (hh >> 2) + 128 * db + 32 * (hh & 3)) : (1024 + 256 * (hh >> 3) + 128 * ((hh & 7) >> 2) + 32 * (hh & 3));
            tr_item(a->in[30] + (size_t)l * 256 * 1536, 1536, kb * 64, n0, (bf16*)(ws + WS_WUQ) + ((size_t)l * 1536 + drow) * 256, 256, a->in[29] + l * 256, scr, lane); continue; }
        r -= 2 * I_UQ;
        if (r < I_KVB) { const int kb = r / 64, n0 = (r % 64) * 32; const int hh = n0 >> 7, db = (n0 & 127) >> 5;
            const int drow = (db < 2) ? (256 * (hh >> 2) + 128 * db + 32 * (hh & 3)) : (1024 + hh * 64 + (db - 2) * 32);
            tr_item(a->in[25], 2048, kb * 64, n0, (bf16*)(ws + WS_WKVB) + (size_t)drow * 256, 256, a->in[24], scr, lane); continue; }
        r -= I_KVB;
        { const int l = r / I_SQ; r -= l * I_SQ; const int kb = r / 32, n0 = (r % 32) * 32;
            tr_item(a->in[33] + (size_t)l * 1024 * 1024, 1024, kb * 64, n0, (bf16*)(ws + WS_WO) + ((size_t)l * 1024 + n0) * 1024, 1024, nullptr, scr, lane); }
    }
    const int gt = lsi(blockIdx.x) * 512 + tid, NT_ = G * 512;
    const int* pos = (const int*)a->in[2];
    for (int idx = gt; idx < T * 16; idx += NT_) { const int row = idx >> 4, i = idx & 15;
        const double b4 = (i & 3) == 0 ? 1.0 : (i & 3) == 1 ? 0.56234132519034908 : (i & 3) == 2 ? 0.31622776601683794 : 0.17782794100389228;
        const double p10 = (i >> 2) == 0 ? 1.0 : (i >> 2) == 1 ? 0.1 : (i >> 2) == 2 ? 0.01 : 0.001;
        double s, c; dsincos((double)pos[row] * (b4 * p10), s, c);
        ((float*)(ws + WS_COS))[idx] = (float)c; ((float*)(ws + WS_SIN))[idx] = (float)s; }
    for (int idx = gt; idx < 3 * T; idx += NT_) ((float*)(ws + WS_QSS))[idx] = 0.f;
    for (int idx = gt; idx < 224 * 1024 / 2; idx += NT_) ((unsigned*)((bf16*)(ws + WS_WKVA) + 288 * 1024))[idx] = 0u;
}

__device__ __forceinline__ void s5_norm_phase(KArgs a, int l, const float* xin, unsigned char* lds, int G_) { const int G = lsi(G_);
    const int tid = lv(threadIdx.x), lane = tid & 63, wave = tid >> 6;
    bf16* stage = (bf16*)lds;
    const float* ng = a->in[5] + l * 1024;
    bf16* AUG = (bf16*)(a->ws + WS_AUG);
    for (int it = lsi(blockIdx.x); it < NB * NSUB; it += G) {
        const int b = it >> 8, c = it & 255;
        const float* ada = (const float*)(a->ws + WS_ADA) + ((size_t)l * 8 + b) * 6144;
        f32x4 mul[4], add[4];
#pragma unroll
        for (int j = 0; j < 4; ++j) { const int ch = 4 * lane + 256 * j; const f32x4 gg = *(const f32x4*)(ng + ch), sc = *(const f32x4*)(ada + 1024 + ch); mul[j] = gg * (sc + 1.0f); add[j] = *(const f32x4*)(ada + ch); }
#pragma unroll
        for (int tt = 0; tt < 2; ++tt) { const int tok = 2 * wave + tt; const float* xr = xin + ((size_t)b * SEQ + c * 16 + tok) * 1024;
            f32x4 v[4]; float ss = 0.f;
#pragma unroll
            for (int j = 0; j < 4; ++j) { v[j] = *(const f32x4*)(xr + 4 * lane + 256 * j); ss += (v[j].x * v[j].x + v[j].y * v[j].y) + (v[j].z * v[j].z + v[j].w * v[j].w); }
            const float rstd = rsqrtf(wave_sum(ss, lane) * (1.f / 1024.f) + EPS);
#pragma unroll
            for (int j = 0; j < 4; ++j) { const f32x4 h = v[j] * rstd * mul[j] + add[j]; *(v2u*)(stage + tok * 1024 + 4 * lane + 256 * j) = (v2u){pk2(h.x, h.y), pk2(h.z, h.w)}; } }
        __syncthreads();
        { const int g = tid >> 3, part = tid & 7; bf16* dst = AUG + ((size_t)g * 2048 + b * 256 + c) * AUGK;
#pragma unroll
            for (int k = 0; k < 4; ++k) { const int chunk = part * 4 + k, s = chunk >> 1, qh = chunk & 1; *(v4u*)(dst + chunk * 8) = *(const v4u*)(stage + s * 1024 + g * 16 + qh * 8); } }
        __syncthreads();
    }
}
__device__ __forceinline__ void norm_phase(const float* x, const float* g1, const float* sh1, const float* sc1, int bstride1, bf16* out1,
                                           const float* g2, const float* sh2, const float* sc2, int bstride2, bf16* out2, int G_) { const int G = lsi(G_);
    const int tid = lv(threadIdx.x), lane = tid & 63, wave = tid >> 6;
    for (int rb = lsi(blockIdx.x) * 8 + wave; rb < T / 16; rb += G * 8) {
        const int b = rb >> 8;
        f32x4 mul[4], add[4], mul2[4], add2[4];
#pragma unroll
        for (int j = 0; j < 4; ++j) { const int ch = 4 * lane + 256 * j; mul[j] = *(const f32x4*)(g1 + ch) * (*(const f32x4*)(sc1 + (size_t)b * bstride1 + ch) + 1.0f); add[j] = *(const f32x4*)(sh1 + (size_t)b * bstride1 + ch);
            if (out2) { mul2[j] = *(const f32x4*)(g2 + ch) * (*(const f32x4*)(sc2 + (size_t)b * bstride2 + ch) + 1.0f); add2[j] = *(const f32x4*)(sh2 + (size_t)b * bstride2 + ch); } }
        for (int r4 = 0; r4 < 16; r4 += 4) {
            f32x4 v[4][4]; float ss[4];
#pragma unroll
            for (int q = 0; q < 4; ++q) { const float* xr = x + ((size_t)rb * 16 + r4 + q) * 1024; ss[q] = 0.f;
#pragma unroll
                for (int j = 0; j < 4; ++j) v[q][j] = *(const f32x4*)(xr + 4 * lane + 256 * j); }
#pragma unroll
            for (int q = 0; q < 4; ++q)
#pragma unroll
                for (int j = 0; j < 4; ++j) ss[q] += (v[q][j].x * v[q][j].x + v[q][j].y * v[q][j].y) + (v[q][j].z * v[q][j].z + v[q][j].w * v[q][j].w);
#pragma unroll
            for (int o = 1; o < 64; o <<= 1) {
                const float t0 = shx(ss[0], lane, o), t1 = shx(ss[1], lane, o), t2 = shx(ss[2], lane, o), t3 = shx(ss[3], lane, o);
                ss[0] += t0; ss[1] += t1; ss[2] += t2; ss[3] += t3; }
#pragma unroll
            for (int q = 0; q < 4; ++q) { const size_t row = (size_t)rb * 16 + r4 + q; const float rstd = rsqrtf(ss[q] * (1.f / 1024.f) + EPS);
#pragma unroll
                for (int j = 0; j < 4; ++j) { const f32x4 h = v[q][j] * rstd * mul[j] + add[j]; *(v2u*)(out1 + row * 1024 + 4 * lane + 256 * j) = (v2u){pk2(h.x, h.y), pk2(h.z, h.w)}; }
                if (out2) {
#pragma unroll
                    for (int j = 0; j < 4; ++j) { const f32x4 h = v[q][j] * rstd * mul2[j] + add2[j]; *(v2u*)(out2 + row * 1024 + 4 * lane + 256 * j) = (v2u){pk2(h.x, h.y), pk2(h.z, h.w)}; } } }
        }
    }
}
__device__ __forceinline__ void carry_phase(KArgs a, int l, int G_) { const int G = lsi(G_);
    const int tid = lv(threadIdx.x), lane = tid & 63, wave = tid >> 6;
    const float* EB = (const float*)(a->ws + WS_EBUF); bf16* AUG = (bf16*)(a->ws + WS_AUG);
    const int nn = lane >> 4, j = lane & 15;
    for (int L = lsi(blockIdx.x); L < 512; L += G)
    for (int nq = wave; nq < 16; nq += 8) {
        const int b = L & 7, g = L >> 3, n = nq * 4 + nn;
        const f32x2 a16 = ((const f32x2*)(a->ws + WS_A16))[(l * 64 + g) * 64 + n];
        const f32x4* ep = (const f32x4*)(EB + ((((size_t)(g * 8 + b) * 64 + n) * 256) + j * 16) * 2);
        f32x4 e[8];
#pragma unroll
        for (int i = 0; i < 8; ++i) e[i] = ep[i];
        f32x2 t = {0.f, 0.f};
#pragma unroll
        for (int i = 0; i < 8; ++i) { t = cmul(a16, t) + (f32x2){e[i].x, e[i].y}; t = cmul(a16, t) + (f32x2){e[i].z, e[i].w}; }
        f32x2 Ad = a16;
#pragma unroll
        for (int k = 0; k < 4; ++k) Ad = cmul(Ad, Ad);
#pragma unroll
        for (int d = 1; d < 16; d <<= 1) { const int sl = ((j >= d) ? lane - d : lane) << 2; const float tx_ = t.x, ty_ = t.y; const float orr = __builtin_bit_cast(float, __builtin_amdgcn_ds_bpermute(sl, __builtin_bit_cast(int, tx_))), oi = __builtin_bit_cast(float, __builtin_amdgcn_ds_bpermute(sl, __builtin_bit_cast(int, ty_)));
            if (j >= d) { t.x += Ad.x * orr - Ad.y * oi; t.y += Ad.x * oi + Ad.y * orr; }
            Ad = cmul(Ad, Ad); }
        f32x2 cur; { const int sl = ((j >= 1) ? lane - 1 : lane) << 2; const float tx_ = t.x, ty_ = t.y; cur.x = __builtin_bit_cast(float, __builtin_amdgcn_ds_bpermute(sl, __builtin_bit_cast(int, tx_))); cur.y = __builtin_bit_cast(float, __builtin_amdgcn_ds_bpermute(sl, __builtin_bit_cast(int, ty_))); } if (j == 0) cur = (f32x2){0.f, 0.f};
        bf16* op = AUG + ((size_t)g * 2048 + b * 256 + j * 16) * AUGK + 256 + 2 * n;
#pragma unroll
        for (int i = 0; i < 8; ++i) {
            *(unsigned*)(op + (size_t)(2 * i) * AUGK) = pk2(cur.x, cur.y); cur = cmul(a16, cur) + (f32x2){e[i].x, e[i].y};
            *(unsigned*)(op + (size_t)(2 * i + 1) * AUGK) = pk2(cur.x, cur.y); cur = cmul(a16, cur) + (f32x2){e[i].z, e[i].w}; }
    }
}

using pg8::Unit;
typedef const f32x4 (&AccRef)[2][2][4][2];
struct GroupOrder {
    int G, c;
    __device__ __forceinline__ bool next(int i, Unit& u) const { const int L = i * G + c; if (L >= 512) return false; u.pm = L; u.pn = L >> 3; return true; }
    __device__ __forceinline__ void a_ready(const Unit&) const {}
    __device__ __forceinline__ void done(const Unit&) const {}
};
struct EpiE { static constexpr bool PERM = false, AFTER_DRAIN = false; float* E;
    __device__ __forceinline__ void operator()(AccRef acc, const Unit& u, int wr, int wc, int fr, int fq) const { fr = lv(fr); fq = lv(fq);
        float* base = E + (size_t)((u.pn * 8 + (u.pm & 7)) * 64) * 512;
#pragma unroll
        for (int ai = 0; ai < 2; ++ai)
#pragma unroll
            for (int m = 0; m < 4; ++m) { const int c = ai * 128 + wr * 64 + m * 16 + fr;
#pragma unroll
                for (int n = 0; n < 2; ++n) { const int ns = 16 * wc + 8 * n + 2 * fq; const f32x4 v = acc[ai][0][m][n];
                    *(f32x2*)(base + ((size_t)ns * 256 + c) * 2) = (f32x2){v.x, v.y}; *(f32x2*)(base + ((size_t)(ns + 1) * 256 + c) * 2) = (f32x2){v.z, v.w}; } }
    }
};
struct EpiY { static constexpr bool PERM = true, AFTER_DRAIN = false; bf16* Gd;
    __device__ __forceinline__ void operator()(AccRef acc, const Unit& u, int wr, int wc, int fr, int fq) const { fr = lv(fr); fq = lv(fq);
        const int g = u.pn, b = u.pm & 7;
#pragma unroll
        for (int bj = 0; bj < 2; ++bj) { const int tc0 = 128 * bj + 32 * wc + 8 * fq, t = tc0 >> 4, p0 = tc0 & 15;
#pragma unroll
            for (int ai = 0; ai < 2; ++ai)
#pragma unroll
                for (int m = 0; m < 4; ++m) { const int r = ai * 128 + wr * 64 + m * 16 + fr; const size_t tok = (size_t)b * SEQ + r * 16 + t;
                    const f32x4 v0 = acc[ai][bj][m][0], v1 = acc[ai][bj][m][1];
                    v4u w; w.x = pk2(gelu_tanh(v0.x), gelu_tanh(v0.y)); w.y = pk2(gelu_tanh(v0.z), gelu_tanh(v0.w)); w.z = pk2(gelu_tanh(v1.x), gelu_tanh(v1.y)); w.w = pk2(gelu_tanh(v1.z), gelu_tanh(v1.w));
                    *(v4u*)(Gd + tok * 1024 + g * 16 + p0) = w; } }
    }
};
struct EpiGlu { static constexpr bool PERM = false, AFTER_DRAIN = false; const bf16* Gd; const float* bglu; const float* gate; const float* xin; float* xout;
    __device__ __forceinline__ void operator()(AccRef acc, const Unit& u, int wr, int wc, int fr, int fq) const { fr = lv(fr); fq = lv(fq);
        const int b = u.pm >> 4; f32x4 gt[2][2], bg[2][2];
#pragma unroll
        for (int bj = 0; bj < 2; ++bj)
#pragma unroll
            for (int n = 0; n < 2; ++n) { const int col = u.pn * 256 + 128 * bj + 32 * wc + 16 * n + 4 * fq; bg[bj][n] = *(const f32x4*)(bglu + col); gt[bj][n] = *(const f32x4*)(gate + (size_t)b * 6144 + col); }
#pragma unroll
        for (int ai = 0; ai < 2; ++ai)
#pragma unroll
            for (int mh = 0; mh < 2; ++mh) { f32x4 xv[2][2][2]; v2u gw[2][2][2];
                const size_t o0 = (size_t)(u.pm * 256 + ai * 128 + wr * 64 + mh * 32 + fr) * 1024 + u.pn * 256 + 32 * wc + 4 * fq;
#pragma unroll
                for (int m = 0; m < 2; ++m)
#pragma unroll
                    for (int bj = 0; bj < 2; ++bj)
#pragma unroll
                        for (int n = 0; n < 2; ++n) { const size_t off = o0 + (size_t)m * 16 * 1024 + 128 * bj + 16 * n; xv[m][bj][n] = *(const f32x4*)(xin + off); gw[m][bj][n] = *(const v2u*)(Gd + off); }
                asm volatile("" ::: "memory");
#pragma unroll
                for (int m = 0; m < 2; ++m)
#pragma unroll
                    for (int bj = 0; bj < 2; ++bj)
#pragma unroll
                        for (int n = 0; n < 2; ++n) { const size_t off = o0 + (size_t)m * 16 * 1024 + 128 * bj + 16 * n; const v2u g2 = gw[m][bj][n];
                            const f32x4 gv = {bflo(g2.x), bfhi(g2.x), bflo(g2.y), bfhi(g2.y)};
                            const f32x4 z = acc[ai][bj][2 * mh + m][n] + bg[bj][n]; const f32x4 mix = {gv.x * sigm(z.x), gv.y * sigm(z.y), gv.z * sigm(z.z), gv.w * sigm(z.w)};
                            *(f32x4*)(xout + off) = xv[m][bj][n] + gt[bj][n] * mix; }
                asm volatile("" ::: "memory"); }
    }
};
struct EpiRes { static constexpr bool PERM = false, AFTER_DRAIN = false; const float* gate; float* x;
    __device__ __forceinline__ void operator()(AccRef acc, const Unit& u, int wr, int wc, int fr, int fq) const { fr = lv(fr); fq = lv(fq);
        const int b = u.pm >> 4; f32x4 gt[2][2];
#pragma unroll
        for (int bj = 0; bj < 2; ++bj)
#pragma unroll
            for (int n = 0; n < 2; ++n) gt[bj][n] = *(const f32x4*)(gate + (size_t)b * 6144 + u.pn * 256 + 128 * bj + 32 * wc + 16 * n + 4 * fq);
#pragma unroll
        for (int ai = 0; ai < 2; ++ai) { f32x4 xv[4][2][2];
            float* xb = x + (size_t)(u.pm * 256 + ai * 128 + wr * 64 + fr) * 1024 + u.pn * 256 + 32 * wc + 4 * fq;
#pragma unroll
            for (int m = 0; m < 4; ++m)
#pragma unroll
                for (int bj = 0; bj < 2; ++bj)
#pragma unroll
                    for (int n = 0; n < 2; ++n) xv[m][bj][n] = *(const f32x4*)(xb + (size_t)m * 16 * 1024 + 128 * bj + 16 * n);
            asm volatile("" ::: "memory");
#pragma unroll
            for (int m = 0; m < 4; ++m)
#pragma unroll
                for (int bj = 0; bj < 2; ++bj)
#pragma unroll
                    for (int n = 0; n < 2; ++n) *(f32x4*)(xb + (size_t)m * 16 * 1024 + 128 * bj + 16 * n) = xv[m][bj][n] + gt[bj][n] * acc[ai][bj][m][n];
            asm volatile("" ::: "memory"); }
    }
};
__device__ __forceinline__ float sq4(f32x4 v);
struct EpiNone { static constexpr bool PERM = false, AFTER_DRAIN = false; float* sink;
    __device__ __forceinline__ void operator()(AccRef acc, const Unit& u, int wr, int wc, int fr, int fq) const { if (sink) { float s = 0.f;
#pragma unroll
        for (int ai = 0; ai < 2; ++ai)
#pragma unroll
            for (int bj = 0; bj < 2; ++bj)
#pragma unroll
                for (int m = 0; m < 4; ++m)
#pragma unroll
                    for (int n = 0; n < 2; ++n) s += sq4(acc[ai][bj][m][n]);
        if (s == 123.456f) sink[0] = s; } }
};
__device__ __forceinline__ float sq4(f32x4 v);
__device__ __forceinline__ void silu2(float g1, float g2, float u1, float u2, float& o1, float& o2) {
    const float a = 1.f + fminf(__expf(-g1), 1e18f), b = 1.f + fminf(__expf(-g2), 1e18f);
    const float r = __builtin_amdgcn_rcpf(a * b);
    o1 = g1 * u1 * (r * b); o2 = g2 * u2 * (r * a);
}
struct EpiGU { static constexpr bool PERM = true, AFTER_DRAIN = false; bf16* H;
    __device__ __forceinline__ void operator()(AccRef acc, const Unit& u, int wr, int wc, int fr, int fq) const { fr = lv(fr); fq = lv(fq);
#pragma unroll
        for (int ai = 0; ai < 2; ++ai)
#pragma unroll
            for (int m = 0; m < 4; ++m) { const size_t row = (size_t)(u.pm * 256 + ai * 128 + wr * 64 + m * 16 + fr);
                const f32x4 g0 = acc[ai][0][m][0], g1 = acc[ai][0][m][1], u0 = acc[ai][1][m][0], u1 = acc[ai][1][m][1];
                float h[8];
                silu2(g0.x, g0.y, u0.x, u0.y, h[0], h[1]); silu2(g0.z, g0.w, u0.z, u0.w, h[2], h[3]);
                silu2(g1.x, g1.y, u1.x, u1.y, h[4], h[5]); silu2(g1.z, g1.w, u1.z, u1.w, h[6], h[7]);
                v4u w; w.x = pk2(h[0], h[1]); w.y = pk2(h[2], h[3]); w.z = pk2(h[4], h[5]); w.w = pk2(h[6], h[7]);
                *(v4u*)(H + row * FF + u.pn * 128 + 32 * wc + 8 * fq) = w; }
    }
};
__device__ __forceinline__ float sq4(f32x4 v) { return (v.x * v.x + v.y * v.y) + (v.z * v.z + v.w * v.w); }
__device__ __forceinline__ float quad_sum_(float s, int lane) { s += shx(s, lane, 16); s += shx(s, lane, 32); return s; }
#define quad_sum(s) quad_sum_((s), fr + 16 * fq)
struct EpiDq { static constexpr bool PERM = true, AFTER_DRAIN = false; bf16* QA; float* SS;
    __device__ __forceinline__ void operator()(AccRef acc, const Unit& u, int wr, int wc, int fr, int fq) const { fr = lv(fr); fq = lv(fq);
#pragma unroll
        for (int ai = 0; ai < 2; ++ai)
#pragma unroll
            for (int m = 0; m < 4; ++m) { const size_t row = (size_t)(u.pm * 256 + ai * 128 + wr * 64 + m * 16 + fr); float ss = 0.f;
#pragma unroll
                for (int bj = 0; bj < 2; ++bj) { const f32x4 v0 = acc[ai][bj][m][0], v1 = acc[ai][bj][m][1]; ss += sq4(v0) + sq4(v1);
                    *(v4u*)(QA + row * 256 + 128 * bj + 32 * wc + 8 * fq) = (v4u){pk2(v0.x, v0.y), pk2(v0.z, v0.w), pk2(v1.x, v1.y), pk2(v1.z, v1.w)}; }
                ss = quad_sum(ss); if (fq == 0) atomicAdd(SS + row, ss); }
    }
};
struct EpiKva { static constexpr bool PERM = false, AFTER_DRAIN = false; bf16* CKV; float* SS; bf16* KR; const float* gkr; const float* COS; const float* SIN;
    __device__ __forceinline__ void operator()(AccRef acc, const Unit& u, int wr, int wc, int fr, int fq) const { fr = lv(fr); fq = lv(fq);
        if (u.pn == 0) {
#pragma unroll
            for (int ai = 0; ai < 2; ++ai)
#pragma unroll
                for (int m = 0; m < 4; ++m) { const size_t row = (size_t)(u.pm * 256 + ai * 128 + wr * 64 + m * 16 + fr); float ss = 0.f;
#pragma unroll
                    for (int bj = 0; bj < 2; ++bj)
#pragma unroll
                        for (int n = 0; n < 2; ++n) { const f32x4 v = acc[ai][bj][m][n]; ss += sq4(v); *(v2u*)(CKV + row * 256 + 128 * bj + 32 * wc + 16 * n + 4 * fq) = (v2u){pk2(v.x, v.y), pk2(v.z, v.w)}; }
                    ss = quad_sum(ss); if (fq == 0) atomicAdd(SS + row, ss); }
        } else if (wc == 0) {
            const f32x4 g1 = *(const f32x4*)(gkr + 4 * fq), g2 = *(const f32x4*)(gkr + 16 + 4 * fq);
#pragma unroll
            for (int ai = 0; ai < 2; ++ai)
#pragma unroll
                for (int m = 0; m < 4; ++m) { const size_t row = (size_t)(u.pm * 256 + ai * 128 + wr * 64 + m * 16 + fr);
                    const f32x4 x1 = acc[ai][0][m][0], x2 = acc[ai][0][m][1];
                    const float rstd = rsqrtf(quad_sum(sq4(x1) + sq4(x2)) * (1.f / 32.f) + EPS);
                    const f32x4 cs = *(const f32x4*)(COS + row * 16 + 4 * fq), sn = *(const f32x4*)(SIN + row * 16 + 4 * fq);
                    const f32x4 y1 = x1 * rstd * g1, y2 = x2 * rstd * g2, o1 = y1 * cs - y2 * sn, o2 = y1 * sn + y2 * cs;
                    *(v2u*)(KR + row * 32 + 4 * fq) = (v2u){pk2(o1.x, o1.y), pk2(o1.z, o1.w)}; *(v2u*)(KR + row * 32 + 16 + 4 * fq) = (v2u){pk2(o2.x, o2.y), pk2(o2.z, o2.w)}; }
        }
    }
};
constexpr float QSC = 0.10206207261596577f * 1.4426950408889634f;
struct EpiUq { static constexpr bool PERM = false, AFTER_DRAIN = false; const float* SS; const float* gn; const float* gr; const float* COS; const float* SIN; bf16* QB;
    __device__ __forceinline__ void operator()(AccRef acc, const Unit& u, int wr, int wc, int fr, int fq) const { fr = lv(fr); fq = lv(fq);
        const int b = u.pm >> 4; float ssv[2][4];
#pragma unroll
        for (int ai = 0; ai < 2; ++ai)
#pragma unroll
            for (int m = 0; m < 4; ++m) ssv[ai][m] = SS[(size_t)(u.pm * 256 + ai * 128 + wr * 64 + m * 16 + fr)];
#pragma unroll
        for (int ai = 0; ai < 2; ++ai)
#pragma unroll
            for (int m = 0; m < 4; ++m) { const int rowi = u.pm * 256 + ai * 128 + wr * 64 + m * 16 + fr; const size_t row = (size_t)rowi; const int s = rowi & (SEQ - 1);
                const float rq = rsqrtf(ssv[ai][m] * (1.f / 256.f) + EPS);
                if (u.pn < 4) { const int hh = 4 * u.pn + wc; float ss = 0.f; f32x4 v[2][2];
#pragma unroll
                    for (int bj = 0; bj < 2; ++bj)
#pragma unroll
                        for (int n = 0; n < 2; ++n) { v[bj][n] = acc[ai][bj][m][n] * rq; ss += sq4(v[bj][n]); }
                    const float rh = rsqrtf(quad_sum(ss) * (1.f / 64.f) + EPS);
                    bf16* dst = QB + (((size_t)b * NH + hh) * SEQ + s) * 96;
#pragma unroll
                    for (int bj = 0; bj < 2; ++bj)
#pragma unroll
                        for (int n = 0; n < 2; ++n) { const int d = 32 * bj + 16 * n + 4 * fq; const f32x4 o = v[bj][n] * (rh * QSC) * *(const f32x4*)(gn + d); *(v2u*)(dst + d) = (v2u){pk2(o.x, o.y), pk2(o.z, o.w)}; }
                } else {
                    const f32x4 cs = *(const f32x4*)(COS + row * 16 + 4 * fq), sn = *(const f32x4*)(SIN + row * 16 + 4 * fq);
                    const f32x4 g1 = *(const f32x4*)(gr + 4 * fq), g2 = *(const f32x4*)(gr + 16 + 4 * fq);
#pragma unroll
                    for (int bj = 0; bj < 2; ++bj) { const int hh = 8 * (u.pn - 4) + 4 * bj + wc;
                        const f32x4 x1 = acc[ai][bj][m][0] * rq, x2 = acc[ai][bj][m][1] * rq;
                        const float rh = rsqrtf(quad_sum(sq4(x1) + sq4(x2)) * (1.f / 32.f) + EPS);
                        const f32x4 y1 = x1 * (rh * QSC) * g1, y2 = x2 * (rh * QSC) * g2, o1 = y1 * cs - y2 * sn, o2 = y1 * sn + y2 * cs;
                        bf16* dst = QB + (((size_t)b * NH + hh) * SEQ + s) * 96 + 64;
                        *(v2u*)(dst + 4 * fq) = (v2u){pk2(o1.x, o1.y), pk2(o1.z, o1.w)}; *(v2u*)(dst + 16 + 4 * fq) = (v2u){pk2(o2.x, o2.y), pk2(o2.z, o2.w)}; }
                } }
    }
};
struct EpiKvb { static constexpr bool PERM = false, AFTER_DRAIN = false; const float* SS; const float* gk; bf16* KB; bf16* VB;
    __device__ __forceinline__ void operator()(AccRef acc, const Unit& u, int wr, int wc, int fr, int fq) const { fr = lv(fr); fq = lv(fq);
        const int b = u.pm >> 4; float ssv[2][4];
#pragma unroll
        for (int ai = 0; ai < 2; ++ai)
#pragma unroll
            for (int m = 0; m < 4; ++m) ssv[ai][m] = SS[(size_t)(u.pm * 256 + ai * 128 + wr * 64 + m * 16 + fr)];
#pragma unroll
        for (int ai = 0; ai < 2; ++ai)
#pragma unroll
            for (int m = 0; m < 4; ++m) { const int rowi = u.pm * 256 + ai * 128 + wr * 64 + m * 16 + fr; const size_t row = (size_t)rowi; const int s = rowi & (SEQ - 1);
                const float rc = rsqrtf(ssv[ai][m] * (1.f / 256.f) + EPS);
                if (u.pn < 4) { const int hh = 4 * u.pn + wc; float ss = 0.f; f32x4 v[2][2];
#pragma unroll
                    for (int bj = 0; bj < 2; ++bj)
#pragma unroll
                        for (int n = 0; n < 2; ++n) { v[bj][n] = acc[ai][bj][m][n] * rc; ss += sq4(v[bj][n]); }
                    const float rh = rsqrtf(quad_sum(ss) * (1.f / 64.f) + EPS);
                    bf16* dst = KB + (((size_t)b * NH + hh) * SEQ + s) * 64;
#pragma unroll
                    for (int bj = 0; bj < 2; ++bj)
#pragma unroll
                        for (int n = 0; n < 2; ++n) { const int d = 32 * bj + 16 * n + 4 * fq; const f32x4 o = v[bj][n] * rh * *(const f32x4*)(gk + d); *(v2u*)(dst + d) = (v2u){pk2(o.x, o.y), pk2(o.z, o.w)}; }
                } else {
#pragma unroll
                    for (int bj = 0; bj < 2; ++bj)
#pragma unroll
                        for (int n = 0; n < 2; ++n) { const int col = 256 * (u.pn - 4) + 128 * bj + 32 * wc + 16 * n + 4 * fq, hh = col >> 6, dv = col & 63;
                            const f32x4 o = acc[ai][bj][m][n] * rc; *(v2u*)(VB + (((size_t)b * NH + hh) * SEQ + s) * 64 + dv) = (v2u){pk2(o.x, o.y), pk2(o.z, o.w)}; }
                } }
    }
};

namespace att {
using bf16x8 = __attribute__((ext_vector_type(8))) short;
using s16x4 = __attribute__((ext_vector_type(4))) short;
using f32x16 = __attribute__((ext_vector_type(16))) float;
using u32x4 = __attribute__((ext_vector_type(4))) unsigned;
constexpr int QBLK = 32, KVBLK = 64;
constexpr float SCALE = 0.10206207261596577f;
constexpr float THR = 6.f;
constexpr int SHM_V = 64 * 64 * 2, SHM_K = 64 * 256;
#define KSWZ(row, colB) ((row) * 256 + ((colB) ^ (((row) & 7) << 4)))
#define SBAR() __builtin_amdgcn_sched_barrier(0)
__device__ __forceinline__ int crow(int r, int hi) { return (r & 3) + 8 * (r >> 2) + 4 * hi; }
__device__ __forceinline__ unsigned cvtpk(float lo, float hi) { unsigned r; asm volatile("v_cvt_pk_bf16_f32 %0, %1, %2" : "=v"(r) : "v"(lo), "v"(hi)); return r; }
__device__ __forceinline__ void partialSM(f32x16& p0, f32x16& p1, float& m_reg, f32x16& negm, float& alpha) {
    constexpr float THRL = THR * 1.4426950408889634f;
    float pmax = p0[0];
#pragma unroll
    for (int r = 1; r < 16; ++r) pmax = fmaxf(pmax, p0[r]);
#pragma unroll
    for (int r = 0; r < 16; ++r) pmax = fmaxf(pmax, p1[r]);
    { auto rr = __builtin_amdgcn_permlane32_swap(__float_as_uint(pmax), __float_as_uint(pmax), false, false); pmax = fmaxf(__uint_as_float(rr[0]), __uint_as_float(rr[1])); }
    if (__builtin_expect(__all(pmax <= THRL), 1)) { alpha = 1.f; }
    else { const float dl = fmaxf(pmax, 0.f); m_reg += dl; alpha = __builtin_amdgcn_exp2f(-dl);
#pragma unroll
        for (int r = 0; r < 16; ++r) { p0[r] -= dl; p1[r] -= dl; }
#pragma unroll
        for (int r = 0; r < 16; ++r) negm[r] = -m_reg; }
#pragma unroll
    for (int r = 0; r < 16; ++r) p0[r] = __builtin_amdgcn_exp2f(p0[r]);
}
__device__ __forceinline__ void finishSM(f32x16& p0, f32x16& p1, float alpha, float& l_reg, bf16x8& pa0, bf16x8& pa1, bf16x8& pa2, bf16x8& pa3) {
#pragma unroll
    for (int r = 0; r < 16; ++r) p1[r] = __builtin_amdgcn_exp2f(p1[r]);
    float ps = 0;
#pragma unroll
    for (int r = 0; r < 16; ++r) ps += p0[r];
#pragma unroll
    for (int r = 0; r < 16; ++r) ps += p1[r];
    { auto rr = __builtin_amdgcn_permlane32_swap(__float_as_uint(ps), __float_as_uint(ps), false, false); ps = __uint_as_float(rr[0]) + __uint_as_float(rr[1]); }
    l_reg = l_reg * alpha + ps;
#define PK4(P, BASE, OUT) do { unsigned a0 = cvtpk(P[BASE + 0], P[BASE + 1]), a1 = cvtpk(P[BASE + 2], P[BASE + 3]);   \
    unsigned b0 = cvtpk(P[BASE + 4], P[BASE + 5]), b1 = cvtpk(P[BASE + 6], P[BASE + 7]);                              \
    auto r0 = __builtin_amdgcn_permlane32_swap(a0, b0, false, false); auto r1 = __builtin_amdgcn_permlane32_swap(a1, b1, false, false); \
    u32x4 w = {r0[0], r1[0], r0[1], r1[1]}; OUT = *reinterpret_cast<bf16x8*>(&w); } while (0)
    PK4(p0, 0, pa0); PK4(p0, 8, pa1); PK4(p1, 0, pa2); PK4(p1, 8, pa3);
#undef PK4
}
__device__ __forceinline__ void qkt(f32x16& p0, f32x16& p1, const char* Ks, const bf16x8* qr, int r32, int hi, const f32x16& cin) {
    p0 = cin; p1 = cin;
#pragma unroll
    for (int d0 = 0; d0 < 6; ++d0) { const int cb = (d0 * 16 + hi * 8) * 2;
        const bf16x8 b0 = *reinterpret_cast<const bf16x8*>(Ks + KSWZ(r32, cb));
        const bf16x8 b1 = *reinterpret_cast<const bf16x8*>(Ks + KSWZ(32 + r32, cb));
        p0 = __builtin_amdgcn_mfma_f32_32x32x16_bf16(b0, qr[d0], p0, 0, 0, 0);
        p1 = __builtin_amdgcn_mfma_f32_32x32x16_bf16(b1, qr[d0], p1, 0, 0, 0); }
}
__device__ __forceinline__ int v_st(int k, int c) { const int kk = (k & ~0xC) | ((k & 4) << 1) | ((k & 8) >> 1); return ((kk >> 3) * 2 + (c >> 5)) * 512 + ((kk & 7) * 32 + (c & 31)) * 2; }
__device__ __forceinline__ int v_rd_base(int lane) { return ((lane & 3) << 3) | (((lane >> 2) & 3) << 6) | (((lane >> 4) & 1) << 5) | (((lane >> 5) & 1) << 8); }
constexpr int v_rd_off(int d0, int ks, int half) { return d0 * 512 + ks * 2048 + half * 1024; }
template <int OFF> __device__ __forceinline__ s16x4 tr_read(int vb) { s16x4 r; asm volatile("ds_read_b64_tr_b16 %0, %1 offset:%2" : "=&v"(r) : "v"(vb), "i"(OFF) : "memory"); return r; }
template <int D0> __device__ __forceinline__ void pv_one(f32x16& od, int vb, bf16x8 pa0, bf16x8 pa1, bf16x8 pa2, bf16x8 pa3) {
    const s16x4 l0 = tr_read<v_rd_off(D0, 0, 0)>(vb), h0 = tr_read<v_rd_off(D0, 0, 1)>(vb), l1 = tr_read<v_rd_off(D0, 1, 0)>(vb), h1 = tr_read<v_rd_off(D0, 1, 1)>(vb);
    const s16x4 l2 = tr_read<v_rd_off(D0, 2, 0)>(vb), h2 = tr_read<v_rd_off(D0, 2, 1)>(vb), l3 = tr_read<v_rd_off(D0, 3, 0)>(vb), h3 = tr_read<v_rd_off(D0, 3, 1)>(vb);
    asm volatile("s_waitcnt lgkmcnt(0)" ::: "memory"); SBAR();
#define PK(L, H) (bf16x8){L[0], L[1], L[2], L[3], H[0], H[1], H[2], H[3]}
    od = __builtin_amdgcn_mfma_f32_32x32x16_bf16(pa0, PK(l0, h0), od, 0, 0, 0);
    od = __builtin_amdgcn_mfma_f32_32x32x16_bf16(pa1, PK(l1, h1), od, 0, 0, 0);
    od = __builtin_amdgcn_mfma_f32_32x32x16_bf16(pa2, PK(l2, h2), od, 0, 0, 0);
    od = __builtin_amdgcn_mfma_f32_32x32x16_bf16(pa3, PK(l3, h3), od, 0, 0, 0);
#undef PK
}
__device__ __forceinline__ void pv_d0(f32x16* o, int vb, bf16x8 pa0, bf16x8 pa1, bf16x8 pa2, bf16x8 pa3) { pv_one<0>(o[0], vb, pa0, pa1, pa2, pa3); pv_one<1>(o[1], vb, pa0, pa1, pa2, pa3); }

__device__ __forceinline__ void attn_unit(const bf16* __restrict__ Qb, const bf16* __restrict__ Kh, const bf16* __restrict__ KRb, const bf16* __restrict__ Vh, bf16* __restrict__ Ob, int NT, char* lds) {
    const int tid = lv(threadIdx.x), wid = tid >> 6, lane = tid & 63, r32 = lane & 31, hi = lane >> 5;
    char* V_lds = lds; char* K_lds = lds + 2 * SHM_V;
    float* ws = (float*)(lds + 2 * SHM_V + 2 * SHM_K) + wid * 64; float* li_l = ws; float* al_l = ws + 32;
    float m_reg = 0.f, l_reg = 0; f32x16 o[2] = {}; bf16x8 qr[6]; f32x16 negm = {}; f32x16 negbig; _Pragma("unroll") for (int r = 0; r < 16; ++r) negbig[r] = -1e30f;
    const bf16* Qw = Qb + (long)(wid * QBLK + r32) * 96 + hi * 8;
#pragma unroll
    for (int d0 = 0; d0 < 6; ++d0) qr[d0] = *reinterpret_cast<const bf16x8*>(Qw + d0 * 16);
    const int sr = tid >> 4, kc = tid & 15; const bool kact = kc < 12;
    const bf16* ksrc = (kc < 8) ? (Kh + kc * 8) : (KRb + (kc - 8) * 8); const int kstr = (kc < 8) ? 64 : 32;
    const int vr = tid >> 3, vc = (tid & 7) * 8; const int vst = v_st(vr, vc);
    const int kw0 = KSWZ(sr, kc * 16), kw1 = KSWZ(32 + sr, kc * 16);
    const int vb0 = (int)(uintptr_t)V_lds + v_rd_base(lane);
    struct { bf16x8 vs, ks0, ks1; } sr_[2];
#define SLOAD(i, k0) do { sr_[i].vs = *reinterpret_cast<const bf16x8*>(Vh + (long)((k0) + vr) * 64 + vc); \
    if (kact) { sr_[i].ks0 = *reinterpret_cast<const bf16x8*>(ksrc + (long)((k0) + sr) * kstr); sr_[i].ks1 = *reinterpret_cast<const bf16x8*>(ksrc + (long)((k0) + 32 + sr) * kstr); } } while (0)
#define SWRITE(b, i) do { *(bf16x8*)(V_lds + (b) * SHM_V + vst) = sr_[i].vs; \
    if (kact) { *(bf16x8*)(K_lds + (b) * SHM_K + kw0) = sr_[i].ks0; *(bf16x8*)(K_lds + (b) * SHM_K + kw1) = sr_[i].ks1; } } while (0)
#define SWAIT() asm volatile("s_waitcnt vmcnt(3)" ::: "memory")
#define RESC(a) do { if (__any((a) < 1.f)) { if (hi == 0) al_l[r32] = (a); asm volatile("s_waitcnt lgkmcnt(0)" ::: "memory"); \
    _Pragma("unroll") for (int d = 0; d < 2; ++d) _Pragma("unroll") for (int r = 0; r < 16; ++r) o[d][r] *= al_l[crow(r, hi)]; } } while (0)
#define MASKED(t) ((t) - (NT - 4) > wq)
#define CIN(t) (MASKED(t) ? negbig : negm)
    f32x16 pA0, pA1, pB0, pB1; float alA, alB; bf16x8 pa0, pa1, pa2, pa3; const int wq = __builtin_amdgcn_readfirstlane(wid >> 1);
    sr_[0].ks0 = bf16x8{}; sr_[0].ks1 = bf16x8{}; sr_[1].ks0 = bf16x8{}; sr_[1].ks1 = bf16x8{};
    SLOAD(0, 0); asm volatile("s_waitcnt vmcnt(0)" ::: "memory"); SWRITE(0, 0); __syncthreads();
    qkt(pA0, pA1, K_lds, qr, r32, hi, negm); partialSM(pA0, pA1, m_reg, negm, alA);
    SLOAD(1, KVBLK); if (2 < NT) SLOAD(0, 2 * KVBLK);
    SWAIT(); SWRITE(1, 1); __syncthreads();
#define BODY(j, CINB, CINA) do { \
        SBAR(); qkt(pB0, pB1, K_lds + SHM_K, qr, r32, hi, CINB); \
        finishSM(pA0, pA1, alA, l_reg, pa0, pa1, pa2, pa3); SBAR(); \
        SLOAD(1, ((j) + 2) * KVBLK); SBAR(); \
        pv_d0(o, vb0, pa0, pa1, pa2, pa3); partialSM(pB0, pB1, m_reg, negm, alB); \
        __syncthreads(); SWAIT(); SWRITE(0, 0); \
        RESC(alB); __syncthreads(); \
        SBAR(); qkt(pA0, pA1, K_lds, qr, r32, hi, CINA); \
        finishSM(pB0, pB1, alB, l_reg, pa0, pa1, pa2, pa3); SBAR(); \
        if ((j) + 3 < NT) SLOAD(0, ((j) + 3) * KVBLK); SBAR(); \
        pv_d0(o, vb0 + SHM_V, pa0, pa1, pa2, pa3); partialSM(pA0, pA1, m_reg, negm, alA); \
        __syncthreads(); SWAIT(); SWRITE(1, 1); \
        RESC(alA); __syncthreads(); } while (0)
    int j = 1;
    for (; j + 5 < NT; j += 2) BODY(j, negm, negm);
    for (; j + 1 < NT; j += 2) BODY(j, CIN(j), CIN(j + 1));
#undef BODY
    SBAR(); qkt(pB0, pB1, K_lds + SHM_K, qr, r32, hi, CIN(NT - 1));
    finishSM(pA0, pA1, alA, l_reg, pa0, pa1, pa2, pa3); SBAR();
    pv_d0(o, vb0, pa0, pa1, pa2, pa3); partialSM(pB0, pB1, m_reg, negm, alB);
    __syncthreads(); RESC(alB);
    finishSM(pB0, pB1, alB, l_reg, pa0, pa1, pa2, pa3); SBAR();
    pv_d0(o, vb0 + SHM_V, pa0, pa1, pa2, pa3);
    if (hi == 0) li_l[r32] = l_reg; asm volatile("s_waitcnt lgkmcnt(0)" ::: "memory");
    float rli[16];
#pragma unroll
    for (int r = 0; r < 16; ++r) rli[r] = __builtin_amdgcn_rcpf(li_l[crow(r, hi)]);
    bf16* Ow = Ob + (long)(wid * QBLK) * 1024;
#pragma unroll
    for (int r = 0; r < 16; ++r) { const int orow = crow(r, hi);
#pragma unroll
        for (int d0 = 0; d0 < 2; ++d0) Ow[(long)orow * 1024 + d0 * 32 + r32] = (bf16)f2bf(o[d0][r] * rli[r]); }
    asm volatile("s_waitcnt vmcnt(0)" ::: "memory");
    __syncthreads();
#undef SLOAD
#undef SWRITE
#undef SWAIT
#undef RESC
#undef MASKED
#undef CIN
}
#undef KSWZ
#undef SBAR
}

__device__ __forceinline__ void attn_phase(KArgs a, unsigned char* lds, int G_) { const int G = lsi(G_);
    const int bx = lsi(blockIdx.x); const int vcu = (G % 8 == 0) ? (bx % 8) * (G / 8) + bx / 8 : bx;
    const bf16* QB = (const bf16*)(a->ws + WS_QB); const bf16* KB = (const bf16*)(a->ws + WS_KB); const bf16* VB = (const bf16*)(a->ws + WS_VB);
    const bf16* KR = (const bf16*)(a->ws + WS_KR); bf16* OB = (bf16*)(a->ws + WS_OB);
    for (int p = vcu; p < 1024; p += G) { const int bh = p >> 3, s = p & 7, b = bh >> 4, h = bh & 15;
        for (int half = 0; half < 2; ++half) { const int qb = half ? 15 - s : s;
            att::attn_unit(QB + ((size_t)bh * SEQ + qb * 256) * 96, KB + (size_t)bh * SEQ * 64, KR + (size_t)b * SEQ * 32, VB + (size_t)bh * SEQ * 64,
                           OB + ((size_t)b * SEQ + qb * 256) * 1024 + h * 64, 4 * (qb + 1), (char*)lds); } }
}

#define LAS __attribute__((address_space(3)))
#define XB_TMO      128
#define XB_XCNT(j)  (256  + 64 * (j))
#define XB_XSUB(j)  (1280 + 64 * (j))
#define XB_XGEN(j)  (2304 + 64 * (j))
#define XB_TOP      3328
#define XB_TOPGEN   3392
#define XCD_BAR_WORDS 3456
#define XB_SPIN_CAP (1u << 18)

__device__ __forceinline__ unsigned xb_ld(unsigned* p)              { return __hip_atomic_load(p, __ATOMIC_RELAXED, __HIP_MEMORY_SCOPE_AGENT); }
__device__ __forceinline__ unsigned xb_add(unsigned* p, unsigned v) { return __hip_atomic_fetch_add(p, v, __ATOMIC_RELAXED, __HIP_MEMORY_SCOPE_AGENT); }
__device__ __forceinline__ unsigned xb_xcc_id() { return (unsigned)__builtin_amdgcn_s_getreg((3 << 11) | 20) & 0xFu; }
#define XB_SPIN(cond, bar) do { unsigned _sp = 0; while (cond) { __builtin_amdgcn_s_sleep(1); \
    if ((++_sp & 255u) == 0u) { if (xb_ld(&(bar)[XB_TMO])) break; if (_sp > XB_SPIN_CAP) { atomicAdd(&(bar)[XB_TMO], 1u); break; } } } } while (0)

struct XcdBarrier {
    unsigned* bar; unsigned x;
    volatile LAS unsigned* st;
};

__device__ __forceinline__ XcdBarrier xcd_barrier_post(unsigned* bar, volatile LAS unsigned* st) {
    XcdBarrier b; b.bar = bar; b.x = xb_xcc_id(); b.st = st;
    if (threadIdx.x == 0) (void)xb_add(&bar[XB_XCNT(b.x)], 1u);
    return b;
}
__device__ __forceinline__ void xcd_barrier_complete(unsigned* bar, unsigned x, unsigned& nloc, unsigned& nx) {
    const unsigned G = gridDim.x * gridDim.y * gridDim.z;
    unsigned sum, cnt, mine, sp = 0u;
    for (;;) {
        sum = 0u; cnt = 0u; mine = 0u;
#pragma unroll
        for (unsigned j = 0; j < 16; ++j) { const unsigned c = xb_ld(&bar[XB_XCNT(j)]); sum += c; cnt += (c > 0u) ? 1u : 0u; mine = (j == x) ? c : mine; }
        if (sum == G) break;
        __builtin_amdgcn_s_sleep(1);
        if ((++sp & 255u) == 0u) { if (xb_ld(&bar[XB_TMO])) break; if (sp > XB_SPIN_CAP) { atomicAdd(&bar[XB_TMO], 1u); break; } }
    }
    nloc = mine > 0u ? mine : 1u; nx = cnt > 0u ? cnt : 1u;
}

__device__ __forceinline__ void xcd_barrier(const XcdBarrier& b) {
    asm volatile("s_waitcnt vmcnt(0)" ::: "memory");
    __syncthreads();
    if (threadIdx.x == 0) {
        unsigned* bar = b.bar;
        __builtin_amdgcn_s_waitcnt(0);
        unsigned nloc = b.st[0], nx = b.st[1];
        if (nloc == 0u) { xcd_barrier_complete(bar, b.x, nloc, nx); b.st[0] = nloc; b.st[1] = nx; }
        const unsigned old = xb_add(&bar[XB_XSUB(b.x)], 1u);
        const unsigned gen = old / nloc;
        if (old + 1u == (gen + 1u) * nloc) {
            __builtin_amdgcn_fence(__ATOMIC_RELEASE, "agent");
            asm volatile("s_waitcnt vmcnt(0)" ::: "memory");
            const unsigned og = xb_add(&bar[XB_TOP], 1u);
            const unsigned tg = og / nx;
            if (og + 1u == (tg + 1u) * nx) xb_add(&bar[XB_TOPGEN], 1u);
            else XB_SPIN(xb_ld(&bar[XB_TOPGEN]) == tg, bar);
            __builtin_amdgcn_fence(__ATOMIC_ACQUIRE, "agent");
            xb_add(&bar[XB_XGEN(b.x)], 1u);
            asm volatile("s_waitcnt vmcnt(0)" ::: "memory");
        } else {
            XB_SPIN(xb_ld(&bar[XB_XGEN(b.x)]) == gen, bar);
            __builtin_amdgcn_fence(__ATOMIC_ACQUIRE, "agent");
            asm volatile("s_waitcnt vmcnt(0)" ::: "memory");
        }
    }
    __syncthreads();
}

__global__ void __launch_bounds__(512, 2) yoco_fwd(Args a_unused) {
    extern __shared__ __attribute__((aligned(16))) unsigned char lds[];
    cg::grid_group grid = cg::this_grid();
    KArgs a0 = kargs();
    volatile LAS unsigned* MISC = (volatile LAS unsigned*)((LAS unsigned char*)lds + 131072 + 320);
    if (threadIdx.x < 32) MISC[threadIdx.x] = 0u;
    __syncthreads();
    XcdBarrier xbar = xcd_barrier_post((unsigned*)(a0->ws) + 4096, MISC + 8);
    const int G = gridDim.x, lo = a0->ph_lo, hi = a0->ph_hi;
    PG8_LAS unsigned char* ldsl = (PG8_LAS unsigned char*)lds;
#define WSL() KArgs a = kargs(); unsigned char* ws = a->ws; float* xo = a->out; const float* ada = (const float*)(ws + WS_ADA) + (size_t)l * 8 * 6144; const float* xin = (l == 0) ? a->in[0] : xo; (void)ada; (void)xin; (void)xo; const int Gl = lsi(G), bxl = lsi((int)blockIdx.x); (void)Gl; (void)bxl
#ifndef REP_ATT
#define REP_ATT 1
#endif
#ifndef REP_UP
#define REP_UP 1
#endif
#ifndef REP_NORM
#define REP_NORM 1
#endif
#ifndef REP_SYNC
#define REP_SYNC 1
#endif
#ifndef REP_S5
#define REP_S5 1
#endif
#ifndef REP_PROJ
#define REP_PROJ 1
#endif
#ifndef REP_RES
#define REP_RES 1
#endif
#ifndef REP_KL
#define REP_KL 0
#endif
#ifndef REP_P0
#define REP_P0 1
#endif
#define IN(k) (lo <= (k) && (k) < hi)
#define SEAM(k) do { if (IN(k) && IN((k) + 1)) for (int rep_ = 0; rep_ < REP_SYNC; ++rep_) { if (a0->coop == 2) grid.sync(); xcd_barrier(xbar); } } while (0)
    if (IN(0)) for (int rep = 0; rep < REP_P0; ++rep) { phase0(kargs(), lds, G); __syncthreads(); }
    SEAM(0);
    for (int l = 0; l < 4; ++l) {
        const int pb = 1 + 8 * l;
        if (l < 2) {
            if (IN(pb + 0)) for (int rep = 0; rep < REP_NORM; ++rep) { WSL(); s5_norm_phase(a, l, xin, lds, G); }
            SEAM(pb + 0);
            if (IN(pb + 1)) for (int rep = 0; rep < REP_S5; ++rep) { WSL(); pg8::Gemm g{(const bf16*)(ws + WS_AUG), (const bf16*)(ws + WS_S5WE) + (size_t)l * 64 * 256 * 256, 64 * 2048, 256, 256, AUGK, 256};
                GroupOrder S{Gl, bxl}; EpiE E{(float*)(ws + WS_EBUF)};
                pg8::gemm_phase<EpiE, GroupOrder, true, true>(ldsl, g, S, E); }
            if (IN(pb + 1)) { asm volatile("s_waitcnt vmcnt(0)" ::: "memory"); __syncthreads(); carry_phase(kargs(), l, G); asm volatile("s_waitcnt vmcnt(0)" ::: "memory"); __syncthreads(); }
            if (IN(pb + 1)) for (int rep = 0; rep < REP_S5; ++rep) { WSL(); pg8::Gemm g{(const bf16*)(ws + WS_AUG), (const bf16*)(ws + WS_S5WT) + (size_t)l * 64 * 256 * AUGK, 64 * 2048, 256, AUGK, AUGK, AUGK};
                GroupOrder S{Gl, bxl}; EpiY E{(bf16*)(ws + WS_XN)};
                pg8::gemm_phase<EpiY, GroupOrder, true, true>(ldsl, g, S, E); }
            SEAM(pb + 3);
            if (IN(pb + 4)) for (int rep = 0; rep < REP_RES; ++rep) { WSL(); pg8::Gemm g{(const bf16*)(ws + WS_XN), (const bf16*)(ws + WS_WGLU) + (size_t)l * 1024 * 1024, T, 1024, 1024, 1024, 1024};
                pg8::StaticOrder S; S.init(T, 1024, Gl, bxl); EpiGlu E{(const bf16*)(ws + WS_XN), a->in[19] + l * 1024, rep ? (const float*)(ws + 262144) : ada + 2048, rep ? xo : xin, xo};
                pg8::gemm_phase<EpiGlu, pg8::StaticOrder, true, true>(ldsl, g, S, E); }
            SEAM(pb + 4);
        } else {
            const int j = l - 2;
            if (IN(pb + 0)) for (int rep = 0; rep < REP_NORM; ++rep) { WSL(); const float* kva = (const float*)(ws + WS_KVADA);
                norm_phase(xo, a->in[5] + l * 1024, ada, ada + 1024, 6144, (bf16*)(ws + WS_XN), a->in[22], kva, kva + 1024, 2048, (j == 0) ? (bf16*)(ws + WS_XK) : nullptr, G); }
            SEAM(pb + 0);
            if (IN(pb + 1)) { WSL();
                { pg8::Gemm g{(const bf16*)(ws + WS_XN), (const bf16*)(ws + WS_WDQ) + (size_t)j * 256 * 1024, T, 256, 1024, 1024, 1024};
                  pg8::StaticOrder S; S.init(T, 256, Gl, bxl); EpiDq E{(bf16*)(ws + WS_QA), (float*)(ws + WS_QSS) + (size_t)j * T};
                  pg8::gemm_phase<EpiDq, pg8::StaticOrder, true, true>(ldsl, g, S, E); }
                if (j == 0) { pg8::Gemm g{(const bf16*)(ws + WS_XK), (const bf16*)(ws + WS_WKVA), T, 512, 1024, 1024, 1024};
                  pg8::StaticOrder S; S.init(T, 512, Gl, bxl); EpiKva E{(bf16*)(ws + WS_CKV), (float*)(ws + WS_KSS), (bf16*)(ws + WS_KR), a->in[27], (const float*)(ws + WS_COS), (const float*)(ws + WS_SIN)};
                  pg8::gemm_phase<EpiKva, pg8::StaticOrder, true, true>(ldsl, g, S, E); }
            }
            SEAM(pb + 1);
            if (IN(pb + 2)) for (int rep = 0; rep < REP_PROJ; ++rep) { WSL();
                { pg8::Gemm g{(const bf16*)(ws + WS_QA), (const bf16*)(ws + WS_WUQ) + (size_t)j * 1536 * 256, T, 1536, 256, 256, 256};
                  pg8::StaticOrder S; S.init(T, 1536, Gl, bxl);
                  EpiUq E{(const float*)(ws + WS_QSS) + (size_t)j * T, a->in[31] + j * 64, a->in[32] + j * 32, (const float*)(ws + WS_COS), (const float*)(ws + WS_SIN), (bf16*)(ws + WS_QB)};
                  pg8::gemm_phase<EpiUq, pg8::StaticOrder, true, true>(ldsl, g, S, E); }
                if (j == 0) { pg8::Gemm g{(const bf16*)(ws + WS_CKV), (const bf16*)(ws + WS_WKVB), T, 2048, 256, 256, 256};
                  pg8::StaticOrder S; S.init(T, 2048, Gl, bxl); EpiKvb E{(const float*)(ws + WS_KSS), a->in[26], (bf16*)(ws + WS_KB), (bf16*)(ws + WS_VB)};
                  pg8::gemm_phase<EpiKvb, pg8::StaticOrder, true, true>(ldsl, g, S, E); }
            }
            SEAM(pb + 2);
            if (IN(pb + 3)) for (int rep = 0; rep < REP_ATT; ++rep) attn_phase(kargs(), lds, G);
            SEAM(pb + 3);
            if (IN(pb + 4)) for (int rep = 0; rep < REP_RES; ++rep) { WSL(); pg8::Gemm g{(const bf16*)(ws + WS_OB), (const bf16*)(ws + WS_WO) + (size_t)j * 1024 * 1024, T, 1024, 1024, 1024, 1024};
                pg8::StaticOrder S; S.init(T, 1024, Gl, bxl); EpiRes E{rep ? (const float*)(ws + 262144) : ada + 2048, xo};
                pg8::gemm_phase<EpiRes, pg8::StaticOrder, true, true>(ldsl, g, S, E); }
            SEAM(pb + 4);
        }
        if (IN(pb + 5)) for (int rep = 0; rep < REP_NORM; ++rep) { WSL(); norm_phase(xo, a->in[6] + l * 1024, ada + 3072, ada + 4096, 6144, (bf16*)(ws + WS_XN), nullptr, nullptr, nullptr, 0, nullptr, G); }
        SEAM(pb + 5);
        if (IN(pb + 6)) for (int rep = 0; rep < REP_UP; ++rep) { WSL(); pg8::Gemm g{(const bf16*)(ws + WS_XN), (const bf16*)(ws + WS_WGU) + (size_t)l * 5632 * 1024, T, 5632, 1024, 1024, 1024};
            pg8::StaticOrder S; S.init(T, 5632, Gl, bxl); EpiGU E{(bf16*)(ws + WS_HB)};
            pg8::gemm_phase<EpiGU, pg8::StaticOrder, true, true>(ldsl, g, S, E); }
        SEAM(pb + 6);
        if (IN(pb + 7)) for (int rep = 0; rep < REP_RES; ++rep) { WSL(); pg8::Gemm g{(const bf16*)(ws + WS_HB), (const bf16*)(ws + WS_WD) + (size_t)l * 1024 * FF, T, 1024, FF, FF, FF};
            pg8::StaticOrder S; S.init(T, 1024, Gl, bxl); EpiRes E{rep ? (const float*)(ws + 262144) : ada + 5120, xo};
            pg8::gemm_phase<EpiRes, pg8::StaticOrder, true, true>(ldsl, g, S, E); }
        if (IN(pb + 7)) for (int rep = 0; rep < REP_KL; ++rep) { WSL(); pg8::Gemm g{(const bf16*)(ws + WS_HB), (const bf16*)(ws + WS_WD) + (size_t)l * 1024 * FF, T, 1024, FF, FF, FF};
            pg8::StaticOrder S; S.init(T, 1024, Gl, bxl); EpiNone E{(float*)(ws + 262144)};
            pg8::gemm_phase<EpiNone, pg8::StaticOrder, true, true>(ldsl, g, S, E); }
        SEAM(pb + 7);
    }
#undef IN
#undef SEAM
}

#ifndef MK_PER_PHASE
#define MK_PER_PHASE 0
#endif
extern "C" void kernel_launch(void* const* d_in, const int* in_sizes, int n_in, void* d_out, int out_size, void* d_ws, size_t ws_size, hipStream_t stream) {
    static int grid = 0;
    if (grid == 0) {
        if (n_in != 34 || out_size != T * DM || ws_size < WS_END) { fprintf(stderr, "kernel_launch: unexpected shapes (n_in %d out %d ws %zu)\n", n_in, out_size, ws_size); grid = -1; return; }
        int dev = 0, cus = 0, per_cu = 0;
        if (hipGetDevice(&dev) != hipSuccess || hipDeviceGetAttribute(&cus, hipDeviceAttributeMultiprocessorCount, dev) != hipSuccess) { grid = -1; return; }
        if (hipFuncSetAttribute((const void*)yoco_fwd, hipFuncAttributeMaxDynamicSharedMemorySize, LDS_BYTES) != hipSuccess) { fprintf(stderr, "kernel_launch: hipFuncSetAttribute failed\n"); grid = -1; return; }
        if (hipOccupancyMaxActiveBlocksPerMultiprocessor(&per_cu, (const void*)yoco_fwd, 512, LDS_BYTES) != hipSuccess || per_cu < 1) per_cu = 1;
        (void)hipGetLastError();
        grid = cus * per_cu;
    }
    if (grid < 0) return;
    Args ha{};
    for (int i = 0; i < 34; ++i) ha.in[i] = (const float*)d_in[i];
    ha.out = (float*)d_out; ha.ws = (unsigned char*)d_ws;
#if MK_PER_PHASE
    for (int ph = 0; ph < NPHASE; ++ph) { ha.ph_lo = ph; ha.ph_hi = ph + 1; ha.coop = 0;
        hipLaunchKernelGGL(yoco_fwd, dim3(grid), dim3(512), LDS_BYTES, stream, ha); }
#else
    (void)hipMemsetAsync(d_ws, 0, 524288, stream);
    ha.ph_lo = 0; ha.ph_hi = NPHASE; ha.coop = 1;
    void* args[] = {&ha};
    const hipError_t e = hipLaunchCooperativeKernel((const void*)yoco_fwd, dim3(grid), dim3(512), args, LDS_BYTES, stream);
    if (e != hipSuccess) fprintf(stderr, "kernel_launch: cooperative launch failed: %s (grid %d)\n", hipGetErrorString(e), grid);
#endif
}
```

```cpp
#include <hip/hip_runtime.h>
#include <hip/hip_cooperative_groups.h>
#include <cstdio>
#include <cstdint>
namespace cg = cooperative_groups;
namespace pg8 {
#define PG8_LAS __attribute__((address_space(3)))
typedef unsigned short bf16_t;
typedef short bf16x8 __attribute__((ext_vector_type(8)));
typedef float f32x4 __attribute__((ext_vector_type(4)));
typedef unsigned u32x4 __attribute__((ext_vector_type(4)));
constexpr int BM = 256, BK = 64, HALF = 128, HTB = HALF * BK * 2  , STAGE_BYTES = 8 * HTB, NXCD = 8, WGM = 8;

__host__ __device__ __forceinline__ int lds_byte(int r, int c) { const int st = (r >> 4) * 2 + (c >> 5), rr = r & 15, cc = c & 31, ob = rr * 64 + cc * 2; return st * 1024 + (ob ^ (((ob >> 9) & 1) << 5)); }
__host__ __device__ __forceinline__ void stage_rc(int b, int& R, int& C) { const int st = b / 1024, sb = b % 1024, swz = sb ^ (((sb >> 9) & 1) << 5); R = (st >> 1) * 16 + swz / 64; C = (st & 1) * 32 + (swz % 64) / 2; }
__host__ __device__ __forceinline__ int perm32(int rho) { const int n = rho >> 4, i = rho & 15; return 8 * (i >> 2) + 4 * n + (i & 3); }

struct Unit { int pm, pn; };
struct Gemm { const bf16_t* A; const bf16_t* Bt; int M, N, K, lda, ldb; };

struct StaticOrder {
    int nM, nN, nwg, G, c;
    __host__ __device__ void init(int M, int N, int G_, int c_) { nM = M / BM; nN = N / BM; nwg = nM * nN; G = G_; c = c_; }
    __host__ __device__ bool next(int i, Unit& u) const {
        const long L = (long)i * G + c; if (L >= nwg) return false;
        int wgid = (int)L; { const int q = nwg / NXCD, r = nwg % NXCD, xcd = wgid % NXCD, off = wgid / NXCD; wgid = (xcd < r ? xcd * (q + 1) : r * (q + 1) + (xcd - r) * q) + off; }
        const int nig = WGM * nN, gid = wgid / nig, fm = gid * WGM, gsz = (nM - fm) < WGM ? (nM - fm) : WGM;
        u.pm = fm + ((wgid % nig) % gsz); u.pn = (wgid % nig) / gsz; return true;
    }
    __device__ __forceinline__ void a_ready(const Unit&) const {}
    __device__ __forceinline__ void done(const Unit&) const {}
};

__device__ __forceinline__ unsigned cvt_pk_bf16(float lo, float hi) { unsigned r; asm volatile("v_cvt_pk_bf16_f32 %0, %1, %2" : "=v"(r) : "v"(lo), "v"(hi)); return r; }
typedef float f32x2 __attribute__((ext_vector_type(2)));
template <class Epi, class Sched, bool ALIGN_EPI = false, bool SP2 = false>
__device__ __forceinline__ void gemm_phase(PG8_LAS unsigned char* lds, const Gemm g, const Sched& S, const Epi& E) {
    int tid_l = threadIdx.x; asm volatile("" : "+v"(tid_l)); const int tid = tid_l, wid = __builtin_amdgcn_readfirstlane(tid >> 6), lane = tid & 63, wr = wid >> 2, wc = wid & 3, fr = lane & 15, fq = lane >> 4;
    int K_l = g.K; asm volatile("" : "+s"(K_l)); const int K = K_l, nt = K / BK;
    unsigned voffA[2], voffB[2];
#pragma unroll
    for (int i = 0; i < 2; ++i) { int R, C; stage_rc(tid * 16 + i * 8192, R, C); const int Rb = Epi::PERM ? ((R & ~31) + perm32(R & 31)) : R;
        voffA[i] = (unsigned)(R * g.lda + C) * 2u; voffB[i] = (unsigned)(Rb * g.ldb + C) * 2u; }
    const size_t kstep = (size_t)(BK * 2);
    const size_t hstepA = (size_t)HALF * g.lda * 2, hstepB = (size_t)HALF * g.ldb * 2;
    const size_t tstepA = 2 * hstepA, tstepB = 2 * hstepB;
    const unsigned ldsw = (unsigned)wid * 1024u;
    const int aoff = lds_byte(wr * 64 + fr, fq * 8), boff = lds_byte(wc * 32 + fr, fq * 8);
#define PG8_SA(b, h) (((b) * 2 + (h)) * HTB)
#define PG8_SB(b, h) ((4 + (b) * 2 + (h)) * HTB)
#define PG8_STAGE(bufoff, gbase, voff) do { _Pragma("unroll") for (int _i = 0; _i < 2; ++_i) \
        __builtin_amdgcn_global_load_lds((const unsigned*)((const char*)(gbase) + (voff)[_i]), (PG8_LAS unsigned*)(lds + (bufoff) + ldsw + _i * 8192), 16, 0, 0); } while (0)
#define PG8_LDA(dst, b, h) do { _Pragma("unroll") for (int m = 0; m < 4; ++m) _Pragma("unroll") for (int k = 0; k < 2; ++k) dst[m][k] = *(const PG8_LAS bf16x8*)(lds + PG8_SA(b, h) + aoff + m * 2048 + k * 1024); } while (0)
#define PG8_LDB(dst, b, h) do { _Pragma("unroll") for (int n = 0; n < 2; ++n) _Pragma("unroll") for (int k = 0; k < 2; ++k) dst[n][k] = *(const PG8_LAS bf16x8*)(lds + PG8_SB(b, h) + boff + n * 2048 + k * 1024); } while (0)
#define PG8_MMA(ai, bj, At, Bt) do { __builtin_amdgcn_s_setprio(1); _Pragma("unroll") for (int m = 0; m < 4; ++m) _Pragma("unroll") for (int n = 0; n < 2; ++n) _Pragma("unroll") for (int k = 0; k < 2; ++k) \
        acc[ai][bj][m][n] = __builtin_amdgcn_mfma_f32_16x16x32_bf16(Bt[n][k], At[m][k], acc[ai][bj][m][n], 0, 0, 0); __builtin_amdgcn_s_setprio(0); } while (0)
#define PG8_WAIT_V(n) asm volatile("s_waitcnt vmcnt(" #n ")" ::: "memory")
#define PG8_WAIT_L(n) asm volatile("s_waitcnt lgkmcnt(" #n ")" ::: "memory")
#define PG8_BAR __builtin_amdgcn_s_barrier()
#define PG8_SCHED __builtin_amdgcn_sched_barrier(0)
    Unit cur, nxt; int ui = 0;
    if (!S.next(0, cur)) return;
    f32x4 acc[2][2][4][2];
#pragma unroll
    for (int a = 0; a < 2; ++a)
#pragma unroll
        for (int b = 0; b < 2; ++b)
#pragma unroll
            for (int m = 0; m < 4; ++m)
#pragma unroll
                for (int n = 0; n < 2; ++n) acc[a][b][m][n] = (f32x4){0.f, 0.f, 0.f, 0.f};
    bf16x8 At[4][2], B0[2][2], B1[2][2];
    const char* cA = (const char*)g.A + (size_t)cur.pm * tstepA; const char* cB = (const char*)g.Bt + (size_t)cur.pn * tstepB;
    S.a_ready(cur);
    if constexpr (SP2) {
        PG8_STAGE(PG8_SB(0, 0), cB, voffB); PG8_STAGE(PG8_SB(0, 1), cB + hstepB, voffB); PG8_STAGE(PG8_SA(0, 0), cA, voffA); PG8_STAGE(PG8_SA(0, 1), cA + hstepA, voffA);
        if (wr == 1) PG8_BAR;
        PG8_WAIT_V(2); PG8_BAR;
        PG8_STAGE(PG8_SB(1, 0), cB + kstep, voffB); PG8_STAGE(PG8_SA(1, 0), cA + kstep, voffA); PG8_STAGE(PG8_SB(1, 1), cB + hstepB + kstep, voffB);
        PG8_WAIT_V(6); PG8_BAR;
    } else {
        PG8_STAGE(PG8_SB(0, 0), cB, voffB); PG8_STAGE(PG8_SA(0, 0), cA, voffA); PG8_STAGE(PG8_SB(0, 1), cB + hstepB, voffB); PG8_STAGE(PG8_SA(0, 1), cA + hstepA, voffA);
        if (wr == 1) PG8_BAR;
        PG8_WAIT_V(4); PG8_BAR;
        PG8_STAGE(PG8_SB(1, 0), cB + kstep, voffB); PG8_STAGE(PG8_SA(1, 0), cA + kstep, voffA); PG8_STAGE(PG8_SB(1, 1), cB + hstepB + kstep, voffB);
        PG8_WAIT_V(6); PG8_BAR;
    }
    for (;;) {
        const bool has_next = S.next(ui + 1, nxt);
        const char* nA = has_next ? (const char*)g.A + (size_t)nxt.pm * tstepA : cA; const char* nB = has_next ? (const char*)g.Bt + (size_t)nxt.pn * tstepB : cB;
        for (int t = 0; t < nt; t += 2) {
            const bool last = (t == nt - 2);
            const char* a1 = cA + (size_t)(t + 1) * kstep;
            const char* a2 = last ? nA : cA + (size_t)(t + 2) * kstep; const char* b2 = last ? nB : cB + (size_t)(t + 2) * kstep;
            const char* a3 = a2 + kstep; const char* b3 = b2 + kstep;
            if (last && has_next) S.a_ready(nxt);
            if constexpr (SP2) {
            PG8_LDB(B0, 0, 0); PG8_LDB(B1, 0, 1); PG8_SCHED; PG8_LDA(At, 0, 0); PG8_STAGE(PG8_SA(1, 1), a1 + hstepA, voffA);
            PG8_WAIT_V(8); PG8_WAIT_L(0); PG8_BAR; PG8_MMA(0, 0, At, B0); PG8_MMA(0, 1, At, B1); PG8_BAR; PG8_SCHED;
            PG8_LDA(At, 0, 1); PG8_STAGE(PG8_SB(0, 0), b2, voffB); PG8_STAGE(PG8_SB(0, 1), b2 + hstepB, voffB); PG8_STAGE(PG8_SA(0, 0), a2, voffA);
            PG8_WAIT_V(8); PG8_WAIT_L(0); PG8_BAR; PG8_MMA(1, 0, At, B0); PG8_MMA(1, 1, At, B1); PG8_BAR; PG8_SCHED;
            PG8_LDB(B0, 1, 0); PG8_LDB(B1, 1, 1); PG8_SCHED; PG8_LDA(At, 1, 0); PG8_STAGE(PG8_SA(0, 1), a2 + hstepA, voffA);
            PG8_WAIT_V(8); PG8_WAIT_L(0); PG8_BAR; PG8_MMA(0, 0, At, B0); PG8_MMA(0, 1, At, B1); PG8_BAR; PG8_SCHED;
            PG8_LDA(At, 1, 1); PG8_STAGE(PG8_SB(1, 0), b3, voffB); PG8_STAGE(PG8_SB(1, 1), b3 + hstepB, voffB); PG8_STAGE(PG8_SA(1, 0), a3, voffA);
            PG8_WAIT_V(8); PG8_WAIT_L(0); PG8_BAR; PG8_MMA(1, 0, At, B0); PG8_MMA(1, 1, At, B1); PG8_BAR; PG8_SCHED;
            } else {
            PG8_LDB(B0, 0, 0); PG8_SCHED; PG8_LDA(At, 0, 0); PG8_STAGE(PG8_SA(1, 1), a1 + hstepA, voffA);
            PG8_WAIT_L(8); PG8_BAR; PG8_WAIT_L(0); PG8_MMA(0, 0, At, B0); PG8_BAR; PG8_SCHED;
            PG8_LDB(B1, 0, 1); PG8_STAGE(PG8_SB(0, 0), b2, voffB);
            PG8_BAR; PG8_WAIT_L(0); PG8_MMA(0, 1, At, B1); PG8_BAR;
            PG8_LDA(At, 0, 1); PG8_STAGE(PG8_SA(0, 0), a2, voffA);
            PG8_BAR; PG8_WAIT_L(0); PG8_MMA(1, 0, At, B0); PG8_BAR; PG8_SCHED;
            PG8_STAGE(PG8_SB(0, 1), b2 + hstepB, voffB);
            PG8_WAIT_V(6); PG8_BAR; PG8_MMA(1, 1, At, B1); PG8_BAR;
            PG8_LDB(B0, 1, 0); PG8_SCHED; PG8_LDA(At, 1, 0); PG8_STAGE(PG8_SA(0, 1), a2 + hstepA, voffA);
            PG8_WAIT_L(8); PG8_BAR; PG8_WAIT_L(0); PG8_MMA(0, 0, At, B0); PG8_BAR; PG8_SCHED;
            PG8_LDB(B1, 1, 1); PG8_STAGE(PG8_SB(1, 0), b3, voffB);
            PG8_BAR; PG8_WAIT_L(0); PG8_MMA(0, 1, At, B1); PG8_BAR;
            PG8_LDA(At, 1, 1); PG8_STAGE(PG8_SA(1, 0), a3, voffA);
            PG8_BAR; PG8_WAIT_L(0); PG8_MMA(1, 0, At, B0); PG8_BAR; PG8_SCHED;
            PG8_STAGE(PG8_SB(1, 1), b3 + hstepB, voffB);
            PG8_WAIT_V(6); PG8_BAR; PG8_MMA(1, 1, At, B1); PG8_BAR;
            }
        }
        if constexpr (ALIGN_EPI) { if (wr == 0) PG8_BAR; }
        if constexpr (!Epi::AFTER_DRAIN) { E(acc, cur, wr, wc, fr, fq); S.done(cur); }
        if (!has_next) break;
#pragma unroll
        for (int a = 0; a < 2; ++a)
#pragma unroll
            for (int b = 0; b < 2; ++b)
#pragma unroll
                for (int m = 0; m < 4; ++m)
#pragma unroll
                    for (int n = 0; n < 2; ++n) acc[a][b][m][n] = (f32x4){0.f, 0.f, 0.f, 0.f};
        cur = nxt; cA = nA; cB = nB; ++ui;
        if constexpr (ALIGN_EPI) { if (wr == 1) PG8_BAR; }
    }
    PG8_WAIT_V(0);
    if constexpr (!ALIGN_EPI) { if (wr == 0) PG8_BAR; }
    PG8_BAR;
    if constexpr (Epi::AFTER_DRAIN) { E.fused(acc, cur, wr, wc, fr, fq, lds, wid, lane); S.done(cur); }
#undef PG8_SA
#undef PG8_SB
#undef PG8_STAGE
#undef PG8_LDA
#undef PG8_LDB
#undef PG8_MMA
#undef PG8_WAIT_V
#undef PG8_WAIT_L
#undef PG8_BAR
#undef PG8_SCHED
}
}

constexpr int NB = 8, SEQ = 4096, DM = 1024, T = NB * SEQ, FF = 2816, NH = 16;
constexpr int SUB = 16, NSUB = SEQ / SUB, AUGK = 384;
constexpr float EPS = 1e-6f;
constexpr size_t MiB = 1u << 20;
constexpr size_t WS_ADA = 1 * MiB;
constexpr size_t WS_KVADA = WS_ADA + 800 * 1024;
constexpr size_t WS_COS = 2 * MiB, WS_SIN = 4 * MiB;
constexpr size_t WS_QSS = 6 * MiB;
constexpr size_t WS_KSS = WS_QSS + 2 * T * 4, WS_A16 = WS_KSS + T * 4;
constexpr size_t WS_KR = 7 * MiB;
constexpr size_t WS_WGU = 10 * MiB;
constexpr size_t WS_WD = WS_WGU + 44 * MiB;
constexpr size_t WS_WGLU = WS_WD + 22 * MiB;
constexpr size_t WS_WDQ = WS_WGLU + 4 * MiB;
constexpr size_t WS_WKVA = WS_WDQ + 1 * MiB;
constexpr size_t WS_WUQ = WS_WKVA + 1 * MiB;
constexpr size_t WS_WKVB = WS_WUQ + 3 * MiB / 2;
constexpr size_t WS_WO = WS_WKVB + 1 * MiB;
constexpr size_t WS_S5WT = 89 * MiB;
constexpr size_t WS_S5WE = WS_S5WT + 24 * MiB;
constexpr size_t WS_CKV = WS_S5WT, WS_QA = WS_S5WT + 16 * MiB;
constexpr size_t WS_XN = 129 * MiB;
constexpr size_t WS_HB = 193 * MiB;
constexpr size_t WS_AUG = WS_HB, WS_EBUF = WS_HB + 96 * MiB;
constexpr size_t WS_QB = WS_HB, WS_XK = WS_HB + 96 * MiB, WS_OB = WS_XK;
constexpr size_t WS_KB = 369 * MiB, WS_VB = 433 * MiB, WS_END = 497 * MiB;
static_assert(WS_WO + 4 * MiB <= WS_S5WT && WS_S5WE + 16 * MiB <= WS_XN, "ws map");

constexpr int LDS_BYTES = 147456;
constexpr int NPHASE = 33;

typedef unsigned short bf16;
typedef unsigned v4u __attribute__((ext_vector_type(4)));
typedef unsigned v2u __attribute__((ext_vector_type(2)));
typedef float f32x4 __attribute__((ext_vector_type(4)));
typedef float f32x2 __attribute__((ext_vector_type(2)));

__device__ __forceinline__ unsigned f2bf(float f) { unsigned u = __builtin_bit_cast(unsigned, f); return (u + 0x7fffu + ((u >> 16) & 1u)) >> 16; }
__device__ __forceinline__ unsigned pk2(float lo, float hi) { return f2bf(lo) | (f2bf(hi) << 16); }
__device__ __forceinline__ float bflo(unsigned w) { return __builtin_bit_cast(float, w << 16); }
__device__ __forceinline__ float bfhi(unsigned w) { return __builtin_bit_cast(float, w & 0xffff0000u); }
__device__ __forceinline__ float shx(float v, int lane, int o) { return __builtin_bit_cast(float, __builtin_amdgcn_ds_bpermute((lane ^ o) << 2, __builtin_bit_cast(int, v))); }
__device__ __forceinline__ float wave_sum(float v, int lane) {
#pragma unroll
    for (int o = 1; o < 64; o <<= 1) v += shx(v, lane, o);
    return v;
}
__device__ __forceinline__ float sigm(float z) { return __builtin_amdgcn_rcpf(1.f + __expf(-z)); }
__device__ __forceinline__ float gelu_tanh(float x) { const float u = 0.7978845608028654f * (x + 0.044715f * x * x * x); return x * __builtin_amdgcn_rcpf(1.f + __expf(-2.f * u)); }
__device__ __forceinline__ f32x2 cmul(f32x2 a, f32x2 b) { return (f32x2){a.x * b.x - a.y * b.y, a.x * b.y + a.y * b.x}; }
__device__ __forceinline__ void dsincos(double x, double& s, double& c) {
    const double q = __builtin_rint(x * 0.63661977236758134308);
    double r = __builtin_fma(-q, 1.57079632679489655800, x); r = __builtin_fma(-q, 6.12323399573676603587e-17, r);
    const double r2 = r * r;
    double sp = 1.0 / 6227020800.0; sp = -1.0 / 39916800.0 + r2 * sp; sp = 1.0 / 362880.0 + r2 * sp; sp = -1.0 / 5040.0 + r2 * sp; sp = 1.0 / 120.0 + r2 * sp; sp = -1.0 / 6.0 + r2 * sp;
    const double s0 = r + r * r2 * sp;
    double cp = 1.0 / 479001600.0; cp = -1.0 / 3628800.0 + r2 * cp; cp = 1.0 / 40320.0 + r2 * cp; cp = -1.0 / 720.0 + r2 * cp; cp = 1.0 / 24.0 + r2 * cp; cp = -0.5 + r2 * cp;
    const double c0 = 1.0 + r2 * cp;
    const int n = ((int)q) & 3;
    s = (n == 0) ? s0 : (n == 1) ? c0 : (n == 2) ? -s0 : -c0;
    c = (n == 0) ? c0 : (n == 1) ? -s0 : (n == 2) ? -c0 : s0;
}

__device__ __forceinline__ int lv(int v) { asm volatile("" : "+v"(v)); return v; }
__device__ __forceinline__ int lsi(int v) { asm volatile("" : "+s"(v)); return v; }
template <class TP> __device__ __forceinline__ TP* ls(TP* p) { asm volatile("" : "+s"(p)); return p; }
struct Args { const float* in[34]; float* out; unsigned char* ws; int ph_lo, ph_hi, coop, pad; };
typedef const __attribute__((address_space(4))) Args* KArgs;
__device__ __forceinline__ KArgs kargs() { KArgs p = (KArgs)__builtin_amdgcn_kernarg_segment_ptr(); asm volatile("" : "+s"(p)); return p; }

__device__ __forceinline__ void tr_item(const float* W, int ldw, int k0, int n0, bf16* dst, int ldd, const float* kscale, float* scr, int lane) {
#pragma unroll 8
    for (int i = 0; i < 32; ++i) { const int kk = 2 * i + (lane >> 5); float v = W[(size_t)(k0 + kk) * ldw + n0 + (lane & 31)]; if (kscale) v *= kscale[k0 + kk]; scr[kk * 33 + (lane & 31)] = v; }
    const int c = lane & 7;
#pragma unroll
    for (int j = 0; j < 4; ++j) { const int n = (lane >> 3) + 8 * j; const float* s = scr + (8 * c) * 33 + n;
        v4u o; o.x = pk2(s[0 * 33], s[1 * 33]); o.y = pk2(s[2 * 33], s[3 * 33]); o.z = pk2(s[4 * 33], s[5 * 33]); o.w = pk2(s[6 * 33], s[7 * 33]);
        *(v4u*)(dst + (size_t)n * ldd + k0 + 8 * c) = o; }
}

__device__ __forceinline__ void ada_item(KArgs a, int it, float* cact, float* part, int tid) {
    const int lane = tid & 63, wave = tid >> 6;
    const int col0 = it * 128;
    const float* W; const float* bias; float* out; int ldw;
    if (col0 < 4 * 6144) { const int l = col0 / 6144, cc = col0 - l * 6144; W = a->in[3] + (size_t)l * 1024 * 6144 + cc; ldw = 6144; bias = a->in[4] + l * 6144 + cc; out = (float*)(a->ws + WS_ADA) + (size_t)l * 8 * 6144 + cc; }
    else { const int cc = col0 - 4 * 6144; W = a->in[20] + cc; ldw = 2048; bias = a->in[21] + cc; out = (float*)(a->ws + WS_KVADA) + cc; }
    float acc[8][2];
#pragma unroll
    for (int b = 0; b < 8; ++b) { acc[b][0] = 0.f; acc[b][1] = 0.f; }
    const float* wp = W + (size_t)(wave * 128) * ldw + 2 * lane;
    const float* cp = cact + wave * 128 * 8;
#pragma unroll 8
    for (int k = 0; k < 128; ++k) {
        const f32x2 w2 = *(const f32x2*)(wp + (size_t)k * ldw);
        const f32x4 c0 = *(const f32x4*)(cp + k * 8), c1 = *(const f32x4*)(cp + k * 8 + 4);
        acc[0][0] += c0.x * w2.x; acc[0][1] += c0.x * w2.y; acc[1][0] += c0.y * w2.x; acc[1][1] += c0.y * w2.y;
        acc[2][0] += c0.z * w2.x; acc[2][1] += c0.z * w2.y; acc[3][0] += c0.w * w2.x; acc[3][1] += c0.w * w2.y;
        acc[4][0] += c1.x * w2.x; acc[4][1] += c1.x * w2.y; acc[5][0] += c1.y * w2.x; acc[5][1] += c1.y * w2.y;
        acc[6][0] += c1.z * w2.x; acc[6][1] += c1.z * w2.y; acc[7][0] += c1.w * w2.x; acc[7][1] += c1.w * w2.y;
    }
#pragma unroll
    for (int b = 0; b < 8; ++b) *(f32x2*)(part + (wave * 8 + b) * 128 + 2 * lane) = (f32x2){acc[b][0], acc[b][1]};
    __syncthreads();
    for (int o = tid; o < 1024; o += 512) { const int b = o >> 7, col = o & 127; float s = bias[col];
#pragma unroll
        for (int w = 0; w < 8; ++w) s += part[(w * 8 + b) * 128 + col];
        out[(size_t)b * ldw + col] = s; }
    __syncthreads();
}

__device__ __forceinline__ void s5prep_item(KArgs a, int l, int g, unsigned char* sm, int tid) {
    f32x2* apw = (f32x2*)sm;
    f32x2* bbv = (f32x2*)(sm + 8704);
    f32x2* ccv = (f32x2*)(sm + 16896);
    float* Kt = (float*)(sm + 25088);
    f32x2* fv = (f32x2*)(sm + 41472);
    const int lg = l * 64 + g;
    const float* lam_re = a->in[10] + lg * 64; const float* lam_im = a->in[11] + lg * 64;
    const float* b_re = a->in[13] + (size_t)lg * 64 * 16; const float* b_im = a->in[14] + (size_t)lg * 64 * 16;
    const float* c_re = a->in[15] + (size_t)lg * 16 * 64; const float* c_im = a->in[16] + (size_t)lg * 16 * 64;
    const float* dsk = a->in[17] + l * 1024 + g * 16;
    if (tid < 64) {
        const int n = tid; const double dt = exp((double)a->in[12][lg]); const double lr = lam_re[n], li = lam_im[n];
        const double mag = exp(lr * dt); double s, c; dsincos(li * dt, s, c); const double ar = mag * c, ai = mag * s;
        double pr = 1.0, pi = 0.0;
        for (int k = 0; k <= 16; ++k) { apw[k * 64 + n] = (f32x2){(float)pr, (float)pi}; const double tr = pr * ar - pi * ai, ti = pr * ai + pi * ar; pr = tr; pi = ti; }
        ((f32x2*)(a->ws + WS_A16))[lg * 64 + n] = apw[16 * 64 + n];
        const double den = lr * lr + li * li, nr = ar - 1.0, ni = ai;
        fv[n] = (f32x2){(float)((nr * lr + ni * li) / den), (float)((ni * lr - nr * li) / den)};
    }
    __syncthreads();
    for (int i = tid; i < 1024; i += 512) { const int n = i >> 4; bbv[i] = cmul(fv[n], (f32x2){b_re[i], b_im[i]}); ccv[i] = (f32x2){c_re[i], c_im[i]}; }
    __syncthreads();
    { const int lag = tid >> 5, p = (tid >> 1) & 15, qh = tid & 1; float acc[8];
#pragma unroll
        for (int q = 0; q < 8; ++q) acc[q] = 0.f;
        for (int n = 0; n < 64; ++n) { const f32x2 w = cmul(ccv[p * 64 + n], apw[lag * 64 + n]);
#pragma unroll
            for (int q = 0; q < 8; ++q) { const f32x2 bq = bbv[n * 16 + qh * 8 + q]; acc[q] += w.x * bq.x - w.y * bq.y; } }
#pragma unroll
        for (int q = 0; q < 8; ++q) Kt[(lag * 16 + p) * 16 + qh * 8 + q] = acc[q]; }
    __syncthreads();
    bf16* WT = (bf16*)(a->ws + WS_S5WT) + (size_t)lg * 256 * AUGK;
    for (int ch = tid; ch < 256 * 48; ch += 512) { const int row = ch / 48, cc = ch - row * 48, t = row >> 4, p = row & 15; float v[8];
        if (cc < 32) { const int s = cc >> 1, qh = cc & 1;
#pragma unroll
            for (int q = 0; q < 8; ++q) { float x = (s <= t) ? Kt[((t - s) * 16 + p) * 16 + qh * 8 + q] : 0.f; if (s == t && qh * 8 + q == p) x += dsk[p]; v[q] = x; } }
        else { const int n0 = (cc - 32) * 4;
#pragma unroll
            for (int k = 0; k < 4; ++k) { const f32x2 w = cmul(ccv[p * 64 + n0 + k], apw[(t + 1) * 64 + n0 + k]); v[2 * k] = w.x; v[2 * k + 1] = -w.y; } }
        v4u o; o.x = pk2(v[0], v[1]); o.y = pk2(v[2], v[3]); o.z = pk2(v[4], v[5]); o.w = pk2(v[6], v[7]);
        *(v4u*)(WT + (size_t)row * AUGK + cc * 8) = o; }
    bf16* WE = (bf16*)(a->ws + WS_S5WE) + (size_t)lg * 256 * 256;
    for (int ch = tid; ch < 256 * 32; ch += 512) { const int row = ch >> 5, cc = ch & 31, s = cc >> 1, qh = cc & 1; float v[8];
        if (row < 128) { const int n = row >> 1, im = row & 1; const f32x2 ap = apw[(15 - s) * 64 + n];
#pragma unroll
            for (int q = 0; q < 8; ++q) { const f32x2 pr = cmul(ap, bbv[n * 16 + qh * 8 + q]); v[q] = im ? pr.y : pr.x; } }
        else {
#pragma unroll
            for (int q = 0; q < 8; ++q) v[q] = 0.f; }
        v4u o; o.x = pk2(v[0], v[1]); o.y = pk2(v[2], v[3]); o.z = pk2(v[4], v[5]); o.w = pk2(v[6], v[7]);
        *(v4u*)(WE + (size_t)row * 256 + cc * 8) = o; }
    __syncthreads();
}

__device__ __forceinline__ void phase0(KArgs a, unsigned char* lds, int G_) { const int G = lsi(G_);
    const int tid = lv(threadIdx.x), lane = tid & 63, wave = tid >> 6;
    float* cact = (float*)lds; float* part = (float*)(lds + 32768);
    for (int i = tid; i < 8192; i += 512) { const int b = i >> 10, k = i & 1023; const float v = a->in[1][i]; cact[k * 8 + b] = v / (1.f + __expf(-v)); }
    __syncthreads();
    for (int it = lsi(blockIdx.x); it < 208 + 128; it += G) {
        if (it < 208) ada_item(a, it, cact, part, tid);
        else { const int r = it - 208; s5prep_item(a, r >> 6, r & 63, lds + 65536, tid); }
    }
    __syncthreads();
    float* scr = (float*)(lds + wave * 16384);
    const int gw = lsi(blockIdx.x) * 8 + wave, NGW = G * 8;
    unsigned char* ws = a->ws;
    constexpr int I_GU = 16 * 88, I_D = 44 * 32, I_SQ = 16 * 32, I_DQ = 16 * 8, I_KVA = 16 * 9, I_UQ = 4 * 48, I_KVB = 4 * 64;
    constexpr int NTR = 8 * I_GU + 4 * I_D + 2 * I_SQ + 2 * I_DQ + I_KVA + 2 * I_UQ + I_KVB + 2 * I_SQ;
    for (int it = gw; it < NTR; it += NGW) {
        int r = it;
        if (r < 8 * I_GU) { const int up = r >= 4 * I_GU; if (up) r -= 4 * I_GU; const int l = r / I_GU; r -= l * I_GU; const int kb = r / 88, n0 = (r % 88) * 32;
            tr_item(a->in[up ? 8 : 7] + (size_t)l * 1024 * FF, FF, kb * 64, n0, (bf16*)(ws + WS_WGU) + ((size_t)l * 5632 + (n0 >> 7) * 256 + up * 128 + (n0 & 127)) * 1024, 1024, nullptr, scr, lane); continue; }
        r -= 8 * I_GU;
        if (r < 4 * I_D) { const int l = r / I_D; r -= l * I_D; const int kb = r / 32, n0 = (r % 32) * 32;
            tr_item(a->in[9] + (size_t)l * FF * 1024, 1024, kb * 64, n0, (bf16*)(ws + WS_WD) + ((size_t)l * 1024 + n0) * FF, FF, nullptr, scr, lane); continue; }
        r -= 4 * I_D;
        if (r < 2 * I_SQ) { const int l = r / I_SQ; r -= l * I_SQ; const int kb = r / 32, n0 = (r % 32) * 32;
            tr_item(a->in[18] + (size_t)l * 1024 * 1024, 1024, kb * 64, n0, (bf16*)(ws + WS_WGLU) + ((size_t)l * 1024 + n0) * 1024, 1024, nullptr, scr, lane); continue; }
        r -= 2 * I_SQ;
        if (r < 2 * I_DQ) { const int l = r / I_DQ; r -= l * I_DQ; const int kb = r / 8, n0 = (r % 8) * 32;
            tr_item(a->in[28] + (size_t)l * 1024 * 256, 256, kb * 64, n0, (bf16*)(ws + WS_WDQ) + ((size_t)l * 256 + n0) * 1024, 1024, nullptr, scr, lane); continue; }
        r -= 2 * I_DQ;
        if (r < I_KVA) { const int kb = r / 9, n0 = (r % 9) * 32;
            tr_item(a->in[23], 288, kb * 64, n0, (bf16*)(ws + WS_WKVA) + (size_t)n0 * 1024, 1024, nullptr, scr, lane); continue; }
        r -= I_KVA;
        if (r < 2 * I_UQ) { const int l = r / I_UQ; r -= l * I_UQ; const int kb = r / 48, n0 = (r % 48) * 32; const int hh = n0 / 96, db = (n0 - hh * 96) >> 5;
            const int drow = (db < 2) ? (256 * (hh >> 2) + 128 * db + 32 * (hh & 3)) : (1024 + 256 * (hh >> 3) + 128 * ((hh & 7) >> 2) + 32 * (hh & 3));
            tr_item(a->in[30] + (size_t)l * 256 * 1536, 1536, kb * 64, n0, (bf16*)(ws + WS_WUQ) + ((size_t)l * 1536 + drow) * 256, 256, a->in[29] + l * 256, scr, lane); continue; }
        r -= 2 * I_UQ;
        if (r < I_KVB) { const int kb = r / 64, n0 = (r % 64) * 32; const int hh = n0 >> 7, db = (n0 & 127) >> 5;
            const int drow = (db < 2) ? (256 * (hh >> 2) + 128 * db + 32 * (hh & 3)) : (1024 + hh * 64 + (db - 2) * 32);
            tr_item(a->in[25], 2048, kb * 64, n0, (bf16*)(ws + WS_WKVB) + (size_t)drow * 256, 256, a->in[24], scr, lane); continue; }
        r -= I_KVB;
        { const int l = r / I_SQ; r -= l * I_SQ; const int kb = r / 32, n0 = (r % 32) * 32;
            tr_item(a->in[33] + (size_t)l * 1024 * 1024, 1024, kb * 64, n0, (bf16*)(ws + WS_WO) + ((size_t)l * 1024 + n0) * 1024, 1024, nullptr, scr, lane); }
    }
    const int gt = lsi(blockIdx.x) * 512 + tid, NT_ = G * 512;
    const int* pos = (const int*)a->in[2];
    for (int idx = gt; idx < T * 16; idx += NT_) { const int row = idx >> 4, i = idx & 15;
        const double b4 = (i & 3) == 0 ? 1.0 : (i & 3) == 1 ? 0.56234132519034908 : (i & 3) == 2 ? 0.31622776601683794 : 0.17782794100389228;
        const double p10 = (i >> 2) == 0 ? 1.0 : (i >> 2) == 1 ? 0.1 : (i >> 2) == 2 ? 0.01 : 0.001;
        double s, c; dsincos((double)pos[row] * (b4 * p10), s, c);
        ((float*)(ws + WS_COS))[idx] = (float)c; ((float*)(ws + WS_SIN))[idx] = (float)s; }
    for (int idx = gt; idx < 3 * T; idx += NT_) ((float*)(ws + WS_QSS))[idx] = 0.f;
    for (int idx = gt; idx < 224 * 1024 / 2; idx += NT_) ((unsigned*)((bf16*)(ws + WS_WKVA) + 288 * 1024))[idx] = 0u;
}

__device__ __forceinline__ void s5_norm_phase(KArgs a, int l, const float* xin, unsigned char* lds, int G_) { const int G = lsi(G_);
    const int tid = lv(threadIdx.x), lane = tid & 63, wave = tid >> 6;
    bf16* stage = (bf16*)lds;
    const float* ng = a->in[5] + l * 1024;
    bf16* AUG = (bf16*)(a->ws + WS_AUG);
    for (int it = lsi(blockIdx.x); it < NB * NSUB; it += G) {
        const int b = it >> 8, c = it & 255;
        const float* ada = (const float*)(a->ws + WS_ADA) + ((size_t)l * 8 + b) * 6144;
        f32x4 mul[4], add[4];
#pragma unroll
        for (int j = 0; j < 4; ++j) { const int ch = 4 * lane + 256 * j; const f32x4 gg = *(const f32x4*)(ng + ch), sc = *(const f32x4*)(ada + 1024 + ch); mul[j] = gg * (sc + 1.0f); add[j] = *(const f32x4*)(ada + ch); }
#pragma unroll
        for (int tt = 0; tt < 2; ++tt) { const int tok = 2 * wave + tt; const float* xr = xin + ((size_t)b * SEQ + c * 16 + tok) * 1024;
            f32x4 v[4]; float ss = 0.f;
#pragma unroll
            for (int j = 0; j < 4; ++j) { v[j] = *(const f32x4*)(xr + 4 * lane + 256 * j); ss += (v[j].x * v[j].x + v[j].y * v[j].y) + (v[j].z * v[j].z + v[j].w * v[j].w); }
            const float rstd = rsqrtf(wave_sum(ss, lane) * (1.f / 1024.f) + EPS);
#pragma unroll
            for (int j = 0; j < 4; ++j) { const f32x4 h = v[j] * rstd * mul[j] + add[j]; *(v2u*)(stage + tok * 1024 + 4 * lane + 256 * j) = (v2u){pk2(h.x, h.y), pk2(h.z, h.w)}; } }
        __syncthreads();
        { const int g = tid >> 3, part = tid & 7; bf16* dst = AUG + ((size_t)g * 2048 + b * 256 + c) * AUGK;
#pragma unroll
            for (int k = 0; k < 4; ++k) { const int chunk = part * 4 + k, s = chunk >> 1, qh = chunk & 1; *(v4u*)(dst + chunk * 8) = *(const v4u*)(stage + s * 1024 + g * 16 + qh * 8); } }
        __syncthreads();
    }
}
__device__ __forceinline__ void norm_phase(const float* x, const float* g1, const float* sh1, const float* sc1, int bstride1, bf16* out1,
                                           const float* g2, const float* sh2, const float* sc2, int bstride2, bf16* out2, int G_) { const int G = lsi(G_);
    const int tid = lv(threadIdx.x), lane = tid & 63, wave = tid >> 6;
    for (int rb = lsi(blockIdx.x) * 8 + wave; rb < T / 16; rb += G * 8) {
        const int b = rb >> 8;
        f32x4 mul[4], add[4], mul2[4], add2[4];
#pragma unroll
        for (int j = 0; j < 4; ++j) { const int ch = 4 * lane + 256 * j; mul[j] = *(const f32x4*)(g1 + ch) * (*(const f32x4*)(sc1 + (size_t)b * bstride1 + ch) + 1.0f); add[j] = *(const f32x4*)(sh1 + (size_t)b * bstride1 + ch);
            if (out2) { mul2[j] = *(const f32x4*)(g2 + ch) * (*(const f32x4*)(sc2 + (size_t)b * bstride2 + ch) + 1.0f); add2[j] = *(const f32x4*)(sh2 + (size_t)b * bstride2 + ch); } }
        for (int r4 = 0; r4 < 16; r4 += 4) {
            f32x4 v[4][4]; float ss[4];
#pragma unroll
            for (int q = 0; q < 4; ++q) { const float* xr = x + ((size_t)rb * 16 + r4 + q) * 1024; ss[q] = 0.f;
#pragma unroll
                for (int j = 0; j < 4; ++j) v[q][j] = *(const f32x4*)(xr + 4 * lane + 256 * j); }
#pragma unroll
            for (int q = 0; q < 4; ++q)
#pragma unroll
                for (int j = 0; j < 4; ++j) ss[q] += (v[q][j].x * v[q][j].x + v[q][j].y * v[q][j].y) + (v[q][j].z * v[q][j].z + v[q][j].w * v[q][j].w);
#pragma unroll
            for (int o = 1; o < 64; o <<= 1) {
                const float t0 = shx(ss[0], lane, o), t1 = shx(ss[1], lane, o), t2 = shx(ss[2], lane, o), t3 = shx(ss[3], lane, o);
                ss[0] += t0; ss[1] += t1; ss[2] += t2; ss[3] += t3; }
#pragma unroll
            for (int q = 0; q < 4; ++q) { const size_t row = (size_t)rb * 16 + r4 + q; const float rstd = rsqrtf(ss[q] * (1.f / 1024.f) + EPS);
#pragma unroll
                for (int j = 0; j < 4; ++j) { const f32x4 h = v[q][j] * rstd * mul[j] + add[j]; *(v2u*)(out1 + row * 1024 + 4 * lane + 256 * j) = (v2u){pk2(h.x, h.y), pk2(h.z, h.w)}; }
                if (out2) {
#pragma unroll
                    for (int j = 0; j < 4; ++j) { const f32x4 h = v[q][j] * rstd * mul2[j] + add2[j]; *(v2u*)(out2 + row * 1024 + 4 * lane + 256 * j) = (v2u){pk2(h.x, h.y), pk2(h.z, h.w)}; } } }
        }
    }
}
__device__ __forceinline__ void carry_phase(KArgs a, int l, int G_) { const int G = lsi(G_);
    const int tid = lv(threadIdx.x), lane = tid & 63, wave = tid >> 6;
    const float* EB = (const float*)(a->ws + WS_EBUF); bf16* AUG = (bf16*)(a->ws + WS_AUG);
    const int nn = lane >> 4, j = lane & 15;
    for (int L = lsi(blockIdx.x); L < 512; L += G)
    for (int nq = wave; nq < 16; nq += 8) {
        const int b = L & 7, g = L >> 3, n = nq * 4 + nn;
        const f32x2 a16 = ((const f32x2*)(a->ws + WS_A16))[(l * 64 + g) * 64 + n];
        const f32x4* ep = (const f32x4*)(EB + ((((size_t)(g * 8 + b) * 64 + n) * 256) + j * 16) * 2);
        f32x4 e[8];
#pragma unroll
        for (int i = 0; i < 8; ++i) e[i] = ep[i];
        f32x2 t = {0.f, 0.f};
#pragma unroll
        for (int i = 0; i < 8; ++i) { t = cmul(a16, t) + (f32x2){e[i].x, e[i].y}; t = cmul(a16, t) + (f32x2){e[i].z, e[i].w}; }
        f32x2 Ad = a16;
#pragma unroll
        for (int k = 0; k < 4; ++k) Ad = cmul(Ad, Ad);
#pragma unroll
        for (int d = 1; d < 16; d <<= 1) { const int sl = ((j >= d) ? lane - d : lane) << 2; const float tx_ = t.x, ty_ = t.y; const float orr = __builtin_bit_cast(float, __builtin_amdgcn_ds_bpermute(sl, __builtin_bit_cast(int, tx_))), oi = __builtin_bit_cast(float, __builtin_amdgcn_ds_bpermute(sl, __builtin_bit_cast(int, ty_)));
            if (j >= d) { t.x += Ad.x * orr - Ad.y * oi; t.y += Ad.x * oi + Ad.y * orr; }
            Ad = cmul(Ad, Ad); }
        f32x2 cur; { const int sl = ((j >= 1) ? lane - 1 : lane) << 2; const float tx_ = t.x, ty_ = t.y; cur.x = __builtin_bit_cast(float, __builtin_amdgcn_ds_bpermute(sl, __builtin_bit_cast(int, tx_))); cur.y = __builtin_bit_cast(float, __builtin_amdgcn_ds_bpermute(sl, __builtin_bit_cast(int, ty_))); } if (j == 0) cur = (f32x2){0.f, 0.f};
        bf16* op = AUG + ((size_t)g * 2048 + b * 256 + j * 16) * AUGK + 256 + 2 * n;
#pragma unroll
        for (int i = 0; i < 8; ++i) {
            *(unsigned*)(op + (size_t)(2 * i) * AUGK) = pk2(cur.x, cur.y); cur = cmul(a16, cur) + (f32x2){e[i].x, e[i].y};
            *(unsigned*)(op + (size_t)(2 * i + 1) * AUGK) = pk2(cur.x, cur.y); cur = cmul(a16, cur) + (f32x2){e[i].z, e[i].w}; }
    }
}

using pg8::Unit;
typedef const f32x4 (&AccRef)[2][2][4][2];
struct GroupOrder {
    int G, c;
    __device__ __forceinline__ bool next(int i, Unit& u) const { const int L = i * G + c; if (L >= 512) return false; u.pm = L; u.pn = L >> 3; return true; }
    __device__ __forceinline__ void a_ready(const Unit&) const {}
    __device__ __forceinline__ void done(const Unit&) const {}
};
struct EpiE { static constexpr bool PERM = false, AFTER_DRAIN = false; float* E;
    __device__ __forceinline__ void operator()(AccRef acc, const Unit& u, int wr, int wc, int fr, int fq) const { fr = lv(fr); fq = lv(fq);
        float* base = E + (size_t)((u.pn * 8 + (u.pm & 7)) * 64) * 512;
#pragma unroll
        for (int ai = 0; ai < 2; ++ai)
#pragma unroll
            for (int m = 0; m < 4; ++m) { const int c = ai * 128 + wr * 64 + m * 16 + fr;
#pragma unroll
                for (int n = 0; n < 2; ++n) { const int ns = 16 * wc + 8 * n + 2 * fq; const f32x4 v = acc[ai][0][m][n];
                    *(f32x2*)(base + ((size_t)ns * 256 + c) * 2) = (f32x2){v.x, v.y}; *(f32x2*)(base + ((size_t)(ns + 1) * 256 + c) * 2) = (f32x2){v.z, v.w}; } }
    }
};
struct EpiY { static constexpr bool PERM = true, AFTER_DRAIN = false; bf16* Gd;
    __device__ __forceinline__ void operator()(AccRef acc, const Unit& u, int wr, int wc, int fr, int fq) const { fr = lv(fr); fq = lv(fq);
        const int g = u.pn, b = u.pm & 7;
#pragma unroll
        for (int bj = 0; bj < 2; ++bj) { const int tc0 = 128 * bj + 32 * wc + 8 * fq, t = tc0 >> 4, p0 = tc0 & 15;
#pragma unroll
            for (int ai = 0; ai < 2; ++ai)
#pragma unroll
                for (int m = 0; m < 4; ++m) { const int r = ai * 128 + wr * 64 + m * 16 + fr; const size_t tok = (size_t)b * SEQ + r * 16 + t;
                    const f32x4 v0 = acc[ai][bj][m][0], v1 = acc[ai][bj][m][1];
                    v4u w; w.x = pk2(gelu_tanh(v0.x), gelu_tanh(v0.y)); w.y = pk2(gelu_tanh(v0.z), gelu_tanh(v0.w)); w.z = pk2(gelu_tanh(v1.x), gelu_tanh(v1.y)); w.w = pk2(gelu_tanh(v1.z), gelu_tanh(v1.w));
                    *(v4u*)(Gd + tok * 1024 + g * 16 + p0) = w; } }
    }
};
struct EpiGlu { static constexpr bool PERM = false, AFTER_DRAIN = false; const bf16* Gd; const float* bglu; const float* gate; const float* xin; float* xout;
    __device__ __forceinline__ void operator()(AccRef acc, const Unit& u, int wr, int wc, int fr, int fq) const { fr = lv(fr); fq = lv(fq);
        const int b = u.pm >> 4; f32x4 gt[2][2], bg[2][2];
#pragma unroll
        for (int bj = 0; bj < 2; ++bj)
#pragma unroll
            for (int n = 0; n < 2; ++n) { const int col = u.pn * 256 + 128 * bj + 32 * wc + 16 * n + 4 * fq; bg[bj][n] = *(const f32x4*)(bglu + col); gt[bj][n] = *(const f32x4*)(gate + (size_t)b * 6144 + col); }
#pragma unroll
        for (int ai = 0; ai < 2; ++ai)
#pragma unroll
            for (int mh = 0; mh < 2; ++mh) { f32x4 xv[2][2][2]; v2u gw[2][2][2];
                const size_t o0 = (size_t)(u.pm * 256 + ai * 128 + wr * 64 + mh * 32 + fr) * 1024 + u.pn * 256 + 32 * wc + 4 * fq;
#pragma unroll
                for (int m = 0; m < 2; ++m)
#pragma unroll
                    for (int bj = 0; bj < 2; ++bj)
#pragma unroll
                        for (int n = 0; n < 2; ++n) { const size_t off = o0 + (size_t)m * 16 * 1024 + 128 * bj + 16 * n; xv[m][bj][n] = *(const f32x4*)(xin + off); gw[m][bj][n] = *(const v2u*)(Gd + off); }
                asm volatile("" ::: "memory");
#pragma unroll
                for (int m = 0; m < 2; ++m)
#pragma unroll
                    for (int bj = 0; bj < 2; ++bj)
#pragma unroll
                        for (int n = 0; n < 2; ++n) { const size_t off = o0 + (size_t)m * 16 * 1024 + 128 * bj + 16 * n; const v2u g2 = gw[m][bj][n];
                            const f32x4 gv = {bflo(g2.x), bfhi(g2.x), bflo(g2.y), bfhi(g2.y)};
                            const f32x4 z = acc[ai][bj][2 * mh + m][n] + bg[bj][n]; const f32x4 mix = {gv.x * sigm(z.x), gv.y * sigm(z.y), gv.z * sigm(z.z), gv.w * sigm(z.w)};
                            *(f32x4*)(xout + off) = xv[m][bj][n] + gt[bj][n] * mix; }
                asm volatile("" ::: "memory"); }
    }
};
struct EpiRes { static constexpr bool PERM = false, AFTER_DRAIN = false; const float* gate; float* x;
    __device__ __forceinline__ void operator()(AccRef acc, const Unit& u, int wr, int wc, int fr, int fq) const { fr = lv(fr); fq = lv(fq);
        const int b = u.pm >> 4; f32x4 gt[2][2];
#pragma unroll
        for (int bj = 0; bj < 2; ++bj)
#pragma unroll
            for (int n = 0; n < 2; ++n) gt[bj][n] = *(const f32x4*)(gate + (size_t)b * 6144 + u.pn * 256 + 128 * bj + 32 * wc + 16 * n + 4 * fq);
#pragma unroll
        for (int ai = 0; ai < 2; ++ai) { f32x4 xv[4][2][2];
            float* xb = x + (size_t)(u.pm * 256 + ai * 128 + wr * 64 + fr) * 1024 + u.pn * 256 + 32 * wc + 4 * fq;
#pragma unroll
            for (int m = 0; m < 4; ++m)
#pragma unroll
                for (int bj = 0; bj < 2; ++bj)
#pragma unroll
                    for (int n = 0; n < 2; ++n) xv[m][bj][n] = *(const f32x4*)(xb + (size_t)m * 16 * 1024 + 128 * bj + 16 * n);
            asm volatile("" ::: "memory");
#pragma unroll
            for (int m = 0; m < 4; ++m)
#pragma unroll
                for (int bj = 0; bj < 2; ++bj)
#pragma unroll
                    for (int n = 0; n < 2; ++n) *(f32x4*)(xb + (size_t)m * 16 * 1024 + 128 * bj + 16 * n) = xv[m][bj][n] + gt[bj][n] * acc[ai][bj][m][n];
            asm volatile("" ::: "memory"); }
    }
};
__device__ __forceinline__ float sq4(f32x4 v);
struct EpiNone { static constexpr bool PERM = false, AFTER_DRAIN = false; float* sink;
    __device__ __forceinline__ void operator()(AccRef acc, const Unit& u, int wr, int wc, int fr, int fq) const { if (sink) { float s = 0.f;
#pragma unroll
        for (int ai = 0; ai < 2; ++ai)
#pragma unroll
            for (int bj = 0; bj < 2; ++bj)
#pragma unroll
                for (int m = 0; m < 4; ++m)
#pragma unroll
                    for (int n = 0; n < 2; ++n) s += sq4(acc[ai][bj][m][n]);
        if (s == 123.456f) sink[0] = s; } }
};
__device__ __forceinline__ float sq4(f32x4 v);
__device__ __forceinline__ void silu2(float g1, float g2, float u1, float u2, float& o1, float& o2) {
    const float a = 1.f + fminf(__expf(-g1), 1e18f), b = 1.f + fminf(__expf(-g2), 1e18f);
    const float r = __builtin_amdgcn_rcpf(a * b);
    o1 = g1 * u1 * (r * b); o2 = g2 * u2 * (r * a);
}
struct EpiGU { static constexpr bool PERM = true, AFTER_DRAIN = false; bf16* H;
    __device__ __forceinline__ void operator()(AccRef acc, const Unit& u, int wr, int wc, int fr, int fq) const { fr = lv(fr); fq = lv(fq);
#pragma unroll
        for (int ai = 0; ai < 2; ++ai)
#pragma unroll
            for (int m = 0; m < 4; ++m) { const size_t row = (size_t)(u.pm * 256 + ai * 128 + wr * 64 + m * 16 + fr);
                const f32x4 g0 = acc[ai][0][m][0], g1 = acc[ai][0][m][1], u0 = acc[ai][1][m][0], u1 = acc[ai][1][m][1];
                float h[8];
                silu2(g0.x, g0.y, u0.x, u0.y, h[0], h[1]); silu2(g0.z, g0.w, u0.z, u0.w, h[2], h[3]);
                silu2(g1.x, g1.y, u1.x, u1.y, h[4], h[5]); silu2(g1.z, g1.w, u1.z, u1.w, h[6], h[7]);
                v4u w; w.x = pk2(h[0], h[1]); w.y = pk2(h[2], h[3]); w.z = pk2(h[4], h[5]); w.w = pk2(h[6], h[7]);
                *(v4u*)(H + row * FF + u.pn * 128 + 32 * wc + 8 * fq) = w; }
    }
};
__device__ __forceinline__ float sq4(f32x4 v) { return (v.x * v.x + v.y * v.y) + (v.z * v.z + v.w * v.w); }
__device__ __forceinline__ float quad_sum_(float s, int lane) { s += shx(s, lane, 16); s += shx(s, lane, 32); return s; }
#define quad_sum(s) quad_sum_((s), fr + 16 * fq)
struct EpiDq { static constexpr bool PERM = true, AFTER_DRAIN = false; bf16* QA; float* SS;
    __device__ __forceinline__ void operator()(AccRef acc, const Unit& u, int wr, int wc, int fr, int fq) const { fr = lv(fr); fq = lv(fq);
#pragma unroll
        for (int ai = 0; ai < 2; ++ai)
#pragma unroll
            for (int m = 0; m < 4; ++m) { const size_t row = (size_t)(u.pm * 256 + ai * 128 + wr * 64 + m * 16 + fr); float ss = 0.f;
#pragma unroll
                for (int bj = 0; bj < 2; ++bj) { const f32x4 v0 = acc[ai][bj][m][0], v1 = acc[ai][bj][m][1]; ss += sq4(v0) + sq4(v1);
                    *(v4u*)(QA + row * 256 + 128 * bj + 32 * wc + 8 * fq) = (v4u){pk2(v0.x, v0.y), pk2(v0.z, v0.w), pk2(v1.x, v1.y), pk2(v1.z, v1.w)}; }
                ss = quad_sum(ss); if (fq == 0) atomicAdd(SS + row, ss); }
    }
};
struct EpiKva { static constexpr bool PERM = false, AFTER_DRAIN = false; bf16* CKV; float* SS; bf16* KR; const float* gkr; const float* COS; const float* SIN;
    __device__ __forceinline__ void operator()(AccRef acc, const Unit& u, int wr, int wc, int fr, int fq) const { fr = lv(fr); fq = lv(fq);
        if (u.pn == 0) {
#pragma unroll
            for (int ai = 0; ai < 2; ++ai)
#pragma unroll
                for (int m = 0; m < 4; ++m) { const size_t row = (size_t)(u.pm * 256 + ai * 128 + wr * 64 + m * 16 + fr); float ss = 0.f;
#pragma unroll
                    for (int bj = 0; bj < 2; ++bj)
#pragma unroll
                        for (int n = 0; n < 2; ++n) { const f32x4 v = acc[ai][bj][m][n]; ss += sq4(v); *(v2u*)(CKV + row * 256 + 128 * bj + 32 * wc + 16 * n + 4 * fq) = (v2u){pk2(v.x, v.y), pk2(v.z, v.w)}; }
                    ss = quad_sum(ss); if (fq == 0) atomicAdd(SS + row, ss); }
        } else if (wc == 0) {
            const f32x4 g1 = *(const f32x4*)(gkr + 4 * fq), g2 = *(const f32x4*)(gkr + 16 + 4 * fq);
#pragma unroll
            for (int ai = 0; ai < 2; ++ai) { f32x4 cs[4], sn[4];
#pragma unroll
                for (int m = 0; m < 4; ++m) { const size_t row = (size_t)(u.pm * 256 + ai * 128 + wr * 64 + m * 16 + fr); cs[m] = *(const f32x4*)(COS + row * 16 + 4 * fq); sn[m] = *(const f32x4*)(SIN + row * 16 + 4 * fq); }
                asm volatile("" ::: "memory");
#pragma unroll
                for (int m = 0; m < 4; ++m) { const size_t row = (size_t)(u.pm * 256 + ai * 128 + wr * 64 + m * 16 + fr);
                    const f32x4 x1 = acc[ai][0][m][0], x2 = acc[ai][0][m][1];
                    const float rstd = rsqrtf(quad_sum(sq4(x1) + sq4(x2)) * (1.f / 32.f) + EPS);
                    const f32x4 y1 = x1 * rstd * g1, y2 = x2 * rstd * g2, o1 = y1 * cs[m] - y2 * sn[m], o2 = y1 * sn[m] + y2 * cs[m];
                    *(v2u*)(KR + row * 32 + 4 * fq) = (v2u){pk2(o1.x, o1.y), pk2(o1.z, o1.w)}; *(v2u*)(KR + row * 32 + 16 + 4 * fq) = (v2u){pk2(o2.x, o2.y), pk2(o2.z, o2.w)}; }
                asm volatile("" ::: "memory"); }
        }
    }
};
constexpr float QSC = 0.10206207261596577f * 1.4426950408889634f;
struct EpiUq { static constexpr bool PERM = false, AFTER_DRAIN = false; const float* SS; const float* gn; const float* gr; const float* COS; const float* SIN; bf16* QB;
    __device__ __forceinline__ void operator()(AccRef acc, const Unit& u, int wr, int wc, int fr, int fq) const { fr = lv(fr); fq = lv(fq);
        const int b = u.pm >> 4; float ssv[2][4];
#pragma unroll
        for (int ai = 0; ai < 2; ++ai)
#pragma unroll
            for (int m = 0; m < 4; ++m) ssv[ai][m] = SS[(size_t)(u.pm * 256 + ai * 128 + wr * 64 + m * 16 + fr)];
        if (u.pn < 4) { const int hh = 4 * u.pn + wc; f32x4 g[2][2];
#pragma unroll
            for (int bj = 0; bj < 2; ++bj)
#pragma unroll
                for (int n = 0; n < 2; ++n) g[bj][n] = *(const f32x4*)(gn + 32 * bj + 16 * n + 4 * fq) * QSC;
            asm volatile("" ::: "memory");
#pragma unroll
            for (int ai = 0; ai < 2; ++ai)
#pragma unroll
                for (int m = 0; m < 4; ++m) { const int rowi = u.pm * 256 + ai * 128 + wr * 64 + m * 16 + fr; const int sq_ = rowi & (SEQ - 1);
                    const float rq = rsqrtf(ssv[ai][m] * (1.f / 256.f) + EPS); float ss = 0.f; f32x4 v[2][2];
#pragma unroll
                    for (int bj = 0; bj < 2; ++bj)
#pragma unroll
                        for (int n = 0; n < 2; ++n) { v[bj][n] = acc[ai][bj][m][n] * rq; ss += sq4(v[bj][n]); }
                    const float rh = rsqrtf(quad_sum(ss) * (1.f / 64.f) + EPS);
                    bf16* dst = QB + (((size_t)b * NH + hh) * SEQ + sq_) * 96;
#pragma unroll
                    for (int bj = 0; bj < 2; ++bj)
#pragma unroll
                        for (int n = 0; n < 2; ++n) { const f32x4 o = v[bj][n] * rh * g[bj][n]; *(v2u*)(dst + 32 * bj + 16 * n + 4 * fq) = (v2u){pk2(o.x, o.y), pk2(o.z, o.w)}; } }
        } else {
            const f32x4 g1 = *(const f32x4*)(gr + 4 * fq) * QSC, g2 = *(const f32x4*)(gr + 16 + 4 * fq) * QSC;
#pragma unroll
            for (int ai = 0; ai < 2; ++ai) { f32x4 cs[4], sn[4];
#pragma unroll
                for (int m = 0; m < 4; ++m) { const size_t row = (size_t)(u.pm * 256 + ai * 128 + wr * 64 + m * 16 + fr); cs[m] = *(const f32x4*)(COS + row * 16 + 4 * fq); sn[m] = *(const f32x4*)(SIN + row * 16 + 4 * fq); }
                asm volatile("" ::: "memory");
#pragma unroll
                for (int m = 0; m < 4; ++m) { const int rowi = u.pm * 256 + ai * 128 + wr * 64 + m * 16 + fr; const int sq_ = rowi & (SEQ - 1);
                    const float rq = rsqrtf(ssv[ai][m] * (1.f / 256.f) + EPS);
#pragma unroll
                    for (int bj = 0; bj < 2; ++bj) { const int hh = 8 * (u.pn - 4) + 4 * bj + wc;
                        const f32x4 x1 = acc[ai][bj][m][0] * rq, x2 = acc[ai][bj][m][1] * rq;
                        const float rh = rsqrtf(quad_sum(sq4(x1) + sq4(x2)) * (1.f / 32.f) + EPS);
                        const f32x4 y1 = x1 * rh * g1, y2 = x2 * rh * g2, o1 = y1 * cs[m] - y2 * sn[m], o2 = y1 * sn[m] + y2 * cs[m];
                        bf16* dst = QB + (((size_t)b * NH + hh) * SEQ + sq_) * 96 + 64;
                        *(v2u*)(dst + 4 * fq) = (v2u){pk2(o1.x, o1.y), pk2(o1.z, o1.w)}; *(v2u*)(dst + 16 + 4 * fq) = (v2u){pk2(o2.x, o2.y), pk2(o2.z, o2.w)}; } }
                asm volatile("" ::: "memory"); }
        }
    }
};
struct EpiKvb { static constexpr bool PERM = false, AFTER_DRAIN = false; const float* SS; const float* gk; bf16* KB; bf16* VB;
    __device__ __forceinline__ void operator()(AccRef acc, const Unit& u, int wr, int wc, int fr, int fq) const { fr = lv(fr); fq = lv(fq);
        const int b = u.pm >> 4; float ssv[2][4]; f32x4 g[2][2];
#pragma unroll
        for (int ai = 0; ai < 2; ++ai)
#pragma unroll
            for (int m = 0; m < 4; ++m) ssv[ai][m] = SS[(size_t)(u.pm * 256 + ai * 128 + wr * 64 + m * 16 + fr)];
#pragma unroll
        for (int bj = 0; bj < 2; ++bj)
#pragma unroll
            for (int n = 0; n < 2; ++n) g[bj][n] = *(const f32x4*)(gk + 32 * bj + 16 * n + 4 * fq);
        asm volatile("" ::: "memory");
#pragma unroll
        for (int ai = 0; ai < 2; ++ai)
#pragma unroll
            for (int m = 0; m < 4; ++m) { const int rowi = u.pm * 256 + ai * 128 + wr * 64 + m * 16 + fr; const int sq_ = rowi & (SEQ - 1);
                const float rc = rsqrtf(ssv[ai][m] * (1.f / 256.f) + EPS);
                if (u.pn < 4) { const int hh = 4 * u.pn + wc; float ss = 0.f; f32x4 v[2][2];
#pragma unroll
                    for (int bj = 0; bj < 2; ++bj)
#pragma unroll
                        for (int n = 0; n < 2; ++n) { v[bj][n] = acc[ai][bj][m][n] * rc; ss += sq4(v[bj][n]); }
                    const float rh = rsqrtf(quad_sum(ss) * (1.f / 64.f) + EPS);
                    bf16* dst = KB + (((size_t)b * NH + hh) * SEQ + sq_) * 64;
#pragma unroll
                    for (int bj = 0; bj < 2; ++bj)
#pragma unroll
                        for (int n = 0; n < 2; ++n) { const f32x4 o = v[bj][n] * rh * g[bj][n]; *(v2u*)(dst + 32 * bj + 16 * n + 4 * fq) = (v2u){pk2(o.x, o.y), pk2(o.z, o.w)}; }
                } else {
#pragma unroll
                    for (int bj = 0; bj < 2; ++bj)
#pragma unroll
                        for (int n = 0; n < 2; ++n) { const int col = 256 * (u.pn - 4) + 128 * bj + 32 * wc + 16 * n + 4 * fq, hh = col >> 6, dv = col & 63;
                            const f32x4 o = acc[ai][bj][m][n] * rc; *(v2u*)(VB + (((size_t)b * NH + hh) * SEQ + sq_) * 64 + dv) = (v2u){pk2(o.x, o.y), pk2(o.z, o.w)}; }
                } }
    }
};

namespace att {
using bf16x8 = __attribute__((ext_vector_type(8))) short;
using s16x4 = __attribute__((ext_vector_type(4))) short;
using f32x16 = __attribute__((ext_vector_type(16))) float;
using u32x4 = __attribute__((ext_vector_type(4))) unsigned;
constexpr int QBLK = 32, KVBLK = 64;
constexpr float SCALE = 0.10206207261596577f;
constexpr float THR = 6.f;
constexpr int SHM_V = 64 * 64 * 2, SHM_K = 64 * 256;
#define KSWZ(row, colB) ((row) * 256 + ((colB) ^ (((row) & 7) << 4)))
#define SBAR() __builtin_amdgcn_sched_barrier(0)
__device__ __forceinline__ int crow(int r, int hi) { return (r & 3) + 8 * (r >> 2) + 4 * hi; }
__device__ __forceinline__ unsigned cvtpk(float lo, float hi) { unsigned r; asm volatile("v_cvt_pk_bf16_f32 %0, %1, %2" : "=v"(r) : "v"(lo), "v"(hi)); return r; }
__device__ __forceinline__ void partialSM(f32x16& p0, f32x16& p1, float& m_reg, f32x16& negm, float& alpha) {
    constexpr float THRL = THR * 1.4426950408889634f;
    float pmax = p0[0];
#pragma unroll
    for (int r = 1; r < 16; ++r) pmax = fmaxf(pmax, p0[r]);
#pragma unroll
    for (int r = 0; r < 16; ++r) pmax = fmaxf(pmax, p1[r]);
    { auto rr = __builtin_amdgcn_permlane32_swap(__float_as_uint(pmax), __float_as_uint(pmax), false, false); pmax = fmaxf(__uint_as_float(rr[0]), __uint_as_float(rr[1])); }
    if (__builtin_expect(__all(pmax <= THRL), 1)) { alpha = 1.f; }
    else { const float dl = fmaxf(pmax, 0.f); m_reg += dl; alpha = __builtin_amdgcn_exp2f(-dl);
#pragma unroll
        for (int r = 0; r < 16; ++r) { p0[r] -= dl; p1[r] -= dl; }
#pragma unroll
        for (int r = 0; r < 16; ++r) negm[r] = -m_reg; }
#pragma unroll
    for (int r = 0; r < 16; ++r) p0[r] = __builtin_amdgcn_exp2f(p0[r]);
}
__device__ __forceinline__ void finishSM(f32x16& p0, f32x16& p1, float alpha, float& l_reg, bf16x8& pa0, bf16x8& pa1, bf16x8& pa2, bf16x8& pa3) {
#pragma unroll
    for (int r = 0; r < 16; ++r) p1[r] = __builtin_amdgcn_exp2f(p1[r]);
    float ps = 0;
#pragma unroll
    for (int r = 0; r < 16; ++r) ps += p0[r];
#pragma unroll
    for (int r = 0; r < 16; ++r) ps += p1[r];
    { auto rr = __builtin_amdgcn_permlane32_swap(__float_as_uint(ps), __float_as_uint(ps), false, false); ps = __uint_as_float(rr[0]) + __uint_as_float(rr[1]); }
    l_reg = l_reg * alpha + ps;
#define PK4(P, BASE, OUT) do { unsigned a0 = cvtpk(P[BASE + 0], P[BASE + 1]), a1 = cvtpk(P[BASE + 2], P[BASE + 3]);   \
    unsigned b0 = cvtpk(P[BASE + 4], P[BASE + 5]), b1 = cvtpk(P[BASE + 6], P[BASE + 7]);                              \
    auto r0 = __builtin_amdgcn_permlane32_swap(a0, b0, false, false); auto r1 = __builtin_amdgcn_permlane32_swap(a1, b1, false, false); \
    u32x4 w = {r0[0], r1[0], r0[1], r1[1]}; OUT = *reinterpret_cast<bf16x8*>(&w); } while (0)
    PK4(p0, 0, pa0); PK4(p0, 8, pa1); PK4(p1, 0, pa2); PK4(p1, 8, pa3);
#undef PK4
}
__device__ __forceinline__ void qkt(f32x16& p0, f32x16& p1, const char* Ks, const bf16x8* qr, int r32, int hi, const f32x16& cin) {
    p0 = cin; p1 = cin;
#pragma unroll
    for (int d0 = 0; d0 < 6; ++d0) { const int cb = (d0 * 16 + hi * 8) * 2;
        const bf16x8 b0 = *reinterpret_cast<const bf16x8*>(Ks + KSWZ(r32, cb));
        const bf16x8 b1 = *reinterpret_cast<const bf16x8*>(Ks + KSWZ(32 + r32, cb));
        p0 = __builtin_amdgcn_mfma_f32_32x32x16_bf16(b0, qr[d0], p0, 0, 0, 0);
        p1 = __builtin_amdgcn_mfma_f32_32x32x16_bf16(b1, qr[d0], p1, 0, 0, 0); }
}
__device__ __forceinline__ int v_st(int k, int c) { const int kk = (k & ~0xC) | ((k & 4) << 1) | ((k & 8) >> 1); return ((kk >> 3) * 2 + (c >> 5)) * 512 + ((kk & 7) * 32 + (c & 31)) * 2; }
__device__ __forceinline__ int v_rd_base(int lane) { return ((lane & 3) << 3) | (((lane >> 2) & 3) << 6) | (((lane >> 4) & 1) << 5) | (((lane >> 5) & 1) << 8); }
constexpr int v_rd_off(int d0, int ks, int half) { return d0 * 512 + ks * 2048 + half * 1024; }
template <int OFF> __device__ __forceinline__ s16x4 tr_read(int vb) { s16x4 r; asm volatile("ds_read_b64_tr_b16 %0, %1 offset:%2" : "=&v"(r) : "v"(vb), "i"(OFF) : "memory"); return r; }
template <int D0> __device__ __forceinline__ void pv_one(f32x16& od, int vb, bf16x8 pa0, bf16x8 pa1, bf16x8 pa2, bf16x8 pa3) {
    const s16x4 l0 = tr_read<v_rd_off(D0, 0, 0)>(vb), h0 = tr_read<v_rd_off(D0, 0, 1)>(vb), l1 = tr_read<v_rd_off(D0, 1, 0)>(vb), h1 = tr_read<v_rd_off(D0, 1, 1)>(vb);
    const s16x4 l2 = tr_read<v_rd_off(D0, 2, 0)>(vb), h2 = tr_read<v_rd_off(D0, 2, 1)>(vb), l3 = tr_read<v_rd_off(D0, 3, 0)>(vb), h3 = tr_read<v_rd_off(D0, 3, 1)>(vb);
    asm volatile("s_waitcnt lgkmcnt(0)" ::: "memory"); SBAR();
#define PK(L, H) (bf16x8){L[0], L[1], L[2], L[3], H[0], H[1], H[2], H[3]}
    od = __builtin_amdgcn_mfma_f32_32x32x16_bf16(pa0, PK(l0, h0), od, 0, 0, 0);
    od = __builtin_amdgcn_mfma_f32_32x32x16_bf16(pa1, PK(l1, h1), od, 0, 0, 0);
    od = __builtin_amdgcn_mfma_f32_32x32x16_bf16(pa2, PK(l2, h2), od, 0, 0, 0);
    od = __builtin_amdgcn_mfma_f32_32x32x16_bf16(pa3, PK(l3, h3), od, 0, 0, 0);
#undef PK
}
__device__ __forceinline__ void pv_d0(f32x16* o, int vb, bf16x8 pa0, bf16x8 pa1, bf16x8 pa2, bf16x8 pa3) { pv_one<0>(o[0], vb, pa0, pa1, pa2, pa3); pv_one<1>(o[1], vb, pa0, pa1, pa2, pa3); }

__device__ __forceinline__ void attn_unit(const bf16* __restrict__ Qb, const bf16* __restrict__ Kh, const bf16* __restrict__ KRb, const bf16* __restrict__ Vh, bf16* __restrict__ Ob, int NT, char* lds) {
    const int tid = lv(threadIdx.x), wid = tid >> 6, lane = tid & 63, r32 = lane & 31, hi = lane >> 5;
    char* V_lds = lds; char* K_lds = lds + 2 * SHM_V;
    float* ws = (float*)(lds + 2 * SHM_V + 2 * SHM_K) + wid * 64; float* li_l = ws; float* al_l = ws + 32;
    float m_reg = 0.f, l_reg = 0; f32x16 o[2] = {}; bf16x8 qr[6]; f32x16 negm = {}; f32x16 negbig; _Pragma("unroll") for (int r = 0; r < 16; ++r) negbig[r] = -1e30f;
    const bf16* Qw = Qb + (long)(wid * QBLK + r32) * 96 + hi * 8;
#pragma unroll
    for (int d0 = 0; d0 < 6; ++d0) qr[d0] = *reinterpret_cast<const bf16x8*>(Qw + d0 * 16);
    const int sr = tid >> 4, kc = tid & 15; const bool kact = kc < 12;
    const bf16* ksrc = (kc < 8) ? (Kh + kc * 8) : (KRb + (kc - 8) * 8); const int kstr = (kc < 8) ? 64 : 32;
    const int vr = tid >> 3, vc = (tid & 7) * 8; const int vst = v_st(vr, vc);
    const int kw0 = KSWZ(sr, kc * 16), kw1 = KSWZ(32 + sr, kc * 16);
    const int vb0 = (int)(uintptr_t)V_lds + v_rd_base(lane);
    struct { bf16x8 vs, ks0, ks1; } sr_[2];
#define SLOAD(i, k0) do { sr_[i].vs = *reinterpret_cast<const bf16x8*>(Vh + (long)((k0) + vr) * 64 + vc); \
    if (kact) { sr_[i].ks0 = *reinterpret_cast<const bf16x8*>(ksrc + (long)((k0) + sr) * kstr); sr_[i].ks1 = *reinterpret_cast<const bf16x8*>(ksrc + (long)((k0) + 32 + sr) * kstr); } } while (0)
#define SWRITE(b, i) do { *(bf16x8*)(V_lds + (b) * SHM_V + vst) = sr_[i].vs; \
    if (kact) { *(bf16x8*)(K_lds + (b) * SHM_K + kw0) = sr_[i].ks0; *(bf16x8*)(K_lds + (b) * SHM_K + kw1) = sr_[i].ks1; } } while (0)
#define SWAIT() asm volatile("s_waitcnt vmcnt(3)" ::: "memory")
#define RESC(a) do { if (__any((a) < 1.f)) { if (hi == 0) al_l[r32] = (a); asm volatile("s_waitcnt lgkmcnt(0)" ::: "memory"); \
    _Pragma("unroll") for (int d = 0; d < 2; ++d) _Pragma("unroll") for (int r = 0; r < 16; ++r) o[d][r] *= al_l[crow(r, hi)]; } } while (0)
#define MASKED(t) ((t) - (NT - 4) > wq)
#define CIN(t) (MASKED(t) ? negbig : negm)
    f32x16 pA0, pA1, pB0, pB1; float alA, alB; bf16x8 pa0, pa1, pa2, pa3; const int wq = __builtin_amdgcn_readfirstlane(wid >> 1);
    sr_[0].ks0 = bf16x8{}; sr_[0].ks1 = bf16x8{}; sr_[1].ks0 = bf16x8{}; sr_[1].ks1 = bf16x8{};
    SLOAD(0, 0); asm volatile("s_waitcnt vmcnt(0)" ::: "memory"); SWRITE(0, 0); __syncthreads();
    qkt(pA0, pA1, K_lds, qr, r32, hi, negm); partialSM(pA0, pA1, m_reg, negm, alA);
    SLOAD(1, KVBLK); if (2 < NT) SLOAD(0, 2 * KVBLK);
    SWAIT(); SWRITE(1, 1); __syncthreads();
#define BODY(j, CINB, CINA) do { \
        SBAR(); qkt(pB0, pB1, K_lds + SHM_K, qr, r32, hi, CINB); \
        finishSM(pA0, pA1, alA, l_reg, pa0, pa1, pa2, pa3); SBAR(); \
        SLOAD(1, ((j) + 2) * KVBLK); SBAR(); \
        pv_d0(o, vb0, pa0, pa1, pa2, pa3); partialSM(pB0, pB1, m_reg, negm, alB); \
        __syncthreads(); SWAIT(); SWRITE(0, 0); \
        RESC(alB); __syncthreads(); \
        SBAR(); qkt(pA0, pA1, K_lds, qr, r32, hi, CINA); \
        finishSM(pB0, pB1, alB, l_reg, pa0, pa1, pa2, pa3); SBAR(); \
        if ((j) + 3 < NT) SLOAD(0, ((j) + 3) * KVBLK); SBAR(); \
        pv_d0(o, vb0 + SHM_V, pa0, pa1, pa2, pa3); partialSM(pA0, pA1, m_reg, negm, alA); \
        __syncthreads(); SWAIT(); SWRITE(1, 1); \
        RESC(alA); __syncthreads(); } while (0)
    int j = 1;
    for (; j + 5 < NT; j += 2) BODY(j, negm, negm);
    for (; j + 1 < NT; j += 2) BODY(j, CIN(j), CIN(j + 1));
#undef BODY
    SBAR(); qkt(pB0, pB1, K_lds + SHM_K, qr, r32, hi, CIN(NT - 1));
    finishSM(pA0, pA1, alA, l_reg, pa0, pa1, pa2, pa3); SBAR();
    pv_d0(o, vb0, pa0, pa1, pa2, pa3); partialSM(pB0, pB1, m_reg, negm, alB);
    __syncthreads(); RESC(alB);
    finishSM(pB0, pB1, alB, l_reg, pa0, pa1, pa2, pa3); SBAR();
    pv_d0(o, vb0 + SHM_V, pa0, pa1, pa2, pa3);
    if (hi == 0) li_l[r32] = l_reg; asm volatile("s_waitcnt lgkmcnt(0)" ::: "memory");
    float rli[16];
#pragma unroll
    for (int r = 0; r < 16; ++r) rli[r] = __builtin_amdgcn_rcpf(li_l[crow(r, hi)]);
    bf16* Ow = Ob + (long)(wid * QBLK) * 1024;
#pragma unroll
    for (int r = 0; r < 16; ++r) { const int orow = crow(r, hi);
#pragma unroll
        for (int d0 = 0; d0 < 2; ++d0) Ow[(long)orow * 1024 + d0 * 32 + r32] = (bf16)f2bf(o[d0][r] * rli[r]); }
    asm volatile("s_waitcnt vmcnt(0)" ::: "memory");
    __syncthreads();
#undef SLOAD
#undef SWRITE
#undef SWAIT
#undef RESC
#undef MASKED
#undef CIN
}
#undef KSWZ
#undef SBAR
}

__device__ __forceinline__ void attn_phase(KArgs a, unsigned char* lds, int G_) { const int G = lsi(G_);
    const int bx = lsi(blockIdx.x); const int vcu = (G % 8 == 0) ? (bx % 8) * (G / 8) + bx / 8 : bx;
    const bf16* QB = (const bf16*)(a->ws + WS_QB); const bf16* KB = (const bf16*)(a->ws + WS_KB); const bf16* VB = (const bf16*)(a->ws + WS_VB);
    const bf16* KR = (const bf16*)(a->ws + WS_KR); bf16* OB = (bf16*)(a->ws + WS_OB);
    for (int p = vcu; p < 1024; p += G) { const int bh = p >> 3, s = p & 7, b = bh >> 4, h = bh & 15;
        for (int half = 0; half < 2; ++half) { const int qb = half ? 15 - s : s;
            att::attn_unit(QB + ((size_t)bh * SEQ + qb * 256) * 96, KB + (size_t)bh * SEQ * 64, KR + (size_t)b * SEQ * 32, VB + (size_t)bh * SEQ * 64,
                           OB + ((size_t)b * SEQ + qb * 256) * 1024 + h * 64, 4 * (qb + 1), (char*)lds); } }
}

#define LAS __attribute__((address_space(3)))
#define XB_TMO      128
#define XB_XCNT(j)  (256  + 64 * (j))
#define XB_XSUB(j)  (1280 + 64 * (j))
#define XB_XGEN(j)  (2304 + 64 * (j))
#define XB_TOP      3328
#define XB_TOPGEN   3392
#define XCD_BAR_WORDS 3456
#define XB_SPIN_CAP (1u << 18)

__device__ __forceinline__ unsigned xb_ld(unsigned* p)              { return __hip_atomic_load(p, __ATOMIC_RELAXED, __HIP_MEMORY_SCOPE_AGENT); }
__device__ __forceinline__ unsigned xb_add(unsigned* p, unsigned v) { return __hip_atomic_fetch_add(p, v, __ATOMIC_RELAXED, __HIP_MEMORY_SCOPE_AGENT); }
__device__ __forceinline__ unsigned xb_xcc_id() { return (unsigned)__builtin_amdgcn_s_getreg((3 << 11) | 20) & 0xFu; }
#define XB_SPIN(cond, bar) do { unsigned _sp = 0; while (cond) { __builtin_amdgcn_s_sleep(1); \
    if ((++_sp & 255u) == 0u) { if (xb_ld(&(bar)[XB_TMO])) break; if (_sp > XB_SPIN_CAP) { atomicAdd(&(bar)[XB_TMO], 1u); break; } } } } while (0)

struct XcdBarrier {
    unsigned* bar; unsigned x;
    volatile LAS unsigned* st;
};

__device__ __forceinline__ XcdBarrier xcd_barrier_post(unsigned* bar, volatile LAS unsigned* st) {
    XcdBarrier b; b.bar = bar; b.x = xb_xcc_id(); b.st = st;
    if (threadIdx.x == 0) (void)xb_add(&bar[XB_XCNT(b.x)], 1u);
    return b;
}
__device__ __forceinline__ void xcd_barrier_complete(unsigned* bar, unsigned x, unsigned& nloc, unsigned& nx) {
    const unsigned G = gridDim.x * gridDim.y * gridDim.z;
    unsigned sum, cnt, mine, sp = 0u;
    for (;;) {
        sum = 0u; cnt = 0u; mine = 0u;
#pragma unroll
        for (unsigned j = 0; j < 16; ++j) { const unsigned c = xb_ld(&bar[XB_XCNT(j)]); sum += c; cnt += (c > 0u) ? 1u : 0u; mine = (j == x) ? c : mine; }
        if (sum == G) break;
        __builtin_amdgcn_s_sleep(1);
        if ((++sp & 255u) == 0u) { if (xb_ld(&bar[XB_TMO])) break; if (sp > XB_SPIN_CAP) { atomicAdd(&bar[XB_TMO], 1u); break; } }
    }
    nloc = mine > 0u ? mine : 1u; nx = cnt > 0u ? cnt : 1u;
}

__device__ __forceinline__ void xcd_barrier(const XcdBarrier& b) {
    asm volatile("s_waitcnt vmcnt(0)" ::: "memory");
    __syncthreads();
    if (threadIdx.x == 0) {
        unsigned* bar = b.bar;
        __builtin_amdgcn_s_waitcnt(0);
        unsigned nloc = b.st[0], nx = b.st[1];
        if (nloc == 0u) { xcd_barrier_complete(bar, b.x, nloc, nx); b.st[0] = nloc; b.st[1] = nx; }
        const unsigned old = xb_add(&bar[XB_XSUB(b.x)], 1u);
        const unsigned gen = old / nloc;
        if (old + 1u == (gen + 1u) * nloc) {
            __builtin_amdgcn_fence(__ATOMIC_RELEASE, "agent");
            asm volatile("s_waitcnt vmcnt(0)" ::: "memory");
            const unsigned og = xb_add(&bar[XB_TOP], 1u);
            const unsigned tg = og / nx;
            if (og + 1u == (tg + 1u) * nx) xb_add(&bar[XB_TOPGEN], 1u);
            else XB_SPIN(xb_ld(&bar[XB_TOPGEN]) == tg, bar);
            __builtin_amdgcn_fence(__ATOMIC_ACQUIRE, "agent");
            xb_add(&bar[XB_XGEN(b.x)], 1u);
            asm volatile("s_waitcnt vmcnt(0)" ::: "memory");
        } else {
            XB_SPIN(xb_ld(&bar[XB_XGEN(b.x)]) == gen, bar);
            __builtin_amdgcn_fence(__ATOMIC_ACQUIRE, "agent");
            asm volatile("s_waitcnt vmcnt(0)" ::: "memory");
        }
    }
    __syncthreads();
}

__global__ void __launch_bounds__(512, 2) yoco_fwd(Args a_unused) {
    extern __shared__ __attribute__((aligned(16))) unsigned char lds[];
    cg::grid_group grid = cg::this_grid();
    KArgs a0 = kargs();
    volatile LAS unsigned* MISC = (volatile LAS unsigned*)((LAS unsigned char*)lds + 131072 + 320);
    if (threadIdx.x < 32) MISC[threadIdx.x] = 0u;
    __syncthreads();
    XcdBarrier xbar = xcd_barrier_post((unsigned*)(a0->ws) + 4096, MISC + 8);
    const int G = gridDim.x, lo = a0->ph_lo, hi = a0->ph_hi;
    PG8_LAS unsigned char* ldsl = (PG8_LAS unsigned char*)lds;
#define WSL() KArgs a = kargs(); unsigned char* ws = a->ws; float* xo = a->out; const float* ada = (const float*)(ws + WS_ADA) + (size_t)l * 8 * 6144; const float* xin = (l == 0) ? a->in[0] : xo; (void)ada; (void)xin; (void)xo; const int Gl = lsi(G), bxl = lsi((int)blockIdx.x); (void)Gl; (void)bxl
#ifndef REP_ATT
#define REP_ATT 1
#endif
#ifndef REP_UP
#define REP_UP 1
#endif
#ifndef REP_NORM
#define REP_NORM 1
#endif
#ifndef REP_SYNC
#define REP_SYNC 1
#endif
#ifndef REP_S5
#define REP_S5 1
#endif
#ifndef REP_PROJ
#define REP_PROJ 1
#endif
#ifndef REP_RES
#define REP_RES 1
#endif
#ifndef REP_KL
#define REP_KL 0
#endif
#ifndef REP_P0
#define REP_P0 1
#endif
#define IN(k) (lo <= (k) && (k) < hi)
#define SEAM(k) do { if (IN(k) && IN((k) + 1)) for (int rep_ = 0; rep_ < REP_SYNC; ++rep_) { if (a0->coop == 2) grid.sync(); xcd_barrier(xbar); } } while (0)
    if (IN(0)) for (int rep = 0; rep < REP_P0; ++rep) { phase0(kargs(), lds, G); __syncthreads(); }
    SEAM(0);
    for (int l = 0; l < 4; ++l) {
        const int pb = 1 + 8 * l;
        if (l < 2) {
            if (IN(pb + 0)) for (int rep = 0; rep < REP_NORM; ++rep) { WSL(); s5_norm_phase(a, l, xin, lds, G); }
            SEAM(pb + 0);
            if (IN(pb + 1)) for (int rep = 0; rep < REP_S5; ++rep) { WSL(); pg8::Gemm g{(const bf16*)(ws + WS_AUG), (const bf16*)(ws + WS_S5WE) + (size_t)l * 64 * 256 * 256, 64 * 2048, 256, 256, AUGK, 256};
                GroupOrder S{Gl, bxl}; EpiE E{(float*)(ws + WS_EBUF)};
                pg8::gemm_phase<EpiE, GroupOrder, true, true>(ldsl, g, S, E); }
            if (IN(pb + 1)) { asm volatile("s_waitcnt vmcnt(0)" ::: "memory"); __syncthreads(); carry_phase(kargs(), l, G); asm volatile("s_waitcnt vmcnt(0)" ::: "memory"); __syncthreads(); }
            if (IN(pb + 1)) for (int rep = 0; rep < REP_S5; ++rep) { WSL(); pg8::Gemm g{(const bf16*)(ws + WS_AUG), (const bf16*)(ws + WS_S5WT) + (size_t)l * 64 * 256 * AUGK, 64 * 2048, 256, AUGK, AUGK, AUGK};
                GroupOrder S{Gl, bxl}; EpiY E{(bf16*)(ws + WS_XN)};
                pg8::gemm_phase<EpiY, GroupOrder, true, true>(ldsl, g, S, E); }
            SEAM(pb + 3);
            if (IN(pb + 4)) for (int rep = 0; rep < REP_RES; ++rep) { WSL(); pg8::Gemm g{(const bf16*)(ws + WS_XN), (const bf16*)(ws + WS_WGLU) + (size_t)l * 1024 * 1024, T, 1024, 1024, 1024, 1024};
                pg8::StaticOrder S; S.init(T, 1024, Gl, bxl); EpiGlu E{(const bf16*)(ws + WS_XN), a->in[19] + l * 1024, rep ? (const float*)(ws + 262144) : ada + 2048, rep ? xo : xin, xo};
                pg8::gemm_phase<EpiGlu, pg8::StaticOrder, true, true>(ldsl, g, S, E); }
            SEAM(pb + 4);
        } else {
            const int j = l - 2;
            if (IN(pb + 0)) for (int rep = 0; rep < REP_NORM; ++rep) { WSL(); const float* kva = (const float*)(ws + WS_KVADA);
                norm_phase(xo, a->in[5] + l * 1024, ada, ada + 1024, 6144, (bf16*)(ws + WS_XN), a->in[22], kva, kva + 1024, 2048, (j == 0) ? (bf16*)(ws + WS_XK) : nullptr, G); }
            SEAM(pb + 0);
            if (IN(pb + 1)) { WSL();
                { pg8::Gemm g{(const bf16*)(ws + WS_XN), (const bf16*)(ws + WS_WDQ) + (size_t)j * 256 * 1024, T, 256, 1024, 1024, 1024};
                  pg8::StaticOrder S; S.init(T, 256, Gl, bxl); EpiDq E{(bf16*)(ws + WS_QA), (float*)(ws + WS_QSS) + (size_t)j * T};
                  pg8::gemm_phase<EpiDq, pg8::StaticOrder, true, true>(ldsl, g, S, E); }
                if (j == 0) { pg8::Gemm g{(const bf16*)(ws + WS_XK), (const bf16*)(ws + WS_WKVA), T, 512, 1024, 1024, 1024};
                  pg8::StaticOrder S; S.init(T, 512, Gl, bxl); EpiKva E{(bf16*)(ws + WS_CKV), (float*)(ws + WS_KSS), (bf16*)(ws + WS_KR), a->in[27], (const float*)(ws + WS_COS), (const float*)(ws + WS_SIN)};
                  pg8::gemm_phase<EpiKva, pg8::StaticOrder, true, true>(ldsl, g, S, E); }
            }
            SEAM(pb + 1);
            if (IN(pb + 2)) for (int rep = 0; rep < REP_PROJ; ++rep) { WSL();
                { pg8::Gemm g{(const bf16*)(ws + WS_QA), (const bf16*)(ws + WS_WUQ) + (size_t)j * 1536 * 256, T, 1536, 256, 256, 256};
                  pg8::StaticOrder S; S.init(T, 1536, Gl, bxl);
                  EpiUq E{(const float*)(ws + WS_QSS) + (size_t)j * T, a->in[31] + j * 64, a->in[32] + j * 32, (const float*)(ws + WS_COS), (const float*)(ws + WS_SIN), (bf16*)(ws + WS_QB)};
                  pg8::gemm_phase<EpiUq, pg8::StaticOrder, true, true>(ldsl, g, S, E); }
                if (j == 0) { pg8::Gemm g{(const bf16*)(ws + WS_CKV), (const bf16*)(ws + WS_WKVB), T, 2048, 256, 256, 256};
                  pg8::StaticOrder S; S.init(T, 2048, Gl, bxl); EpiKvb E{(const float*)(ws + WS_KSS), a->in[26], (bf16*)(ws + WS_KB), (bf16*)(ws + WS_VB)};
                  pg8::gemm_phase<EpiKvb, pg8::StaticOrder, true, true>(ldsl, g, S, E); }
            }
            SEAM(pb + 2);
            if (IN(pb + 3)) for (int rep = 0; rep < REP_ATT; ++rep) attn_phase(kargs(), lds, G);
            SEAM(pb + 3);
            if (IN(pb + 4)) for (int rep = 0; rep < REP_RES; ++rep) { WSL(); pg8::Gemm g{(const bf16*)(ws + WS_OB), (const bf16*)(ws + WS_WO) + (size_t)j * 1024 * 1024, T, 1024, 1024, 1024, 1024};
                pg8::StaticOrder S; S.init(T, 1024, Gl, bxl); EpiRes E{rep ? (const float*)(ws + 262144) : ada + 2048, xo};
                pg8::gemm_phase<EpiRes, pg8::StaticOrder, true, true>(ldsl, g, S, E); }
            SEAM(pb + 4);
        }
        if (IN(pb + 5)) for (int rep = 0; rep < REP_NORM; ++rep) { WSL(); norm_phase(xo, a->in[6] + l * 1024, ada + 3072, ada + 4096, 6144, (bf16*)(ws + WS_XN), nullptr, nullptr, nullptr, 0, nullptr, G); }
        SEAM(pb + 5);
        if (IN(pb + 6)) for (int rep = 0; rep < REP_UP; ++rep) { WSL(); pg8::Gemm g{(const bf16*)(ws + WS_XN), (const bf16*)(ws + WS_WGU) + (size_t)l * 5632 * 1024, T, 5632, 1024, 1024, 1024};
            pg8::StaticOrder S; S.init(T, 5632, Gl, bxl); EpiGU E{(bf16*)(ws + WS_HB)};
            pg8::gemm_phase<EpiGU, pg8::StaticOrder, true, true>(ldsl, g, S, E); }
        SEAM(pb + 6);
        if (IN(pb + 7)) for (int rep = 0; rep < REP_RES; ++rep) { WSL(); pg8::Gemm g{(const bf16*)(ws + WS_HB), (const bf16*)(ws + WS_WD) + (size_t)l * 1024 * FF, T, 1024, FF, FF, FF};
            pg8::StaticOrder S; S.init(T, 1024, Gl, bxl); EpiRes E{rep ? (const float*)(ws + 262144) : ada + 5120, xo};
            pg8::gemm_phase<EpiRes, pg8::StaticOrder, true, true>(ldsl, g, S, E); }
        if (IN(pb + 7)) for (int rep = 0; rep < REP_KL; ++rep) { WSL(); pg8::Gemm g{(const bf16*)(ws + WS_HB), (const bf16*)(ws + WS_WD) + (size_t)l * 1024 * FF, T, 1024, FF, FF, FF};
            pg8::StaticOrder S; S.init(T, 1024, Gl, bxl); EpiNone E{(float*)(ws + 262144)};
            pg8::gemm_phase<EpiNone, pg8::StaticOrder, true, true>(ldsl, g, S, E); }
        SEAM(pb + 7);
    }
#undef IN
#undef SEAM
}

#ifndef MK_PER_PHASE
#define MK_PER_PHASE 0
#endif
extern "C" void kernel_launch(void* const* d_in, const int* in_sizes, int n_in, void* d_out, int out_size, void* d_ws, size_t ws_size, hipStream_t stream) {
    static int grid = 0;
    if (grid == 0) {
        if (n_in != 34 || out_size != T * DM || ws_size < WS_END) { fprintf(stderr, "kernel_launch: unexpected shapes (n_in %d out %d ws %zu)\n", n_in, out_size, ws_size); grid = -1; return; }
        int dev = 0, cus = 0, per_cu = 0;
        if (hipGetDevice(&dev) != hipSuccess || hipDeviceGetAttribute(&cus, hipDeviceAttributeMultiprocessorCount, dev) != hipSuccess) { grid = -1; return; }
        if (hipFuncSetAttribute((const void*)yoco_fwd, hipFuncAttributeMaxDynamicSharedMemorySize, LDS_BYTES) != hipSuccess) { fprintf(stderr, "kernel_launch: hipFuncSetAttribute failed\n"); grid = -1; return; }
        if (hipOccupancyMaxActiveBlocksPerMultiprocessor(&per_cu, (const void*)yoco_fwd, 512, LDS_BYTES) != hipSuccess || per_cu < 1) per_cu = 1;
        (void)hipGetLastError();
        grid = cus * per_cu;
    }
    if (grid < 0) return;
    Args ha{};
    for (int i = 0; i < 34; ++i) ha.in[i] = (const float*)d_in[i];
    ha.out = (float*)d_out; ha.ws = (unsigned char*)d_ws;
#if MK_PER_PHASE
    for (int ph = 0; ph < NPHASE; ++ph) { ha.ph_lo = ph; ha.ph_hi = ph + 1; ha.coop = 0;
        hipLaunchKernelGGL(yoco_fwd, dim3(grid), dim3(512), LDS_BYTES, stream, ha); }
#else
    (void)hipMemsetAsync(d_ws, 0, 524288, stream);
    ha.ph_lo = 0; ha.ph_hi = NPHASE; ha.coop = 1;
    void* args[] = {&ha};
    const hipError_t e = hipLaunchCooperativeKernel((const void*)yoco_fwd, dim3(grid), dim3(512), args, LDS_BYTES, stream);
    if (e != hipSuccess) fprintf(stderr, "kernel_launch: cooperative launch failed: %s (grid %d)\n", hipGetErrorString(e), grid);
#endif
}
```

```cpp
#include <hip/hip_runtime.h>
#include <hip/hip_cooperative_groups.h>
#include <cstdio>
#include <cstdint>
namespace cg = cooperative_groups;
namespace pg8 {
#define PG8_LAS __attribute__((address_space(3)))
typedef unsigned short bf16_t;
typedef short bf16x8 __attribute__((ext_vector_type(8)));
typedef float f32x4 __attribute__((ext_vector_type(4)));
typedef unsigned u32x4 __attribute__((ext_vector_type(4)));
constexpr int BM = 256, BK = 64, HALF = 128, HTB = HALF * BK * 2  , STAGE_BYTES = 8 * HTB, NXCD = 8, WGM = 8;

__host__ __device__ __forceinline__ int lds_byte(int r, int c) { const int st = (r >> 4) * 2 + (c >> 5), rr = r & 15, cc = c & 31, ob = rr * 64 + cc * 2; return st * 1024 + (ob ^ (((ob >> 9) & 1) << 5)); }
__host__ __device__ __forceinline__ void stage_rc(int b, int& R, int& C) { const int st = b / 1024, sb = b % 1024, swz = sb ^ (((sb >> 9) & 1) << 5); R = (st >> 1) * 16 + swz / 64; C = (st & 1) * 32 + (swz % 64) / 2; }
__host__ __device__ __forceinline__ int perm32(int rho) { const int n = rho >> 4, i = rho & 15; return 8 * (i >> 2) + 4 * n + (i & 3); }

struct Unit { int pm, pn; };
struct Gemm { const bf16_t* A; const bf16_t* Bt; int M, N, K, lda, ldb; };

struct StaticOrder {
    int nM, nN, nwg, G, c;
    __host__ __device__ void init(int M, int N, int G_, int c_) { nM = M / BM; nN = N / BM; nwg = nM * nN; G = G_; c = c_; }
    __host__ __device__ bool next(int i, Unit& u) const {
        const long L = (long)i * G + c; if (L >= nwg) return false;
        int wgid = (int)L; { const int q = nwg / NXCD, r = nwg % NXCD, xcd = wgid % NXCD, off = wgid / NXCD; wgid = (xcd < r ? xcd * (q + 1) : r * (q + 1) + (xcd - r) * q) + off; }
        const int nig = WGM * nN, gid = wgid / nig, fm = gid * WGM, gsz = (nM - fm) < WGM ? (nM - fm) : WGM;
        u.pm = fm + ((wgid % nig) % gsz); u.pn = (wgid % nig) / gsz; return true;
    }
    __device__ __forceinline__ void a_ready(const Unit&) const {}
    __device__ __forceinline__ void done(const Unit&) const {}
};

__device__ __forceinline__ unsigned cvt_pk_bf16(float lo, float hi) { unsigned r; asm volatile("v_cvt_pk_bf16_f32 %0, %1, %2" : "=v"(r) : "v"(lo), "v"(hi)); return r; }
typedef float f32x2 __attribute__((ext_vector_type(2)));
template <class Epi, class Sched, bool ALIGN_EPI = false, bool SP2 = false>
__device__ __forceinline__ void gemm_phase(PG8_LAS unsigned char* lds, const Gemm g, const Sched& S, const Epi& E) {
    int tid_l = threadIdx.x; asm volatile("" : "+v"(tid_l)); const int tid = tid_l, wid = __builtin_amdgcn_readfirstlane(tid >> 6), lane = tid & 63, wr = wid >> 2, wc = wid & 3, fr = lane & 15, fq = lane >> 4;
    int K_l = g.K; asm volatile("" : "+s"(K_l)); const int K = K_l, nt = K / BK;
    unsigned voffA[2], voffB[2];
#pragma unroll
    for (int i = 0; i < 2; ++i) { int R, C; stage_rc(tid * 16 + i * 8192, R, C); const int Rb = Epi::PERM ? ((R & ~31) + perm32(R & 31)) : R;
        voffA[i] = (unsigned)(R * g.lda + C) * 2u; voffB[i] = (unsigned)(Rb * g.ldb + C) * 2u; }
    const size_t kstep = (size_t)(BK * 2);
    const size_t hstepA = (size_t)HALF * g.lda * 2, hstepB = (size_t)HALF * g.ldb * 2;
    const size_t tstepA = 2 * hstepA, tstepB = 2 * hstepB;
    const unsigned ldsw = (unsigned)wid * 1024u;
    const int aoff = lds_byte(wr * 64 + fr, fq * 8), boff = lds_byte(wc * 32 + fr, fq * 8);
#define PG8_SA(b, h) (((b) * 2 + (h)) * HTB)
#define PG8_SB(b, h) ((4 + (b) * 2 + (h)) * HTB)
#define PG8_STAGE(bufoff, gbase, voff) do { _Pragma("unroll") for (int _i = 0; _i < 2; ++_i) \
        __builtin_amdgcn_global_load_lds((const unsigned*)((const char*)(gbase) + (voff)[_i]), (PG8_LAS unsigned*)(lds + (bufoff) + ldsw + _i * 8192), 16, 0, 0); } while (0)
#define PG8_LDA(dst, b, h) do { _Pragma("unroll") for (int m = 0; m < 4; ++m) _Pragma("unroll") for (int k = 0; k < 2; ++k) dst[m][k] = *(const PG8_LAS bf16x8*)(lds + PG8_SA(b, h) + aoff + m * 2048 + k * 1024); } while (0)
#define PG8_LDB(dst, b, h) do { _Pragma("unroll") for (int n = 0; n < 2; ++n) _Pragma("unroll") for (int k = 0; k < 2; ++k) dst[n][k] = *(const PG8_LAS bf16x8*)(lds + PG8_SB(b, h) + boff + n * 2048 + k * 1024); } while (0)
#define PG8_MMA(ai, bj, At, Bt) do { __builtin_amdgcn_s_setprio(1); _Pragma("unroll") for (int m = 0; m < 4; ++m) _Pragma("unroll") for (int n = 0; n < 2; ++n) _Pragma("unroll") for (int k = 0; k < 2; ++k) \
        acc[ai][bj][m][n] = __builtin_amdgcn_mfma_f32_16x16x32_bf16(Bt[n][k], At[m][k], acc[ai][bj][m][n], 0, 0, 0); __builtin_amdgcn_s_setprio(0); } while (0)
#define PG8_WAIT_V(n) asm volatile("s_waitcnt vmcnt(" #n ")" ::: "memory")
#define PG8_WAIT_L(n) asm volatile("s_waitcnt lgkmcnt(" #n ")" ::: "memory")
#define PG8_BAR __builtin_amdgcn_s_barrier()
#define PG8_SCHED __builtin_amdgcn_sched_barrier(0)
    Unit cur, nxt; int ui = 0;
    if (!S.next(0, cur)) return;
    f32x4 acc[2][2][4][2];
#pragma unroll
    for (int a = 0; a < 2; ++a)
#pragma unroll
        for (int b = 0; b < 2; ++b)
#pragma unroll
            for (int m = 0; m < 4; ++m)
#pragma unroll
                for (int n = 0; n < 2; ++n) acc[a][b][m][n] = (f32x4){0.f, 0.f, 0.f, 0.f};
    bf16x8 At[4][2], B0[2][2], B1[2][2];
    const char* cA = (const char*)g.A + (size_t)cur.pm * tstepA; const char* cB = (const char*)g.Bt + (size_t)cur.pn * tstepB;
    S.a_ready(cur);
    if constexpr (SP2) {
        PG8_STAGE(PG8_SB(0, 0), cB, voffB); PG8_STAGE(PG8_SB(0, 1), cB + hstepB, voffB); PG8_STAGE(PG8_SA(0, 0), cA, voffA); PG8_STAGE(PG8_SA(0, 1), cA + hstepA, voffA);
        if (wr == 1) PG8_BAR;
        PG8_WAIT_V(2); PG8_BAR;
        PG8_STAGE(PG8_SB(1, 0), cB + kstep, voffB); PG8_STAGE(PG8_SA(1, 0), cA + kstep, voffA); PG8_STAGE(PG8_SB(1, 1), cB + hstepB + kstep, voffB);
        PG8_WAIT_V(6); PG8_BAR;
    } else {
        PG8_STAGE(PG8_SB(0, 0), cB, voffB); PG8_STAGE(PG8_SA(0, 0), cA, voffA); PG8_STAGE(PG8_SB(0, 1), cB + hstepB, voffB); PG8_STAGE(PG8_SA(0, 1), cA + hstepA, voffA);
        if (wr == 1) PG8_BAR;
        PG8_WAIT_V(4); PG8_BAR;
        PG8_STAGE(PG8_SB(1, 0), cB + kstep, voffB); PG8_STAGE(PG8_SA(1, 0), cA + kstep, voffA); PG8_STAGE(PG8_SB(1, 1), cB + hstepB + kstep, voffB);
        PG8_WAIT_V(6); PG8_BAR;
    }
    for (;;) {
        const bool has_next = S.next(ui + 1, nxt);
        const char* nA = has_next ? (const char*)g.A + (size_t)nxt.pm * tstepA : cA; const char* nB = has_next ? (const char*)g.Bt + (size_t)nxt.pn * tstepB : cB;
        for (int t = 0; t < nt; t += 2) {
            const bool last = (t == nt - 2);
            const char* a1 = cA + (size_t)(t + 1) * kstep;
            const char* a2 = last ? nA : cA + (size_t)(t + 2) * kstep; const char* b2 = last ? nB : cB + (size_t)(t + 2) * kstep;
            const char* a3 = a2 + kstep; const char* b3 = b2 + kstep;
            if (last && has_next) S.a_ready(nxt);
            if constexpr (SP2) {
            PG8_LDB(B0, 0, 0); PG8_LDB(B1, 0, 1); PG8_SCHED; PG8_LDA(At, 0, 0); PG8_STAGE(PG8_SA(1, 1), a1 + hstepA, voffA);
            PG8_WAIT_V(8); PG8_WAIT_L(0); PG8_BAR; PG8_MMA(0, 0, At, B0); PG8_MMA(0, 1, At, B1); PG8_BAR; PG8_SCHED;
            PG8_LDA(At, 0, 1); PG8_STAGE(PG8_SB(0, 0), b2, voffB); PG8_STAGE(PG8_SB(0, 1), b2 + hstepB, voffB); PG8_STAGE(PG8_SA(0, 0), a2, voffA);
            PG8_WAIT_V(8); PG8_WAIT_L(0); PG8_BAR; PG8_MMA(1, 0, At, B0); PG8_MMA(1, 1, At, B1); PG8_BAR; PG8_SCHED;
            PG8_LDB(B0, 1, 0); PG8_LDB(B1, 1, 1); PG8_SCHED; PG8_LDA(At, 1, 0); PG8_STAGE(PG8_SA(0, 1), a2 + hstepA, voffA);
            PG8_WAIT_V(8); PG8_WAIT_L(0); PG8_BAR; PG8_MMA(0, 0, At, B0); PG8_MMA(0, 1, At, B1); PG8_BAR; PG8_SCHED;
            PG8_LDA(At, 1, 1); PG8_STAGE(PG8_SB(1, 0), b3, voffB); PG8_STAGE(PG8_SB(1, 1), b3 + hstepB, voffB); PG8_STAGE(PG8_SA(1, 0), a3, voffA);
            PG8_WAIT_V(8); PG8_WAIT_L(0); PG8_BAR; PG8_MMA(1, 0, At, B0); PG8_MMA(1, 1, At, B1); PG8_BAR; PG8_SCHED;
            } else {
            PG8_LDB(B0, 0, 0); PG8_SCHED; PG8_LDA(At, 0, 0); PG8_STAGE(PG8_SA(1, 1), a1 + hstepA, voffA);
            PG8_WAIT_L(8); PG8_BAR; PG8_WAIT_L(0); PG8_MMA(0, 0, At, B0); PG8_BAR; PG8_SCHED;
            PG8_LDB(B1, 0, 1); PG8_STAGE(PG8_SB(0, 0), b2, voffB);
            PG8_BAR; PG8_WAIT_L(0); PG8_MMA(0, 1, At, B1); PG8_BAR;
            PG8_LDA(At, 0, 1); PG8_STAGE(PG8_SA(0, 0), a2, voffA);
            PG8_BAR; PG8_WAIT_L(0); PG8_MMA(1, 0, At, B0); PG8_BAR; PG8_SCHED;
            PG8_STAGE(PG8_SB(0, 1), b2 + hstepB, voffB);
            PG8_WAIT_V(6); PG8_BAR; PG8_MMA(1, 1, At, B1); PG8_BAR;
            PG8_LDB(B0, 1, 0); PG8_SCHED; PG8_LDA(At, 1, 0); PG8_STAGE(PG8_SA(0, 1), a2 + hstepA, voffA);
            PG8_WAIT_L(8); PG8_BAR; PG8_WAIT_L(0); PG8_MMA(0, 0, At, B0); PG8_BAR; PG8_SCHED;
            PG8_LDB(B1, 1, 1); PG8_STAGE(PG8_SB(1, 0), b3, voffB);
            PG8_BAR; PG8_WAIT_L(0); PG8_MMA(0, 1, At, B1); PG8_BAR;
            PG8_LDA(At, 1, 1); PG8_STAGE(PG8_SA(1, 0), a3, voffA);
            PG8_BAR; PG8_WAIT_L(0); PG8_MMA(1, 0, At, B0); PG8_BAR; PG8_SCHED;
            PG8_STAGE(PG8_SB(1, 1), b3 + hstepB, voffB);
            PG8_WAIT_V(6); PG8_BAR; PG8_MMA(1, 1, At, B1); PG8_BAR;
            }
        }
        if constexpr (ALIGN_EPI) { if (wr == 0) PG8_BAR; }
        if constexpr (!Epi::AFTER_DRAIN) { E(acc, cur, wr, wc, fr, fq); S.done(cur); }
        if (!has_next) break;
#pragma unroll
        for (int a = 0; a < 2; ++a)
#pragma unroll
            for (int b = 0; b < 2; ++b)
#pragma unroll
                for (int m = 0; m < 4; ++m)
#pragma unroll
                    for (int n = 0; n < 2; ++n) acc[a][b][m][n] = (f32x4){0.f, 0.f, 0.f, 0.f};
        cur = nxt; cA = nA; cB = nB; ++ui;
        if constexpr (ALIGN_EPI) { if (wr == 1) PG8_BAR; }
    }
    PG8_WAIT_V(0);
    if constexpr (!ALIGN_EPI) { if (wr == 0) PG8_BAR; }
    PG8_BAR;
    if constexpr (Epi::AFTER_DRAIN) { E.fused(acc, cur, wr, wc, fr, fq, lds, wid, lane); S.done(cur); }
#undef PG8_SA
#undef PG8_SB
#undef PG8_STAGE
#undef PG8_LDA
#undef PG8_LDB
#undef PG8_MMA
#undef PG8_WAIT_V
#undef PG8_WAIT_L
#undef PG8_BAR
#undef PG8_SCHED
}
}

constexpr int NB = 8, SEQ = 4096, DM = 1024, T = NB * SEQ, FF = 2816, NH = 16;
constexpr int SUB = 16, NSUB = SEQ / SUB, AUGK = 384;
constexpr float EPS = 1e-6f;
constexpr size_t MiB = 1u << 20;
constexpr size_t WS_ADA = 1 * MiB;
constexpr size_t WS_KVADA = WS_ADA + 800 * 1024;
constexpr size_t WS_COS = 2 * MiB, WS_SIN = 4 * MiB;
constexpr size_t WS_QSS = 6 * MiB;
constexpr size_t WS_KSS = WS_QSS + 2 * T * 4, WS_A16 = WS_KSS + T * 4;
constexpr size_t WS_KR = 7 * MiB;
constexpr size_t WS_WGU = 10 * MiB;
constexpr size_t WS_WD = WS_WGU + 44 * MiB;
constexpr size_t WS_WGLU = WS_WD + 22 * MiB;
constexpr size_t WS_WDQ = WS_WGLU + 4 * MiB;
constexpr size_t WS_WKVA = WS_WDQ + 1 * MiB;
constexpr size_t WS_WUQ = WS_WKVA + 1 * MiB;
constexpr size_t WS_WKVB = WS_WUQ + 3 * MiB / 2;
constexpr size_t WS_WO = WS_WKVB + 1 * MiB;
constexpr size_t WS_S5WT = 89 * MiB;
constexpr size_t WS_S5WE = WS_S5WT + 24 * MiB;
constexpr size_t WS_CKV = WS_S5WT, WS_QA = WS_S5WT + 16 * MiB;
constexpr size_t WS_XN = 129 * MiB;
constexpr size_t WS_HB = 193 * MiB;
constexpr size_t WS_AUG = WS_HB, WS_EBUF = WS_HB + 96 * MiB;
constexpr size_t WS_QB = WS_HB, WS_XK = WS_HB + 96 * MiB, WS_OB = WS_XK;
constexpr size_t WS_KB = 369 * MiB, WS_VB = 433 * MiB, WS_END = 497 * MiB;
static_assert(WS_WO + 4 * MiB <= WS_S5WT && WS_S5WE + 16 * MiB <= WS_XN, "ws map");

constexpr int LDS_BYTES = 147456;
constexpr int NPHASE = 33;

typedef unsigned short bf16;
typedef unsigned v4u __attribute__((ext_vector_type(4)));
typedef unsigned v2u __attribute__((ext_vector_type(2)));
typedef float f32x4 __attribute__((ext_vector_type(4)));
typedef float f32x2 __attribute__((ext_vector_type(2)));

__device__ __forceinline__ unsigned f2bf(float f) { unsigned u = __builtin_bit_cast(unsigned, f); return (u + 0x7fffu + ((u >> 16) & 1u)) >> 16; }
__device__ __forceinline__ unsigned pk2(float lo, float hi) { return f2bf(lo) | (f2bf(hi) << 16); }
__device__ __forceinline__ float bflo(unsigned w) { return __builtin_bit_cast(float, w << 16); }
__device__ __forceinline__ float bfhi(unsigned w) { return __builtin_bit_cast(float, w & 0xffff0000u); }
__device__ __forceinline__ float shx(float v, int lane, int o) { return __builtin_bit_cast(float, __builtin_amdgcn_ds_bpermute((lane ^ o) << 2, __builtin_bit_cast(int, v))); }
__device__ __forceinline__ float wave_sum(float v, int lane) {
#pragma unroll
    for (int o = 1; o < 64; o <<= 1) v += shx(v, lane, o);
    return v;
}
__device__ __forceinline__ float sigm(float z) { return __builtin_amdgcn_rcpf(1.f + __expf(-z)); }
__device__ __forceinline__ float gelu_tanh(float x) { const float u = 0.7978845608028654f * (x + 0.044715f * x * x * x); return x * __builtin_amdgcn_rcpf(1.f + __expf(-2.f * u)); }
__device__ __forceinline__ f32x2 cmul(f32x2 a, f32x2 b) { return (f32x2){a.x * b.x - a.y * b.y, a.x * b.y + a.y * b.x}; }
__device__ __forceinline__ void dsincos(double x, double& s, double& c) {
    const double q = __builtin_rint(x * 0.63661977236758134308);
    double r = __builtin_fma(-q, 1.57079632679489655800, x); r = __builtin_fma(-q, 6.12323399573676603587e-17, r);
    const double r2 = r * r;
    double sp = 1.0 / 6227020800.0; sp = -1.0 / 39916800.0 + r2 * sp; sp = 1.0 / 362880.0 + r2 * sp; sp = -1.0 / 5040.0 + r2 * sp; sp = 1.0 / 120.0 + r2 * sp; sp = -1.0 / 6.0 + r2 * sp;
    const double s0 = r + r * r2 * sp;
    double cp = 1.0 / 479001600.0; cp = -1.0 / 3628800.0 + r2 * cp; cp = 1.0 / 40320.0 + r2 * cp; cp = -1.0 / 720.0 + r2 * cp; cp = 1.0 / 24.0 + r2 * cp; cp = -0.5 + r2 * cp;
    const double c0 = 1.0 + r2 * cp;
    const int n = ((int)q) & 3;
    s = (n == 0) ? s0 : (n == 1) ? c0 : (n == 2) ? -s0 : -c0;
    c = (n == 0) ? c0 : (n == 1) ? -s0 : (n == 2) ? -c0 : s0;
}

__device__ __forceinline__ int lv(int v) { asm volatile("" : "+v"(v)); return v; }
__device__ __forceinline__ int lsi(int v) { asm volatile("" : "+s"(v)); return v; }
template <class TP> __device__ __forceinline__ TP* ls(TP* p) { asm volatile("" : "+s"(p)); return p; }
struct Args { const float* in[34]; float* out; unsigned char* ws; int ph_lo, ph_hi, coop, pad; };
typedef const __attribute__((address_space(4))) Args* KArgs;
__device__ __forceinline__ KArgs kargs() { KArgs p = (KArgs)__builtin_amdgcn_kernarg_segment_ptr(); asm volatile("" : "+s"(p)); return p; }

__device__ __forceinline__ void tr_item(const float* W, int ldw, int k0, int n0, bf16* dst, int ldd, const float* kscale, float* scr, int lane) {
#pragma unroll 8
    for (int i = 0; i < 32; ++i) { const int kk = 2 * i + (lane >> 5); float v = W[(size_t)(k0 + kk) * ldw + n0 + (lane & 31)]; if (kscale) v *= kscale[k0 + kk]; scr[kk * 33 + (lane & 31)] = v; }
    const int c = lane & 7;
#pragma unroll
    for (int j = 0; j < 4; ++j) { const int n = (lane >> 3) + 8 * j; const float* s = scr + (8 * c) * 33 + n;
        v4u o; o.x = pk2(s[0 * 33], s[1 * 33]); o.y = pk2(s[2 * 33], s[3 * 33]); o.z = pk2(s[4 * 33], s[5 * 33]); o.w = pk2(s[6 * 33], s[7 * 33]);
        *(v4u*)(dst + (size_t)n * ldd + k0 + 8 * c) = o; }
}

__device__ __forceinline__ void ada_item(KArgs a, int it, float* cact, float* part, int tid) {
    const int lane = tid & 63, wave = tid >> 6;
    const int col0 = it * 128;
    const float* W; const float* bias; float* out; int ldw;
    if (col0 < 4 * 6144) { const int l = col0 / 6144, cc = col0 - l * 6144; W = a->in[3] + (size_t)l * 1024 * 6144 + cc; ldw = 6144; bias = a->in[4] + l * 6144 + cc; out = (float*)(a->ws + WS_ADA) + (size_t)l * 8 * 6144 + cc; }
    else { const int cc = col0 - 4 * 6144; W = a->in[20] + cc; ldw = 2048; bias = a->in[21] + cc; out = (float*)(a->ws + WS_KVADA) + cc; }
    float acc[8][2];
#pragma unroll
    for (int b = 0; b < 8; ++b) { acc[b][0] = 0.f; acc[b][1] = 0.f; }
    const float* wp = W + (size_t)(wave * 128) * ldw + 2 * lane;
    const float* cp = cact + wave * 128 * 8;
#pragma unroll 8
    for (int k = 0; k < 128; ++k) {
        const f32x2 w2 = *(const f32x2*)(wp + (size_t)k * ldw);
        const f32x4 c0 = *(const f32x4*)(cp + k * 8), c1 = *(const f32x4*)(cp + k * 8 + 4);
        acc[0][0] += c0.x * w2.x; acc[0][1] += c0.x * w2.y; acc[1][0] += c0.y * w2.x; acc[1][1] += c0.y * w2.y;
        acc[2][0] += c0.z * w2.x; acc[2][1] += c0.z * w2.y; acc[3][0] += c0.w * w2.x; acc[3][1] += c0.w * w2.y;
        acc[4][0] += c1.x * w2.x; acc[4][1] += c1.x * w2.y; acc[5][0] += c1.y * w2.x; acc[5][1] += c1.y * w2.y;
        acc[6][0] += c1.z * w2.x; acc[6][1] += c1.z * w2.y; acc[7][0] += c1.w * w2.x; acc[7][1] += c1.w * w2.y;
    }
#pragma unroll
    for (int b = 0; b < 8; ++b) *(f32x2*)(part + (wave * 8 + b) * 128 + 2 * lane) = (f32x2){acc[b][0], acc[b][1]};
    __syncthreads();
    for (int o = tid; o < 1024; o += 512) { const int b = o >> 7, col = o & 127; float s = bias[col];
#pragma unroll
        for (int w = 0; w < 8; ++w) s += part[(w * 8 + b) * 128 + col];
        out[(size_t)b * ldw + col] = s; }
    __syncthreads();
}

__device__ __forceinline__ void s5prep_item(KArgs a, int l, int g, unsigned char* sm, int tid) {
    f32x2* apw = (f32x2*)sm;
    f32x2* bbv = (f32x2*)(sm + 8704);
    f32x2* ccv = (f32x2*)(sm + 16896);
    float* Kt = (float*)(sm + 25088);
    f32x2* fv = (f32x2*)(sm + 41472);
    const int lg = l * 64 + g;
    const float* lam_re = a->in[10] + lg * 64; const float* lam_im = a->in[11] + lg * 64;
    const float* b_re = a->in[13] + (size_t)lg * 64 * 16; const float* b_im = a->in[14] + (size_t)lg * 64 * 16;
    const float* c_re = a->in[15] + (size_t)lg * 16 * 64; const float* c_im = a->in[16] + (size_t)lg * 16 * 64;
    const float* dsk = a->in[17] + l * 1024 + g * 16;
    if (tid < 64) {
        const int n = tid; const double dt = exp((double)a->in[12][lg]); const double lr = lam_re[n], li = lam_im[n];
        const double mag = exp(lr * dt); double s, c; dsincos(li * dt, s, c); const double ar = mag * c, ai = mag * s;
        double pr = 1.0, pi = 0.0;
        for (int k = 0; k <= 16; ++k) { apw[k * 64 + n] = (f32x2){(float)pr, (float)pi}; const double tr = pr * ar - pi * ai, ti = pr * ai + pi * ar; pr = tr; pi = ti; }
        ((f32x2*)(a->ws + WS_A16))[lg * 64 + n] = apw[16 * 64 + n];
        const double den = lr * lr + li * li, nr = ar - 1.0, ni = ai;
        fv[n] = (f32x2){(float)((nr * lr + ni * li) / den), (float)((ni * lr - nr * li) / den)};
    }
    __syncthreads();
    for (int i = tid; i < 1024; i += 512) { const int n = i >> 4; bbv[i] = cmul(fv[n], (f32x2){b_re[i], b_im[i]}); ccv[i] = (f32x2){c_re[i], c_im[i]}; }
    __syncthreads();
    { const int lag = tid >> 5, p = (tid >> 1) & 15, qh = tid & 1; float acc[8];
#pragma unroll
        for (int q = 0; q < 8; ++q) acc[q] = 0.f;
        for (int n = 0; n < 64; ++n) { const f32x2 w = cmul(ccv[p * 64 + n], apw[lag * 64 + n]);
#pragma unroll
            for (int q = 0; q < 8; ++q) { const f32x2 bq = bbv[n * 16 + qh * 8 + q]; acc[q] += w.x * bq.x - w.y * bq.y; } }
#pragma unroll
        for (int q = 0; q < 8; ++q) Kt[(lag * 16 + p) * 16 + qh * 8 + q] = acc[q]; }
    __syncthreads();
    bf16* WT = (bf16*)(a->ws + WS_S5WT) + (size_t)lg * 256 * AUGK;
    for (int ch = tid; ch < 256 * 48; ch += 512) { const int row = ch / 48, cc = ch - row * 48, t = row >> 4, p = row & 15; float v[8];
        if (cc < 32) { const int s = cc >> 1, qh = cc & 1;
#pragma unroll
            for (int q = 0; q < 8; ++q) { float x = (s <= t) ? Kt[((t - s) * 16 + p) * 16 + qh * 8 + q] : 0.f; if (s == t && qh * 8 + q == p) x += dsk[p]; v[q] = x; } }
        else { const int n0 = (cc - 32) * 4;
#pragma unroll
            for (int k = 0; k < 4; ++k) { const f32x2 w = cmul(ccv[p * 64 + n0 + k], apw[(t + 1) * 64 + n0 + k]); v[2 * k] = w.x; v[2 * k + 1] = -w.y; } }
        v4u o; o.x = pk2(v[0], v[1]); o.y = pk2(v[2], v[3]); o.z = pk2(v[4], v[5]); o.w = pk2(v[6], v[7]);
        *(v4u*)(WT + (size_t)row * AUGK + cc * 8) = o; }
    bf16* WE = (bf16*)(a->ws + WS_S5WE) + (size_t)lg * 256 * 256;
    for (int ch = tid; ch < 256 * 32; ch += 512) { const int row = ch >> 5, cc = ch & 31, s = cc >> 1, qh = cc & 1; float v[8];
        if (row < 128) { const int n = row >> 1, im = row & 1; const f32x2 ap = apw[(15 - s) * 64 + n];
#pragma unroll
            for (int q = 0; q < 8; ++q) { const f32x2 pr = cmul(ap, bbv[n * 16 + qh * 8 + q]); v[q] = im ? pr.y : pr.x; } }
        else {
#pragma unroll
            for (int q = 0; q < 8; ++q) v[q] = 0.f; }
        v4u o; o.x = pk2(v[0], v[1]); o.y = pk2(v[2], v[3]); o.z = pk2(v[4], v[5]); o.w = pk2(v[6], v[7]);
        *(v4u*)(WE + (size_t)row * 256 + cc * 8) = o; }
    __syncthreads();
}

__device__ __forceinline__ void phase0(KArgs a, unsigned char* lds, int G_) { const int G = lsi(G_);
    const int tid = lv(threadIdx.x), lane = tid & 63, wave = tid >> 6;
    float* cact = (float*)lds; float* part = (float*)(lds + 32768);
    for (int i = tid; i < 8192; i += 512) { const int b = i >> 10, k = i & 1023; const float v = a->in[1][i]; cact[k * 8 + b] = v / (1.f + __expf(-v)); }
    __syncthreads();
    for (int it = lsi(blockIdx.x); it < 208 + 128; it += G) {
        if (it < 208) ada_item(a, it, cact, part, tid);
        else { const int r = it - 208; s5prep_item(a, r >> 6, r & 63, lds + 65536, tid); }
    }
    __syncthreads();
    float* scr = (float*)(lds + wave * 16384);
    const int gw = lsi(blockIdx.x) * 8 + wave, NGW = G * 8;
    unsigned char* ws = a->ws;
    constexpr int I_GU = 16 * 88, I_D = 44 * 32, I_SQ = 16 * 32, I_DQ = 16 * 8, I_KVA = 16 * 9, I_UQ = 4 * 48, I_KVB = 4 * 64;
    constexpr int NTR = 8 * I_GU + 4 * I_D + 2 * I_SQ + 2 * I_DQ + I_KVA + 2 * I_UQ + I_KVB + 2 * I_SQ;
    for (int it = gw; it < NTR; it += NGW) {
        int r = it;
        if (r < 8 * I_GU) { const int up = r >= 4 * I_GU; if (up) r -= 4 * I_GU; const int l = r / I_GU; r -= l * I_GU; const int kb = r / 88, n0 = (r % 88) * 32;
            tr_item(a->in[up ? 8 : 7] + (size_t)l * 1024 * FF, FF, kb * 64, n0, (bf16*)(ws + WS_WGU) + ((size_t)l * 5632 + (n0 >> 7) * 256 + up * 128 + (n0 & 127)) * 1024, 1024, nullptr, scr, lane); continue; }
        r -= 8 * I_GU;
        if (r < 4 * I_D) { const int l = r / I_D; r -= l * I_D; const int kb = r / 32, n0 = (r % 32) * 32;
            tr_item(a->in[9] + (size_t)l * FF * 1024, 1024, kb * 64, n0, (bf16*)(ws + WS_WD) + ((size_t)l * 1024 + n0) * FF, FF, nullptr, scr, lane); continue; }
        r -= 4 * I_D;
        if (r < 2 * I_SQ) { const int l = r / I_SQ; r -= l * I_SQ; const int kb = r / 32, n0 = (r % 32) * 32;
            tr_item(a->in[18] + (size_t)l * 1024 * 1024, 1024, kb * 64, n0, (bf16*)(ws + WS_WGLU) + ((size_t)l * 1024 + n0) * 1024, 1024, nullptr, scr, lane); continue; }
        r -= 2 * I_SQ;
        if (r < 2 * I_DQ) { const int l = r / I_DQ; r -= l * I_DQ; const int kb = r / 8, n0 = (r % 8) * 32;
            tr_item(a->in[28] + (size_t)l * 1024 * 256, 256, kb * 64, n0, (bf16*)(ws + WS_WDQ) + ((size_t)l * 256 + n0) * 1024, 1024, nullptr, scr, lane); continue; }
        r -= 2 * I_DQ;
        if (r < I_KVA) { const int kb = r / 9, n0 = (r % 9) * 32;
            tr_item(a->in[23], 288, kb * 64, n0, (bf16*)(ws + WS_WKVA) + (size_t)n0 * 1024, 1024, nullptr, scr, lane); continue; }
        r -= I_KVA;
        if (r < 2 * I_UQ) { const int l = r / I_UQ; r -= l * I_UQ; const int kb = r / 48, n0 = (r % 48) * 32; const int hh = n0 / 96, db = (n0 - hh * 96) >> 5;
            const int drow = (db < 2) ? (256 * (hh >> 2) + 128 * db + 32 * (hh & 3)) : (1024 + 256 * (hh >> 3) + 128 * ((hh & 7) >> 2) + 32 * (hh & 3));
            tr_item(a->in[30] + (size_t)l * 256 * 1536, 1536, kb * 64, n0, (bf16*)(ws + WS_WUQ) + ((size_t)l * 1536 + drow) * 256, 256, a->in[29] + l * 256, scr, lane); continue; }
        r -= 2 * I_UQ;
        if (r < I_KVB) { const int kb = r / 64, n0 = (r % 64) * 32; const int hh = n0 >> 7, db = (n0 & 127) >> 5;
            const int drow = (db < 2) ? (256 * (hh >> 2) + 128 * db + 32 * (hh & 3)) : (1024 + hh * 64 + (db - 2) * 32);
            tr_item(a->in[25], 2048, kb * 64, n0, (bf16*)(ws + WS_WKVB) + (size_t)drow * 256, 256, a->in[24], scr, lane); continue; }
        r -= I_KVB;
        { const int l = r / I_SQ; r -= l * I_SQ; const int kb = r / 32, n0 = (r % 32) * 32;
            tr_item(a->in[33] + (size_t)l * 1024 * 1024, 1024, kb * 64, n0, (bf16*)(ws + WS_WO) + ((size_t)l * 1024 + n0) * 1024, 1024, nullptr, scr, lane); }
    }
    const int gt = lsi(blockIdx.x) * 512 + tid, NT_ = G * 512;
    const int* pos = (const int*)a->in[2];
    for (int idx = gt; idx < T * 16; idx += NT_) { const int row = idx >> 4, i = idx & 15;
        const double b4 = (i & 3) == 0 ? 1.0 : (i & 3) == 1 ? 0.56234132519034908 : (i & 3) == 2 ? 0.31622776601683794 : 0.17782794100389228;
        const double p10 = (i >> 2) == 0 ? 1.0 : (i >> 2) == 1 ? 0.1 : (i >> 2) == 2 ? 0.01 : 0.001;
        double s, c; dsincos((double)pos[row] * (b4 * p10), s, c);
        ((float*)(ws + WS_COS))[idx] = (float)c; ((float*)(ws + WS_SIN))[idx] = (float)s; }
    for (int idx = gt; idx < 3 * T; idx += NT_) ((float*)(ws + WS_QSS))[idx] = 0.f;
    for (int idx = gt; idx < 224 * 1024 / 2; idx += NT_) ((unsigned*)((bf16*)(ws + WS_WKVA) + 288 * 1024))[idx] = 0u;
}

__device__ __forceinline__ void s5_norm_phase(KArgs a, int l, const float* xin, unsigned char* lds, int G_) { const int G = lsi(G_);
    const int tid = lv(threadIdx.x), lane = tid & 63, wave = tid >> 6;
    bf16* stage = (bf16*)lds;
    const float* ng = a->in[5] + l * 1024;
    bf16* AUG = (bf16*)(a->ws + WS_AUG);
    for (int it = lsi(blockIdx.x); it < NB * NSUB; it += G) {
        const int b = it >> 8, c = it & 255;
        const float* ada = (const float*)(a->ws + WS_ADA) + ((size_t)l * 8 + b) * 6144;
        f32x4 mul[4], add[4];
#pragma unroll
        for (int j = 0; j < 4; ++j) { const int ch = 4 * lane + 256 * j; const f32x4 gg = *(const f32x4*)(ng + ch), sc = *(const f32x4*)(ada + 1024 + ch); mul[j] = gg * (sc + 1.0f); add[j] = *(const f32x4*)(ada + ch); }
#pragma unroll
        for (int tt = 0; tt < 2; ++tt) { const int tok = 2 * wave + tt; const float* xr = xin + ((size_t)b * SEQ + c * 16 + tok) * 1024;
            f32x4 v[4]; float ss = 0.f;
#pragma unroll
            for (int j = 0; j < 4; ++j) { v[j] = *(const f32x4*)(xr + 4 * lane + 256 * j); ss += (v[j].x * v[j].x + v[j].y * v[j].y) + (v[j].z * v[j].z + v[j].w * v[j].w); }
            const float rstd = rsqrtf(wave_sum(ss, lane) * (1.f / 1024.f) + EPS);
#pragma unroll
            for (int j = 0; j < 4; ++j) { const f32x4 h = v[j] * rstd * mul[j] + add[j]; *(v2u*)(stage + tok * 1024 + 4 * lane + 256 * j) = (v2u){pk2(h.x, h.y), pk2(h.z, h.w)}; } }
        __syncthreads();
        { const int g = tid >> 3, part = tid & 7; bf16* dst = AUG + ((size_t)g * 2048 + b * 256 + c) * AUGK;
#pragma unroll
            for (int k = 0; k < 4; ++k) { const int chunk = part * 4 + k, s = chunk >> 1, qh = chunk & 1; *(v4u*)(dst + chunk * 8) = *(const v4u*)(stage + s * 1024 + g * 16 + qh * 8); } }
        __syncthreads();
    }
}
__device__ __forceinline__ void norm_phase(const float* x, const float* g1, const float* sh1, const float* sc1, int bstride1, bf16* out1,
                                           const float* g2, const float* sh2, const float* sc2, int bstride2, bf16* out2, int G_) { const int G = lsi(G_);
    const int tid = lv(threadIdx.x), lane = tid & 63, wave = tid >> 6;
    for (int rb = lsi(blockIdx.x) * 8 + wave; rb < T / 16; rb += G * 8) {
        const int b = rb >> 8;
        f32x4 mul[4], add[4], mul2[4], add2[4];
#pragma unroll
        for (int j = 0; j < 4; ++j) { const int ch = 4 * lane + 256 * j; mul[j] = *(const f32x4*)(g1 + ch) * (*(const f32x4*)(sc1 + (size_t)b * bstride1 + ch) + 1.0f); add[j] = *(const f32x4*)(sh1 + (size_t)b * bstride1 + ch);
            if (out2) { mul2[j] = *(const f32x4*)(g2 + ch) * (*(const f32x4*)(sc2 + (size_t)b * bstride2 + ch) + 1.0f); add2[j] = *(const f32x4*)(sh2 + (size_t)b * bstride2 + ch); } }
        for (int r4 = 0; r4 < 16; r4 += 4) {
            f32x4 v[4][4]; float ss[4];
#pragma unroll
            for (int q = 0; q < 4; ++q) { const float* xr = x + ((size_t)rb * 16 + r4 + q) * 1024; ss[q] = 0.f;
#pragma unroll
                for (int j = 0; j < 4; ++j) v[q][j] = *(const f32x4*)(xr + 4 * lane + 256 * j); }
#pragma unroll
            for (int q = 0; q < 4; ++q)
#pragma unroll
                for (int j = 0; j < 4; ++j) ss[q] += (v[q][j].x * v[q][j].x + v[q][j].y * v[q][j].y) + (v[q][j].z * v[q][j].z + v[q][j].w * v[q][j].w);
#pragma unroll
            for (int o = 1; o < 64; o <<= 1) {
                const float t0 = shx(ss[0], lane, o), t1 = shx(ss[1], lane, o), t2 = shx(ss[2], lane, o), t3 = shx(ss[3], lane, o);
                ss[0] += t0; ss[1] += t1; ss[2] += t2; ss[3] += t3; }
#pragma unroll
            for (int q = 0; q < 4; ++q) { const size_t row = (size_t)rb * 16 + r4 + q; const float rstd = rsqrtf(ss[q] * (1.f / 1024.f) + EPS);
#pragma unroll
                for (int j = 0; j < 4; ++j) { const f32x4 h = v[q][j] * rstd * mul[j] + add[j]; *(v2u*)(out1 + row * 1024 + 4 * lane + 256 * j) = (v2u){pk2(h.x, h.y), pk2(h.z, h.w)}; }
                if (out2) {
#pragma unroll
                    for (int j = 0; j < 4; ++j) { const f32x4 h = v[q][j] * rstd * mul2[j] + add2[j]; *(v2u*)(out2 + row * 1024 + 4 * lane + 256 * j) = (v2u){pk2(h.x, h.y), pk2(h.z, h.w)}; } } }
        }
    }
}
__device__ __forceinline__ void carry_phase(KArgs a, int l, int G_) { const int G = lsi(G_);
    const int tid = lv(threadIdx.x), lane = tid & 63, wave = tid >> 6;
    const float* EB = (const float*)(a->ws + WS_EBUF); bf16* AUG = (bf16*)(a->ws + WS_AUG);
    const int nn = lane >> 4, j = lane & 15;
    for (int L = lsi(blockIdx.x); L < 512; L += G)
    for (int nq = wave; nq < 16; nq += 8) {
        const int b = L & 7, g = L >> 3, n = nq * 4 + nn;
        const f32x2 a16 = ((const f32x2*)(a->ws + WS_A16))[(l * 64 + g) * 64 + n];
        const f32x4* ep = (const f32x4*)(EB + ((((size_t)(g * 8 + b) * 64 + n) * 256) + j * 16) * 2);
        f32x4 e[8];
#pragma unroll
        for (int i = 0; i < 8; ++i) e[i] = ep[i];
        f32x2 t = {0.f, 0.f};
#pragma unroll
        for (int i = 0; i < 8; ++i) { t = cmul(a16, t) + (f32x2){e[i].x, e[i].y}; t = cmul(a16, t) + (f32x2){e[i].z, e[i].w}; }
        f32x2 Ad = a16;
#pragma unroll
        for (int k = 0; k < 4; ++k) Ad = cmul(Ad, Ad);
#pragma unroll
        for (int d = 1; d < 16; d <<= 1) { const int sl = ((j >= d) ? lane - d : lane) << 2; const float tx_ = t.x, ty_ = t.y; const float orr = __builtin_bit_cast(float, __builtin_amdgcn_ds_bpermute(sl, __builtin_bit_cast(int, tx_))), oi = __builtin_bit_cast(float, __builtin_amdgcn_ds_bpermute(sl, __builtin_bit_cast(int, ty_)));
            if (j >= d) { t.x += Ad.x * orr - Ad.y * oi; t.y += Ad.x * oi + Ad.y * orr; }
            Ad = cmul(Ad, Ad); }
        f32x2 cur; { const int sl = ((j >= 1) ? lane - 1 : lane) << 2; const float tx_ = t.x, ty_ = t.y; cur.x = __builtin_bit_cast(float, __builtin_amdgcn_ds_bpermute(sl, __builtin_bit_cast(int, tx_))); cur.y = __builtin_bit_cast(float, __builtin_amdgcn_ds_bpermute(sl, __builtin_bit_cast(int, ty_))); } if (j == 0) cur = (f32x2){0.f, 0.f};
        bf16* op = AUG + ((size_t)g * 2048 + b * 256 + j * 16) * AUGK + 256 + 2 * n;
#pragma unroll
        for (int i = 0; i < 8; ++i) {
            *(unsigned*)(op + (size_t)(2 * i) * AUGK) = pk2(cur.x, cur.y); cur = cmul(a16, cur) + (f32x2){e[i].x, e[i].y};
            *(unsigned*)(op + (size_t)(2 * i + 1) * AUGK) = pk2(cur.x, cur.y); cur = cmul(a16, cur) + (f32x2){e[i].z, e[i].w}; }
    }
}

using pg8::Unit;
typedef const f32x4 (&AccRef)[2][2][4][2];
struct GroupOrder {
    int G, c;
    __device__ __forceinline__ bool next(int i, Unit& u) const { const int L = i * G + c; if (L >= 512) return false; u.pm = L; u.pn = L >> 3; return true; }
    __device__ __forceinline__ void a_ready(const Unit&) const {}
    __device__ __forceinline__ void done(const Unit&) const {}
};
struct EpiE { static constexpr bool PERM = false, AFTER_DRAIN = false; float* E;
    __device__ __forceinline__ void operator()(AccRef acc, const Unit& u, int wr, int wc, int fr, int fq) const { fr = lv(fr); fq = lv(fq);
        float* base = E + (size_t)((u.pn * 8 + (u.pm & 7)) * 64) * 512;
#pragma unroll
        for (int ai = 0; ai < 2; ++ai)
#pragma unroll
            for (int m = 0; m < 4; ++m) { const int c = ai * 128 + wr * 64 + m * 16 + fr;
#pragma unroll
                for (int n = 0; n < 2; ++n) { const int ns = 16 * wc + 8 * n + 2 * fq; const f32x4 v = acc[ai][0][m][n];
                    *(f32x2*)(base + ((size_t)ns * 256 + c) * 2) = (f32x2){v.x, v.y}; *(f32x2*)(base + ((size_t)(ns + 1) * 256 + c) * 2) = (f32x2){v.z, v.w}; } }
    }
};
struct EpiY { static constexpr bool PERM = true, AFTER_DRAIN = false; bf16* Gd;
    __device__ __forceinline__ void operator()(AccRef acc, const Unit& u, int wr, int wc, int fr, int fq) const { fr = lv(fr); fq = lv(fq);
        const int g = u.pn, b = u.pm & 7;
#pragma unroll
        for (int bj = 0; bj < 2; ++bj) { const int tc0 = 128 * bj + 32 * wc + 8 * fq, t = tc0 >> 4, p0 = tc0 & 15;
#pragma unroll
            for (int ai = 0; ai < 2; ++ai)
#pragma unroll
                for (int m = 0; m < 4; ++m) { const int r = ai * 128 + wr * 64 + m * 16 + fr; const size_t tok = (size_t)b * SEQ + r * 16 + t;
                    const f32x4 v0 = acc[ai][bj][m][0], v1 = acc[ai][bj][m][1];
                    v4u w; w.x = pk2(gelu_tanh(v0.x), gelu_tanh(v0.y)); w.y = pk2(gelu_tanh(v0.z), gelu_tanh(v0.w)); w.z = pk2(gelu_tanh(v1.x), gelu_tanh(v1.y)); w.w = pk2(gelu_tanh(v1.z), gelu_tanh(v1.w));
                    *(v4u*)(Gd + tok * 1024 + g * 16 + p0) = w; } }
    }
};
struct EpiGlu { static constexpr bool PERM = false, AFTER_DRAIN = false; const bf16* Gd; const float* bglu; const float* gate; const float* xin; float* xout;
    __device__ __forceinline__ void operator()(AccRef acc, const Unit& u, int wr, int wc, int fr, int fq) const { fr = lv(fr); fq = lv(fq);
        const int b = u.pm >> 4; f32x4 gt[2][2], bg[2][2];
#pragma unroll
        for (int bj = 0; bj < 2; ++bj)
#pragma unroll
            for (int n = 0; n < 2; ++n) { const int col = u.pn * 256 + 128 * bj + 32 * wc + 16 * n + 4 * fq; bg[bj][n] = *(const f32x4*)(bglu + col); gt[bj][n] = *(const f32x4*)(gate + (size_t)b * 6144 + col); }
#pragma unroll
        for (int ai = 0; ai < 2; ++ai)
#pragma unroll
            for (int mh = 0; mh < 2; ++mh) { f32x4 xv[2][2][2]; v2u gw[2][2][2];
                const size_t o0 = (size_t)(u.pm * 256 + ai * 128 + wr * 64 + mh * 32 + fr) * 1024 + u.pn * 256 + 32 * wc + 4 * fq;
#pragma unroll
                for (int m = 0; m < 2; ++m)
#pragma unroll
                    for (int bj = 0; bj < 2; ++bj)
#pragma unroll
                        for (int n = 0; n < 2; ++n) { const size_t off = o0 + (size_t)m * 16 * 1024 + 128 * bj + 16 * n; xv[m][bj][n] = *(const f32x4*)(xin + off); gw[m][bj][n] = *(const v2u*)(Gd + off); }
                asm volatile("" ::: "memory");
#pragma unroll
                for (int m = 0; m < 2; ++m)
#pragma unroll
                    for (int bj = 0; bj < 2; ++bj)
#pragma unroll
                        for (int n = 0; n < 2; ++n) { const size_t off = o0 + (size_t)m * 16 * 1024 + 128 * bj + 16 * n; const v2u g2 = gw[m][bj][n];
                            const f32x4 gv = {bflo(g2.x), bfhi(g2.x), bflo(g2.y), bfhi(g2.y)};
                            const f32x4 z = acc[ai][bj][2 * mh + m][n] + bg[bj][n]; const f32x4 mix = {gv.x * sigm(z.x), gv.y * sigm(z.y), gv.z * sigm(z.z), gv.w * sigm(z.w)};
                            *(f32x4*)(xout + off) = xv[m][bj][n] + gt[bj][n] * mix; }
                asm volatile("" ::: "memory"); }
    }
};
struct EpiRes { static constexpr bool PERM = false, AFTER_DRAIN = false; const float* gate; float* x;
    __device__ __forceinline__ void operator()(AccRef acc, const Unit& u, int wr, int wc, int fr, int fq) const { fr = lv(fr); fq = lv(fq);
        const int b = u.pm >> 4; f32x4 gt[2][2];
#pragma unroll
        for (int bj = 0; bj < 2; ++bj)
#pragma unroll
            for (int n = 0; n < 2; ++n) gt[bj][n] = *(const f32x4*)(gate + (size_t)b * 6144 + u.pn * 256 + 128 * bj + 32 * wc + 16 * n + 4 * fq);
#pragma unroll
        for (int ai = 0; ai < 2; ++ai) { f32x4 xv[4][2][2];
            float* xb = x + (size_t)(u.pm * 256 + ai * 128 + wr * 64 + fr) * 1024 + u.pn * 256 + 32 * wc + 4 * fq;
#pragma unroll
            for (int m = 0; m < 4; ++m)
#pragma unroll
                for (int bj = 0; bj < 2; ++bj)
#pragma unroll
                    for (int n = 0; n < 2; ++n) xv[m][bj][n] = *(const f32x4*)(xb + (size_t)m * 16 * 1024 + 128 * bj + 16 * n);
            asm volatile("" ::: "memory");
#pragma unroll
            for (int m = 0; m < 4; ++m)
#pragma unroll
                for (int bj = 0; bj < 2; ++bj)
#pragma unroll
                    for (int n = 0; n < 2; ++n) *(f32x4*)(xb + (size_t)m * 16 * 1024 + 128 * bj + 16 * n) = xv[m][bj][n] + gt[bj][n] * acc[ai][bj][m][n];
            asm volatile("" ::: "memory"); }
    }
};
__device__ __forceinline__ float sq4(f32x4 v);
struct EpiNone { static constexpr bool PERM = false, AFTER_DRAIN = false; float* sink;
    __device__ __forceinline__ void operator()(AccRef acc, const Unit& u, int wr, int wc, int fr, int fq) const { if (sink) { float s = 0.f;
#pragma unroll
        for (int ai = 0; ai < 2; ++ai)
#pragma unroll
            for (int bj = 0; bj < 2; ++bj)
#pragma unroll
                for (int m = 0; m < 4; ++m)
#pragma unroll
                    for (int n = 0; n < 2; ++n) s += sq4(acc[ai][bj][m][n]);
        if (s == 123.456f) sink[0] = s; } }
};
__device__ __forceinline__ float sq4(f32x4 v);
__device__ __forceinline__ void silu2(float g1, float g2, float u1, float u2, float& o1, float& o2) {
    const float a = 1.f + fminf(__expf(-g1), 1e18f), b = 1.f + fminf(__expf(-g2), 1e18f);
    const float r = __builtin_amdgcn_rcpf(a * b);
    o1 = g1 * u1 * (r * b); o2 = g2 * u2 * (r * a);
}
struct EpiGU { static constexpr bool PERM = true, AFTER_DRAIN = false; bf16* H;
    __device__ __forceinline__ void operator()(AccRef acc, const Unit& u, int wr, int wc, int fr, int fq) const { fr = lv(fr); fq = lv(fq);
#pragma unroll
        for (int ai = 0; ai < 2; ++ai)
#pragma unroll
            for (int m = 0; m < 4; ++m) { const size_t row = (size_t)(u.pm * 256 + ai * 128 + wr * 64 + m * 16 + fr);
                const f32x4 g0 = acc[ai][0][m][0], g1 = acc[ai][0][m][1], u0 = acc[ai][1][m][0], u1 = acc[ai][1][m][1];
                float h[8];
                silu2(g0.x, g0.y, u0.x, u0.y, h[0], h[1]); silu2(g0.z, g0.w, u0.z, u0.w, h[2], h[3]);
                silu2(g1.x, g1.y, u1.x, u1.y, h[4], h[5]); silu2(g1.z, g1.w, u1.z, u1.w, h[6], h[7]);
                v4u w; w.x = pk2(h[0], h[1]); w.y = pk2(h[2], h[3]); w.z = pk2(h[4], h[5]); w.w = pk2(h[6], h[7]);
                *(v4u*)(H + row * FF + u.pn * 128 + 32 * wc + 8 * fq) = w; }
    }
};
__device__ __forceinline__ float sq4(f32x4 v) { return (v.x * v.x + v.y * v.y) + (v.z * v.z + v.w * v.w); }
__device__ __forceinline__ float quad_sum_(float s, int lane) { s += shx(s, lane, 16); s += shx(s, lane, 32); return s; }
#define quad_sum(s) quad_sum_((s), fr + 16 * fq)
struct EpiDq { static constexpr bool PERM = true, AFTER_DRAIN = false; bf16* QA; float* SS;
    __device__ __forceinline__ void operator()(AccRef acc, const Unit& u, int wr, int wc, int fr, int fq) const { fr = lv(fr); fq = lv(fq);
#pragma unroll
        for (int ai = 0; ai < 2; ++ai)
#pragma unroll
            for (int m = 0; m < 4; ++m) { const size_t row = (size_t)(u.pm * 256 + ai * 128 + wr * 64 + m * 16 + fr); float ss = 0.f;
#pragma unroll
                for (int bj = 0; bj < 2; ++bj) { const f32x4 v0 = acc[ai][bj][m][0], v1 = acc[ai][bj][m][1]; ss += sq4(v0) + sq4(v1);
                    *(v4u*)(QA + row * 256 + 128 * bj + 32 * wc + 8 * fq) = (v4u){pk2(v0.x, v0.y), pk2(v0.z, v0.w), pk2(v1.x, v1.y), pk2(v1.z, v1.w)}; }
                ss = quad_sum(ss); if (fq == 0) atomicAdd(SS + row, ss); }
    }
};
struct EpiKva { static constexpr bool PERM = false, AFTER_DRAIN = false; bf16* CKV; float* SS; bf16* KR; const float* gkr; const float* COS; const float* SIN;
    __device__ __forceinline__ void operator()(AccRef acc, const Unit& u, int wr, int wc, int fr, int fq) const { fr = lv(fr); fq = lv(fq);
        if (u.pn == 0) {
#pragma unroll
            for (int ai = 0; ai < 2; ++ai)
#pragma unroll
                for (int m = 0; m < 4; ++m) { const size_t row = (size_t)(u.pm * 256 + ai * 128 + wr * 64 + m * 16 + fr); float ss = 0.f;
#pragma unroll
                    for (int bj = 0; bj < 2; ++bj)
#pragma unroll
                        for (int n = 0; n < 2; ++n) { const f32x4 v = acc[ai][bj][m][n]; ss += sq4(v); *(v2u*)(CKV + row * 256 + 128 * bj + 32 * wc + 16 * n + 4 * fq) = (v2u){pk2(v.x, v.y), pk2(v.z, v.w)}; }
                    ss = quad_sum(ss); if (fq == 0) atomicAdd(SS + row, ss); }
        } else if (wc == 0) {
            const f32x4 g1 = *(const f32x4*)(gkr + 4 * fq), g2 = *(const f32x4*)(gkr + 16 + 4 * fq);
#pragma unroll
            for (int ai = 0; ai < 2; ++ai) { f32x4 cs[4], sn[4];
#pragma unroll
                for (int m = 0; m < 4; ++m) { const size_t row = (size_t)(u.pm * 256 + ai * 128 + wr * 64 + m * 16 + fr); cs[m] = *(const f32x4*)(COS + row * 16 + 4 * fq); sn[m] = *(const f32x4*)(SIN + row * 16 + 4 * fq); }
                asm volatile("" ::: "memory");
#pragma unroll
                for (int m = 0; m < 4; ++m) { const size_t row = (size_t)(u.pm * 256 + ai * 128 + wr * 64 + m * 16 + fr);
                    const f32x4 x1 = acc[ai][0][m][0], x2 = acc[ai][0][m][1];
                    const float rstd = rsqrtf(quad_sum(sq4(x1) + sq4(x2)) * (1.f / 32.f) + EPS);
                    const f32x4 y1 = x1 * rstd * g1, y2 = x2 * rstd * g2, o1 = y1 * cs[m] - y2 * sn[m], o2 = y1 * sn[m] + y2 * cs[m];
                    *(v2u*)(KR + row * 32 + 4 * fq) = (v2u){pk2(o1.x, o1.y), pk2(o1.z, o1.w)}; *(v2u*)(KR + row * 32 + 16 + 4 * fq) = (v2u){pk2(o2.x, o2.y), pk2(o2.z, o2.w)}; }
                asm volatile("" ::: "memory"); }
        }
    }
};
constexpr float QSC = 0.10206207261596577f * 1.4426950408889634f;
struct EpiUq { static constexpr bool PERM = false, AFTER_DRAIN = false; const float* SS; const float* gn; const float* gr; const float* COS; const float* SIN; bf16* QB;
    __device__ __forceinline__ void operator()(AccRef acc, const Unit& u, int wr, int wc, int fr, int fq) const { fr = lv(fr); fq = lv(fq);
        const int b = u.pm >> 4; float ssv[2][4];
#pragma unroll
        for (int ai = 0; ai < 2; ++ai)
#pragma unroll
            for (int m = 0; m < 4; ++m) ssv[ai][m] = SS[(size_t)(u.pm * 256 + ai * 128 + wr * 64 + m * 16 + fr)];
        if (u.pn < 4) { const int hh = 4 * u.pn + wc; f32x4 g[2][2];
#pragma unroll
            for (int bj = 0; bj < 2; ++bj)
#pragma unroll
                for (int n = 0; n < 2; ++n) g[bj][n] = *(const f32x4*)(gn + 32 * bj + 16 * n + 4 * fq) * QSC;
            asm volatile("" ::: "memory");
#pragma unroll
            for (int ai = 0; ai < 2; ++ai)
#pragma unroll
                for (int m = 0; m < 4; ++m) { const int rowi = u.pm * 256 + ai * 128 + wr * 64 + m * 16 + fr; const int sq_ = rowi & (SEQ - 1);
                    const float rq = rsqrtf(ssv[ai][m] * (1.f / 256.f) + EPS); float ss = 0.f; f32x4 v[2][2];
#pragma unroll
                    for (int bj = 0; bj < 2; ++bj)
#pragma unroll
                        for (int n = 0; n < 2; ++n) { v[bj][n] = acc[ai][bj][m][n] * rq; ss += sq4(v[bj][n]); }
                    const float rh = rsqrtf(quad_sum(ss) * (1.f / 64.f) + EPS);
                    bf16* dst = QB + (((size_t)b * NH + hh) * SEQ + sq_) * 96;
#pragma unroll
                    for (int bj = 0; bj < 2; ++bj)
#pragma unroll
                        for (int n = 0; n < 2; ++n) { const f32x4 o = v[bj][n] * rh * g[bj][n]; *(v2u*)(dst + 32 * bj + 16 * n + 4 * fq) = (v2u){pk2(o.x, o.y), pk2(o.z, o.w)}; } }
        } else {
            const f32x4 g1 = *(const f32x4*)(gr + 4 * fq) * QSC, g2 = *(const f32x4*)(gr + 16 + 4 * fq) * QSC;
#pragma unroll
            for (int ai = 0; ai < 2; ++ai) { f32x4 cs[4], sn[4];
#pragma unroll
                for (int m = 0; m < 4; ++m) { const size_t row = (size_t)(u.pm * 256 + ai * 128 + wr * 64 + m * 16 + fr); cs[m] = *(const f32x4*)(COS + row * 16 + 4 * fq); sn[m] = *(const f32x4*)(SIN + row * 16 + 4 * fq); }
                asm volatile("" ::: "memory");
#pragma unroll
                for (int m = 0; m < 4; ++m) { const int rowi = u.pm * 256 + ai * 128 + wr * 64 + m * 16 + fr; const int sq_ = rowi & (SEQ - 1);
                    const float rq = rsqrtf(ssv[ai][m] * (1.f / 256.f) + EPS);
#pragma unroll
                    for (int bj = 0; bj < 2; ++bj) { const int hh = 8 * (u.pn - 4) + 4 * bj + wc;
                        const f32x4 x1 = acc[ai][bj][m][0] * rq, x2 = acc[ai][bj][m][1] * rq;
                        const float rh = rsqrtf(quad_sum(sq4(x1) + sq4(x2)) * (1.f / 32.f) + EPS);
                        const f32x4 y1 = x1 * rh * g1, y2 = x2 * rh * g2, o1 = y1 * cs[m] - y2 * sn[m], o2 = y1 * sn[m] + y2 * cs[m];
                        bf16* dst = QB + (((size_t)b * NH + hh) * SEQ + sq_) * 96 + 64;
                        *(v2u*)(dst + 4 * fq) = (v2u){pk2(o1.x, o1.y), pk2(o1.z, o1.w)}; *(v2u*)(dst + 16 + 4 * fq) = (v2u){pk2(o2.x, o2.y), pk2(o2.z, o2.w)}; } }
                asm volatile("" ::: "memory"); }
        }
    }
};
struct EpiKvb { static constexpr bool PERM = false, AFTER_DRAIN = false; const float* SS; const float* gk; bf16* KB; bf16* VB;
    __device__ __forceinline__ void operator()(AccRef acc, const Unit& u, int wr, int wc, int fr, int fq) const { fr = lv(fr); fq = lv(fq);
        const int b = u.pm >> 4; float ssv[2][4]; f32x4 g[2][2];
#pragma unroll
        for (int ai = 0; ai < 2; ++ai)
#pragma unroll
            for (int m = 0; m < 4; ++m) ssv[ai][m] = SS[(size_t)(u.pm * 256 + ai * 128 + wr * 64 + m * 16 + fr)];
#pragma unroll
        for (int bj = 0; bj < 2; ++bj)
#pragma unroll
            for (int n = 0; n < 2; ++n) g[bj][n] = *(const f32x4*)(gk + 32 * bj + 16 * n + 4 * fq);
        asm volatile("" ::: "memory");
#pragma unroll
        for (int ai = 0; ai < 2; ++ai)
#pragma unroll
            for (int m = 0; m < 4; ++m) { const int rowi = u.pm * 256 + ai * 128 + wr * 64 + m * 16 + fr; const int sq_ = rowi & (SEQ - 1);
                const float rc = rsqrtf(ssv[ai][m] * (1.f / 256.f) + EPS);
                if (u.pn < 4) { const int hh = 4 * u.pn + wc; float ss = 0.f; f32x4 v[2][2];
#pragma unroll
                    for (int bj = 0; bj < 2; ++bj)
#pragma unroll
                        for (int n = 0; n < 2; ++n) { v[bj][n] = acc[ai][bj][m][n] * rc; ss += sq4(v[bj][n]); }
                    const float rh = rsqrtf(quad_sum(ss) * (1.f / 64.f) + EPS);
                    bf16* dst = KB + (((size_t)b * NH + hh) * SEQ + sq_) * 64;
#pragma unroll
                    for (int bj = 0; bj < 2; ++bj)
#pragma unroll
                        for (int n = 0; n < 2; ++n) { const f32x4 o = v[bj][n] * rh * g[bj][n]; *(v2u*)(dst + 32 * bj + 16 * n + 4 * fq) = (v2u){pk2(o.x, o.y), pk2(o.z, o.w)}; }
                } else {
#pragma unroll
                    for (int bj = 0; bj < 2; ++bj)
#pragma unroll
                        for (int n = 0; n < 2; ++n) { const int col = 256 * (u.pn - 4) + 128 * bj + 32 * wc + 16 * n + 4 * fq, hh = col >> 6, dv = col & 63;
                            const f32x4 o = acc[ai][bj][m][n] * rc; *(v2u*)(VB + (((size_t)b * NH + hh) * SEQ + sq_) * 64 + dv) = (v2u){pk2(o.x, o.y), pk2(o.z, o.w)}; }
                } }
    }
};

namespace att {
using bf16x8 = __attribute__((ext_vector_type(8))) short;
using s16x4 = __attribute__((ext_vector_type(4))) short;
using f32x16 = __attribute__((ext_vector_type(16))) float;
using u32x4 = __attribute__((ext_vector_type(4))) unsigned;
constexpr int QBLK = 32, KVBLK = 64;
constexpr float SCALE = 0.10206207261596577f;
constexpr float THR = 6.f;
constexpr int SHM_V = 64 * 64 * 2, SHM_K = 64 * 256;
#define KSWZ(row, colB) ((row) * 256 + ((colB) ^ (((row) & 7) << 4)))
#define SBAR() __builtin_amdgcn_sched_barrier(0)
__device__ __forceinline__ int crow(int r, int hi) { return (r & 3) + 8 * (r >> 2) + 4 * hi; }
__device__ __forceinline__ unsigned cvtpk(float lo, float hi) { unsigned r; asm volatile("v_cvt_pk_bf16_f32 %0, %1, %2" : "=v"(r) : "v"(lo), "v"(hi)); return r; }
__device__ __forceinline__ void partialSM(f32x16& p0, f32x16& p1, float& m_reg, f32x16& negm, float& alpha) {
    constexpr float THRL = THR * 1.4426950408889634f;
    float pmax = p0[0];
#pragma unroll
    for (int r = 1; r < 16; ++r) pmax = fmaxf(pmax, p0[r]);
#pragma unroll
    for (int r = 0; r < 16; ++r) pmax = fmaxf(pmax, p1[r]);
    { auto rr = __builtin_amdgcn_permlane32_swap(__float_as_uint(pmax), __float_as_uint(pmax), false, false); pmax = fmaxf(__uint_as_float(rr[0]), __uint_as_float(rr[1])); }
    if (__builtin_expect(__all(pmax <= THRL), 1)) { alpha = 1.f; }
    else { const float dl = fmaxf(pmax, 0.f); m_reg += dl; alpha = __builtin_amdgcn_exp2f(-dl);
#pragma unroll
        for (int r = 0; r < 16; ++r) { p0[r] -= dl; p1[r] -= dl; }
#pragma unroll
        for (int r = 0; r < 16; ++r) negm[r] = -m_reg; }
#pragma unroll
    for (int r = 0; r < 16; ++r) p0[r] = __builtin_amdgcn_exp2f(p0[r]);
}
__device__ __forceinline__ void finishSM(f32x16& p0, f32x16& p1, float alpha, float& l_reg, bf16x8& pa0, bf16x8& pa1, bf16x8& pa2, bf16x8& pa3) {
#pragma unroll
    for (int r = 0; r < 16; ++r) p1[r] = __builtin_amdgcn_exp2f(p1[r]);
    float ps = 0;
#pragma unroll
    for (int r = 0; r < 16; ++r) ps += p0[r];
#pragma unroll
    for (int r = 0; r < 16; ++r) ps += p1[r];
    { auto rr = __builtin_amdgcn_permlane32_swap(__float_as_uint(ps), __float_as_uint(ps), false, false); ps = __uint_as_float(rr[0]) + __uint_as_float(rr[1]); }
    l_reg = l_reg * alpha + ps;
#define PK4(P, BASE, OUT) do { unsigned a0 = cvtpk(P[BASE + 0], P[BASE + 1]), a1 = cvtpk(P[BASE + 2], P[BASE + 3]);   \
    unsigned b0 = cvtpk(P[BASE + 4], P[BASE + 5]), b1 = cvtpk(P[BASE + 6], P[BASE + 7]);                              \
    auto r0 = __builtin_amdgcn_permlane32_swap(a0, b0, false, false); auto r1 = __builtin_amdgcn_permlane32_swap(a1, b1, false, false); \
    u32x4 w = {r0[0], r1[0], r0[1], r1[1]}; OUT = *reinterpret_cast<bf16x8*>(&w); } while (0)
    PK4(p0, 0, pa0); PK4(p0, 8, pa1); PK4(p1, 0, pa2); PK4(p1, 8, pa3);
#undef PK4
}
__device__ __forceinline__ void qkt(f32x16& p0, f32x16& p1, const char* Ks, const bf16x8* qr, int r32, int hi, const f32x16& cin) {
    p0 = cin; p1 = cin;
#pragma unroll
    for (int d0 = 0; d0 < 6; ++d0) { const int cb = (d0 * 16 + hi * 8) * 2;
        const bf16x8 b0 = *reinterpret_cast<const bf16x8*>(Ks + KSWZ(r32, cb));
        const bf16x8 b1 = *reinterpret_cast<const bf16x8*>(Ks + KSWZ(32 + r32, cb));
        p0 = __builtin_amdgcn_mfma_f32_32x32x16_bf16(b0, qr[d0], p0, 0, 0, 0);
        p1 = __builtin_amdgcn_mfma_f32_32x32x16_bf16(b1, qr[d0], p1, 0, 0, 0); }
}
__device__ __forceinline__ int v_st(int k, int c) { const int kk = (k & ~0xC) | ((k & 4) << 1) | ((k & 8) >> 1); return ((kk >> 3) * 2 + (c >> 5)) * 512 + ((kk & 7) * 32 + (c & 31)) * 2; }
__device__ __forceinline__ int v_rd_base(int lane) { return ((lane & 3) << 3) | (((lane >> 2) & 3) << 6) | (((lane >> 4) & 1) << 5) | (((lane >> 5) & 1) << 8); }
constexpr int v_rd_off(int d0, int ks, int half) { return d0 * 512 + ks * 2048 + half * 1024; }
template <int OFF> __device__ __forceinline__ s16x4 tr_read(int vb) { s16x4 r; asm volatile("ds_read_b64_tr_b16 %0, %1 offset:%2" : "=&v"(r) : "v"(vb), "i"(OFF) : "memory"); return r; }
template <int D0> __device__ __forceinline__ void pv_one(f32x16& od, int vb, bf16x8 pa0, bf16x8 pa1, bf16x8 pa2, bf16x8 pa3) {
    const s16x4 l0 = tr_read<v_rd_off(D0, 0, 0)>(vb), h0 = tr_read<v_rd_off(D0, 0, 1)>(vb), l1 = tr_read<v_rd_off(D0, 1, 0)>(vb), h1 = tr_read<v_rd_off(D0, 1, 1)>(vb);
    const s16x4 l2 = tr_read<v_rd_off(D0, 2, 0)>(vb), h2 = tr_read<v_rd_off(D0, 2, 1)>(vb), l3 = tr_read<v_rd_off(D0, 3, 0)>(vb), h3 = tr_read<v_rd_off(D0, 3, 1)>(vb);
    asm volatile("s_waitcnt lgkmcnt(0)" ::: "memory"); SBAR();
#define PK(L, H) (bf16x8){L[0], L[1], L[2], L[3], H[0], H[1], H[2], H[3]}
    od = __builtin_amdgcn_mfma_f32_32x32x16_bf16(pa0, PK(l0, h0), od, 0, 0, 0);
    od = __builtin_amdgcn_mfma_f32_32x32x16_bf16(pa1, PK(l1, h1), od, 0, 0, 0);
    od = __builtin_amdgcn_mfma_f32_32x32x16_bf16(pa2, PK(l2, h2), od, 0, 0, 0);
    od = __builtin_amdgcn_mfma_f32_32x32x16_bf16(pa3, PK(l3, h3), od, 0, 0, 0);
#undef PK
}
__device__ __forceinline__ void pv_d0(f32x16* o, int vb, bf16x8 pa0, bf16x8 pa1, bf16x8 pa2, bf16x8 pa3) { pv_one<0>(o[0], vb, pa0, pa1, pa2, pa3); pv_one<1>(o[1], vb, pa0, pa1, pa2, pa3); }

__device__ __forceinline__ void attn_unit(const bf16* __restrict__ Qb, const bf16* __restrict__ Kh, const bf16* __restrict__ KRb, const bf16* __restrict__ Vh, bf16* __restrict__ Ob, int NT, char* lds) {
    const int tid = lv(threadIdx.x), wid = tid >> 6, lane = tid & 63, r32 = lane & 31, hi = lane >> 5;
    char* V_lds = lds; char* K_lds = lds + 2 * SHM_V;
    float* ws = (float*)(lds + 2 * SHM_V + 2 * SHM_K) + wid * 64; float* li_l = ws; float* al_l = ws + 32;
    float m_reg = 0.f, l_reg = 0; f32x16 o[2] = {}; bf16x8 qr[6]; f32x16 negm = {}; f32x16 negbig; _Pragma("unroll") for (int r = 0; r < 16; ++r) negbig[r] = -1e30f;
    const bf16* Qw = Qb + (long)(wid * QBLK + r32) * 96 + hi * 8;
#pragma unroll
    for (int d0 = 0; d0 < 6; ++d0) qr[d0] = *reinterpret_cast<const bf16x8*>(Qw + d0 * 16);
    const int sr = tid >> 4, kc = tid & 15; const bool kact = kc < 12;
    const bf16* ksrc = (kc < 8) ? (Kh + kc * 8) : kact ? (KRb + (kc - 8) * 8) : (Kh + (kc & 7) * 8); const int kstr = (kc >= 8 && kact) ? 32 : 64;
    const int vr = tid >> 3, vc = (tid & 7) * 8; const int vst = v_st(vr, vc);
    const int kw0 = kact ? KSWZ(sr, kc * 16) : (2 * SHM_K + 2048 + tid * 32), kw1 = kact ? KSWZ(32 + sr, kc * 16) : (2 * SHM_K + 2048 + tid * 32 + 16);
    const int vb0 = (int)(uintptr_t)V_lds + v_rd_base(lane);
    struct { bf16x8 vs, ks0, ks1; } sr_[2];
#define SLOAD(i, k0) do { sr_[i].vs = *reinterpret_cast<const bf16x8*>(Vh + (long)((k0) + vr) * 64 + vc); \
    sr_[i].ks0 = *reinterpret_cast<const bf16x8*>(ksrc + (long)((k0) + sr) * kstr); sr_[i].ks1 = *reinterpret_cast<const bf16x8*>(ksrc + (long)((k0) + 32 + sr) * kstr); } while (0)
#define SWRITE(b, i) do { *(bf16x8*)(V_lds + (b) * SHM_V + vst) = sr_[i].vs; \
    *(bf16x8*)(K_lds + (b) * SHM_K + kw0) = sr_[i].ks0; *(bf16x8*)(K_lds + (b) * SHM_K + kw1) = sr_[i].ks1; } while (0)
#define SWAIT() asm volatile("s_waitcnt vmcnt(3)" ::: "memory")
#define RESC(a) do { if (__any((a) < 1.f)) { if (hi == 0) al_l[r32] = (a); asm volatile("s_waitcnt lgkmcnt(0)" ::: "memory"); \
    _Pragma("unroll") for (int d = 0; d < 2; ++d) _Pragma("unroll") for (int r = 0; r < 16; ++r) o[d][r] *= al_l[crow(r, hi)]; } } while (0)
#define MASKED(t) ((t) - (NT - 4) > wq)
#define CIN(t) (MASKED(t) ? negbig : negm)
    f32x16 pA0, pA1, pB0, pB1; float alA, alB; bf16x8 pa0, pa1, pa2, pa3; const int wq = __builtin_amdgcn_readfirstlane(wid >> 1);
    sr_[0].ks0 = bf16x8{}; sr_[0].ks1 = bf16x8{}; sr_[1].ks0 = bf16x8{}; sr_[1].ks1 = bf16x8{};
    SLOAD(0, 0); asm volatile("s_waitcnt vmcnt(0)" ::: "memory"); SWRITE(0, 0); __syncthreads();
    qkt(pA0, pA1, K_lds, qr, r32, hi, negm); partialSM(pA0, pA1, m_reg, negm, alA);
    SLOAD(1, KVBLK); SLOAD(0, 2 * KVBLK);
    SWAIT(); SWRITE(1, 1); __syncthreads();
#define BODY(j, CINB, CINA) do { \
        SBAR(); qkt(pB0, pB1, K_lds + SHM_K, qr, r32, hi, CINB); \
        finishSM(pA0, pA1, alA, l_reg, pa0, pa1, pa2, pa3); SBAR(); \
        SLOAD(1, ((j) + 2) * KVBLK); SBAR(); \
        pv_d0(o, vb0, pa0, pa1, pa2, pa3); partialSM(pB0, pB1, m_reg, negm, alB); \
        __syncthreads(); SWAIT(); SWRITE(0, 0); \
        RESC(alB); __syncthreads(); \
        SBAR(); qkt(pA0, pA1, K_lds, qr, r32, hi, CINA); \
        finishSM(pB0, pB1, alB, l_reg, pa0, pa1, pa2, pa3); SBAR(); \
        SLOAD(0, (((j) + 3 < NT) ? (j) + 3 : NT - 1) * KVBLK); SBAR(); \
        pv_d0(o, vb0 + SHM_V, pa0, pa1, pa2, pa3); partialSM(pA0, pA1, m_reg, negm, alA); \
        __syncthreads(); SWAIT(); SWRITE(1, 1); \
        RESC(alA); __syncthreads(); } while (0)
    int j = 1;
    for (; j + 5 < NT; j += 2) BODY(j, negm, negm);
    for (; j + 1 < NT; j += 2) BODY(j, CIN(j), CIN(j + 1));
#undef BODY
    SBAR(); qkt(pB0, pB1, K_lds + SHM_K, qr, r32, hi, CIN(NT - 1));
    finishSM(pA0, pA1, alA, l_reg, pa0, pa1, pa2, pa3); SBAR();
    pv_d0(o, vb0, pa0, pa1, pa2, pa3); partialSM(pB0, pB1, m_reg, negm, alB);
    __syncthreads(); RESC(alB);
    finishSM(pB0, pB1, alB, l_reg, pa0, pa1, pa2, pa3); SBAR();
    pv_d0(o, vb0 + SHM_V, pa0, pa1, pa2, pa3);
    if (hi == 0) li_l[r32] = l_reg; asm volatile("s_waitcnt lgkmcnt(0)" ::: "memory");
    float rli[16];
#pragma unroll
    for (int r = 0; r < 16; ++r) rli[r] = __builtin_amdgcn_rcpf(li_l[crow(r, hi)]);
    bf16* Ow = Ob + (long)(wid * QBLK) * 1024;
#pragma unroll
    for (int r = 0; r < 16; ++r) { const int orow = crow(r, hi);
#pragma unroll
        for (int d0 = 0; d0 < 2; ++d0) Ow[(long)orow * 1024 + d0 * 32 + r32] = (bf16)f2bf(o[d0][r] * rli[r]); }
    asm volatile("s_waitcnt vmcnt(0)" ::: "memory");
    __syncthreads();
#undef SLOAD
#undef SWRITE
#undef SWAIT
#undef RESC
#undef MASKED
#undef CIN
}
#undef KSWZ
#undef SBAR
}

__device__ __forceinline__ void attn_phase(KArgs a, unsigned char* lds, int G_) { const int G = lsi(G_);
    const int bx = lsi(blockIdx.x); const int vcu = (G % 8 == 0) ? (bx % 8) * (G / 8) + bx / 8 : bx;
    const bf16* QB = (const bf16*)(a->ws + WS_QB); const bf16* KB = (const bf16*)(a->ws + WS_KB); const bf16* VB = (const bf16*)(a->ws + WS_VB);
    const bf16* KR = (const bf16*)(a->ws + WS_KR); bf16* OB = (bf16*)(a->ws + WS_OB);
    for (int p = vcu; p < 1024; p += G) { const int bh = p >> 3, s = p & 7, b = bh >> 4, h = bh & 15;
        for (int half = 0; half < 2; ++half) { const int qb = half ? 15 - s : s;
            att::attn_unit(QB + ((size_t)bh * SEQ + qb * 256) * 96, KB + (size_t)bh * SEQ * 64, KR + (size_t)b * SEQ * 32, VB + (size_t)bh * SEQ * 64,
                           OB + ((size_t)b * SEQ + qb * 256) * 1024 + h * 64, 4 * (qb + 1), (char*)lds); } }
}

#define LAS __attribute__((address_space(3)))
#define XB_TMO      128
#define XB_XCNT(j)  (256  + 64 * (j))
#define XB_XSUB(j)  (1280 + 64 * (j))
#define XB_XGEN(j)  (2304 + 64 * (j))
#define XB_TOP      3328
#define XB_TOPGEN   3392
#define XCD_BAR_WORDS 3456
#define XB_SPIN_CAP (1u << 18)

__device__ __forceinline__ unsigned xb_ld(unsigned* p)              { return __hip_atomic_load(p, __ATOMIC_RELAXED, __HIP_MEMORY_SCOPE_AGENT); }
__device__ __forceinline__ unsigned xb_add(unsigned* p, unsigned v) { return __hip_atomic_fetch_add(p, v, __ATOMIC_RELAXED, __HIP_MEMORY_SCOPE_AGENT); }
__device__ __forceinline__ unsigned xb_xcc_id() { return (unsigned)__builtin_amdgcn_s_getreg((3 << 11) | 20) & 0xFu; }
#define XB_SPIN(cond, bar) do { unsigned _sp = 0; while (cond) { __builtin_amdgcn_s_sleep(1); \
    if ((++_sp & 255u) == 0u) { if (xb_ld(&(bar)[XB_TMO])) break; if (_sp > XB_SPIN_CAP) { atomicAdd(&(bar)[XB_TMO], 1u); break; } } } } while (0)

struct XcdBarrier {
    unsigned* bar; unsigned x;
    volatile LAS unsigned* st;
};

__device__ __forceinline__ XcdBarrier xcd_barrier_post(unsigned* bar, volatile LAS unsigned* st) {
    XcdBarrier b; b.bar = bar; b.x = xb_xcc_id(); b.st = st;
    if (threadIdx.x == 0) (void)xb_add(&bar[XB_XCNT(b.x)], 1u);
    return b;
}
__device__ __forceinline__ void xcd_barrier_complete(unsigned* bar, unsigned x, unsigned& nloc, unsigned& nx) {
    const unsigned G = gridDim.x * gridDim.y * gridDim.z;
    unsigned sum, cnt, mine, sp = 0u;
    for (;;) {
        sum = 0u; cnt = 0u; mine = 0u;
#pragma unroll
        for (unsigned j = 0; j < 16; ++j) { const unsigned c = xb_ld(&bar[XB_XCNT(j)]); sum += c; cnt += (c > 0u) ? 1u : 0u; mine = (j == x) ? c : mine; }
        if (sum == G) break;
        __builtin_amdgcn_s_sleep(1);
        if ((++sp & 255u) == 0u) { if (xb_ld(&bar[XB_TMO])) break; if (sp > XB_SPIN_CAP) { atomicAdd(&bar[XB_TMO], 1u); break; } }
    }
    nloc = mine > 0u ? mine : 1u; nx = cnt > 0u ? cnt : 1u;
}

__device__ __forceinline__ void xcd_barrier(const XcdBarrier& b) {
    asm volatile("s_waitcnt vmcnt(0)" ::: "memory");
    __syncthreads();
    if (threadIdx.x == 0) {
        unsigned* bar = b.bar;
        __builtin_amdgcn_s_waitcnt(0);
        unsigned nloc = b.st[0], nx = b.st[1];
        if (nloc == 0u) { xcd_barrier_complete(bar, b.x, nloc, nx); b.st[0] = nloc; b.st[1] = nx; }
        const unsigned old = xb_add(&bar[XB_XSUB(b.x)], 1u);
        const unsigned gen = old / nloc;
        if (old + 1u == (gen + 1u) * nloc) {
            __builtin_amdgcn_fence(__ATOMIC_RELEASE, "agent");
            asm volatile("s_waitcnt vmcnt(0)" ::: "memory");
            const unsigned og = xb_add(&bar[XB_TOP], 1u);
            const unsigned tg = og / nx;
            if (og + 1u == (tg + 1u) * nx) xb_add(&bar[XB_TOPGEN], 1u);
            else XB_SPIN(xb_ld(&bar[XB_TOPGEN]) == tg, bar);
            __builtin_amdgcn_fence(__ATOMIC_ACQUIRE, "agent");
            xb_add(&bar[XB_XGEN(b.x)], 1u);
            asm volatile("s_waitcnt vmcnt(0)" ::: "memory");
        } else {
            XB_SPIN(xb_ld(&bar[XB_XGEN(b.x)]) == gen, bar);
            __builtin_amdgcn_fence(__ATOMIC_ACQUIRE, "agent");
            asm volatile("s_waitcnt vmcnt(0)" ::: "memory");
        }
    }
    __syncthreads();
}

__global__ void __launch_bounds__(512, 2) yoco_fwd(Args a_unused) {
    extern __shared__ __attribute__((aligned(16))) unsigned char lds[];
    cg::grid_group grid = cg::this_grid();
    KArgs a0 = kargs();
    volatile LAS unsigned* MISC = (volatile LAS unsigned*)((LAS unsigned char*)lds + 131072 + 320);
    if (threadIdx.x < 32) MISC[threadIdx.x] = 0u;
    __syncthreads();
    XcdBarrier xbar = xcd_barrier_post((unsigned*)(a0->ws) + 4096, MISC + 8);
    const int G = gridDim.x, lo = a0->ph_lo, hi = a0->ph_hi;
    PG8_LAS unsigned char* ldsl = (PG8_LAS unsigned char*)lds;
#define WSL() KArgs a = kargs(); unsigned char* ws = a->ws; float* xo = a->out; const float* ada = (const float*)(ws + WS_ADA) + (size_t)l * 8 * 6144; const float* xin = (l == 0) ? a->in[0] : xo; (void)ada; (void)xin; (void)xo; const int Gl = lsi(G), bxl = lsi((int)blockIdx.x); (void)Gl; (void)bxl
#ifndef REP_ATT
#define REP_ATT 1
#endif
#ifndef REP_UP
#define REP_UP 1
#endif
#ifndef REP_NORM
#define REP_NORM 1
#endif
#ifndef REP_SYNC
#define REP_SYNC 1
#endif
#ifndef REP_S5
#define REP_S5 1
#endif
#ifndef REP_PROJ
#define REP_PROJ 1
#endif
#ifndef REP_RES
#define REP_RES 1
#endif
#ifndef REP_KL
#define REP_KL 0
#endif
#ifndef REP_P0
#define REP_P0 1
#endif
#define IN(k) (lo <= (k) && (k) < hi)
#define SEAM(k) do { if (IN(k) && IN((k) + 1)) for (int rep_ = 0; rep_ < REP_SYNC; ++rep_) { if (a0->coop == 2) grid.sync(); xcd_barrier(xbar); } } while (0)
    if (IN(0)) for (int rep = 0; rep < REP_P0; ++rep) { phase0(kargs(), lds, G); __syncthreads(); }
    SEAM(0);
    for (int l = 0; l < 4; ++l) {
        const int pb = 1 + 8 * l;
        if (l < 2) {
            if (IN(pb + 0)) for (int rep = 0; rep < REP_NORM; ++rep) { WSL(); s5_norm_phase(a, l, xin, lds, G); }
            SEAM(pb + 0);
            if (IN(pb + 1)) for (int rep = 0; rep < REP_S5; ++rep) { WSL(); pg8::Gemm g{(const bf16*)(ws + WS_AUG), (const bf16*)(ws + WS_S5WE) + (size_t)l * 64 * 256 * 256, 64 * 2048, 256, 256, AUGK, 256};
                GroupOrder S{Gl, bxl}; EpiE E{(float*)(ws + WS_EBUF)};
                pg8::gemm_phase<EpiE, GroupOrder, true, true>(ldsl, g, S, E); }
            if (IN(pb + 1)) { asm volatile("s_waitcnt vmcnt(0)" ::: "memory"); __syncthreads(); carry_phase(kargs(), l, G); asm volatile("s_waitcnt vmcnt(0)" ::: "memory"); __syncthreads(); }
            if (IN(pb + 1)) for (int rep = 0; rep < REP_S5; ++rep) { WSL(); pg8::Gemm g{(const bf16*)(ws + WS_AUG), (const bf16*)(ws + WS_S5WT) + (size_t)l * 64 * 256 * AUGK, 64 * 2048, 256, AUGK, AUGK, AUGK};
                GroupOrder S{Gl, bxl}; EpiY E{(bf16*)(ws + WS_XN)};
                pg8::gemm_phase<EpiY, GroupOrder, true, true>(ldsl, g, S, E); }
            SEAM(pb + 3);
            if (IN(pb + 4)) for (int rep = 0; rep < REP_RES; ++rep) { WSL(); pg8::Gemm g{(const bf16*)(ws + WS_XN), (const bf16*)(ws + WS_WGLU) + (size_t)l * 1024 * 1024, T, 1024, 1024, 1024, 1024};
                pg8::StaticOrder S; S.init(T, 1024, Gl, bxl); EpiGlu E{(const bf16*)(ws + WS_XN), a->in[19] + l * 1024, rep ? (const float*)(ws + 262144) : ada + 2048, rep ? xo : xin, xo};
                pg8::gemm_phase<EpiGlu, pg8::StaticOrder, true, true>(ldsl, g, S, E); }
            SEAM(pb + 4);
        } else {
            const int j = l - 2;
            if (IN(pb + 0)) for (int rep = 0; rep < REP_NORM; ++rep) { WSL(); const float* kva = (const float*)(ws + WS_KVADA);
                norm_phase(xo, a->in[5] + l * 1024, ada, ada + 1024, 6144, (bf16*)(ws + WS_XN), a->in[22], kva, kva + 1024, 2048, (j == 0) ? (bf16*)(ws + WS_XK) : nullptr, G); }
            SEAM(pb + 0);
            if (IN(pb + 1)) { WSL();
                { pg8::Gemm g{(const bf16*)(ws + WS_XN), (const bf16*)(ws + WS_WDQ) + (size_t)j * 256 * 1024, T, 256, 1024, 1024, 1024};
                  pg8::StaticOrder S; S.init(T, 256, Gl, bxl); EpiDq E{(bf16*)(ws + WS_QA), (float*)(ws + WS_QSS) + (size_t)j * T};
                  pg8::gemm_phase<EpiDq, pg8::StaticOrder, true, true>(ldsl, g, S, E); }
                if (j == 0) { pg8::Gemm g{(const bf16*)(ws + WS_XK), (const bf16*)(ws + WS_WKVA), T, 512, 1024, 1024, 1024};
                  pg8::StaticOrder S; S.init(T, 512, Gl, bxl); EpiKva E{(bf16*)(ws + WS_CKV), (float*)(ws + WS_KSS), (bf16*)(ws + WS_KR), a->in[27], (const float*)(ws + WS_COS), (const float*)(ws + WS_SIN)};
                  pg8::gemm_phase<EpiKva, pg8::StaticOrder, true, true>(ldsl, g, S, E); }
            }
            SEAM(pb + 1);
            if (IN(pb + 2)) for (int rep = 0; rep < REP_PROJ; ++rep) { WSL();
                { pg8::Gemm g{(const bf16*)(ws + WS_QA), (const bf16*)(ws + WS_WUQ) + (size_t)j * 1536 * 256, T, 1536, 256, 256, 256};
                  pg8::StaticOrder S; S.init(T, 1536, Gl, bxl);
                  EpiUq E{(const float*)(ws + WS_QSS) + (size_t)j * T, a->in[31] + j * 64, a->in[32] + j * 32, (const float*)(ws + WS_COS), (const float*)(ws + WS_SIN), (bf16*)(ws + WS_QB)};
                  pg8::gemm_phase<EpiUq, pg8::StaticOrder, true, true>(ldsl, g, S, E); }
                if (j == 0) { pg8::Gemm g{(const bf16*)(ws + WS_CKV), (const bf16*)(ws + WS_WKVB), T, 2048, 256, 256, 256};
                  pg8::StaticOrder S; S.init(T, 2048, Gl, bxl); EpiKvb E{(const float*)(ws + WS_KSS), a->in[26], (bf16*)(ws + WS_KB), (bf16*)(ws + WS_VB)};
                  pg8::gemm_phase<EpiKvb, pg8::StaticOrder, true, true>(ldsl, g, S, E); }
            }
            SEAM(pb + 2);
            if (IN(pb + 3)) for (int rep = 0; rep < REP_ATT; ++rep) attn_phase(kargs(), lds, G);
            SEAM(pb + 3);
            if (IN(pb + 4)) for (int rep = 0; rep < REP_RES; ++rep) { WSL(); pg8::Gemm g{(const bf16*)(ws + WS_OB), (const bf16*)(ws + WS_WO) + (size_t)j * 1024 * 1024, T, 1024, 1024, 1024, 1024};
                pg8::StaticOrder S; S.init(T, 1024, Gl, bxl); EpiRes E{rep ? (const float*)(ws + 262144) : ada + 2048, xo};
                pg8::gemm_phase<EpiRes, pg8::StaticOrder, true, true>(ldsl, g, S, E); }
            SEAM(pb + 4);
        }
        if (IN(pb + 5)) for (int rep = 0; rep < REP_NORM; ++rep) { WSL(); norm_phase(xo, a->in[6] + l * 1024, ada + 3072, ada + 4096, 6144, (bf16*)(ws + WS_XN), nullptr, nullptr, nullptr, 0, nullptr, G); }
        SEAM(pb + 5);
        if (IN(pb + 6)) for (int rep = 0; rep < REP_UP; ++rep) { WSL(); pg8::Gemm g{(const bf16*)(ws + WS_XN), (const bf16*)(ws + WS_WGU) + (size_t)l * 5632 * 1024, T, 5632, 1024, 1024, 1024};
            pg8::StaticOrder S; S.init(T, 5632, Gl, bxl); EpiGU E{(bf16*)(ws + WS_HB)};
            pg8::gemm_phase<EpiGU, pg8::StaticOrder, true, true>(ldsl, g, S, E); }
        SEAM(pb + 6);
        if (IN(pb + 7)) for (int rep = 0; rep < REP_RES; ++rep) { WSL(); pg8::Gemm g{(const bf16*)(ws + WS_HB), (const bf16*)(ws + WS_WD) + (size_t)l * 1024 * FF, T, 1024, FF, FF, FF};
            pg8::StaticOrder S; S.init(T, 1024, Gl, bxl); EpiRes E{rep ? (const float*)(ws + 262144) : ada + 5120, xo};
            pg8::gemm_phase<EpiRes, pg8::StaticOrder, true, true>(ldsl, g, S, E); }
        if (IN(pb + 7)) for (int rep = 0; rep < REP_KL; ++rep) { WSL(); pg8::Gemm g{(const bf16*)(ws + WS_HB), (const bf16*)(ws + WS_WD) + (size_t)l * 1024 * FF, T, 1024, FF, FF, FF};
            pg8::StaticOrder S; S.init(T, 1024, Gl, bxl); EpiNone E{(float*)(ws + 262144)};
            pg8::gemm_phase<EpiNone, pg8::StaticOrder, true, true>(ldsl, g, S, E); }
        SEAM(pb + 7);
    }
#undef IN
#undef SEAM
}

#ifndef MK_PER_PHASE
#define MK_PER_PHASE 0
#endif
extern "C" void kernel_launch(void* const* d_in, const int* in_sizes, int n_in, void* d_out, int out_size, void* d_ws, size_t ws_size, hipStream_t stream) {
    static int grid = 0;
    if (grid == 0) {
        if (n_in != 34 || out_size != T * DM || ws_size < WS_END) { fprintf(stderr, "kernel_launch: unexpected shapes (n_in %d out %d ws %zu)\n", n_in, out_size, ws_size); grid = -1; return; }
        int dev = 0, cus = 0, per_cu = 0;
        if (hipGetDevice(&dev) != hipSuccess || hipDeviceGetAttribute(&cus, hipDeviceAttributeMultiprocessorCount, dev) != hipSuccess) { grid = -1; return; }
        if (hipFuncSetAttribute((const void*)yoco_fwd, hipFuncAttributeMaxDynamicSharedMemorySize, LDS_BYTES) != hipSuccess) { fprintf(stderr, "kernel_launch: hipFuncSetAttribute failed\n"); grid = -1; return; }
        if (hipOccupancyMaxActiveBlocksPerMultiprocessor(&per_cu, (const void*)yoco_fwd, 512, LDS_BYTES) != hipSuccess || per_cu < 1) per_cu = 1;
        (void)hipGetLastError();
        grid = cus * per_cu;
    }
    if (grid < 0) return;
    Args ha{};
    for (int i = 0; i < 34; ++i) ha.in[i] = (const float*)d_in[i];
    ha.out = (float*)d_out; ha.ws = (unsigned char*)d_ws;
#if MK_PER_PHASE
    for (int ph = 0; ph < NPHASE; ++ph) { ha.ph_lo = ph; ha.ph_hi = ph + 1; ha.coop = 0;
        hipLaunchKernelGGL(yoco_fwd, dim3(grid), dim3(512), LDS_BYTES, stream, ha); }
#else
    (void)hipMemsetAsync(d_ws, 0, 524288, stream);
    ha.ph_lo = 0; ha.ph_hi = NPHASE; ha.coop = 1;
    void* args[] = {&ha};
    const hipError_t e = hipLaunchCooperativeKernel((const void*)yoco_fwd, dim3(grid), dim3(512), args, LDS_BYTES, stream);
    if (e != hipSuccess) fprintf(stderr, "kernel_launch: cooperative launch failed: %s (grid %d)\n", hipGetErrorString(e), grid);
#endif
}
```

```cpp
#include <hip/hip_runtime.h>
#include <hip/hip_cooperative_groups.h>
#include <cstdio>
#include <cstdint>
namespace cg = cooperative_groups;
namespace pg8 {
#define PG8_LAS __attribute__((address_space(3)))
typedef unsigned short bf16_t;
typedef short bf16x8 __attribute__((ext_vector_type(8)));
typedef float f32x4 __attribute__((ext_vector_type(4)));
typedef unsigned u32x4 __attribute__((ext_vector_type(4)));
constexpr int BM = 256, BK = 64, HALF = 128, HTB = HALF * BK * 2  , STAGE_BYTES = 8 * HTB, NXCD = 8, WGM = 8;

__host__ __device__ __forceinline__ int lds_byte(int r, int c) { const int st = (r >> 4) * 2 + (c >> 5), rr = r & 15, cc = c & 31, ob = rr * 64 + cc * 2; return st * 1024 + (ob ^ (((ob >> 9) & 1) << 5)); }
__host__ __device__ __forceinline__ void stage_rc(int b, int& R, int& C) { const int st = b / 1024, sb = b % 1024, swz = sb ^ (((sb >> 9) & 1) << 5); R = (st >> 1) * 16 + swz / 64; C = (st & 1) * 32 + (swz % 64) / 2; }
__host__ __device__ __forceinline__ int perm32(int rho) { const int n = rho >> 4, i = rho & 15; return 8 * (i >> 2) + 4 * n + (i & 3); }

struct Unit { int pm, pn; };
struct Gemm { const bf16_t* A; const bf16_t* Bt; int M, N, K, lda, ldb; };

struct StaticOrder {
    int nM, nN, nwg, G, c;
    __host__ __device__ void init(int M, int N, int G_, int c_) { nM = M / BM; nN = N / BM; nwg = nM * nN; G = G_; c = c_; }
    __host__ __device__ bool next(int i, Unit& u) const {
        const long L = (long)i * G + c; if (L >= nwg) return false;
        int wgid = (int)L; { const int q = nwg / NXCD, r = nwg % NXCD, xcd = wgid % NXCD, off = wgid / NXCD; wgid = (xcd < r ? xcd * (q + 1) : r * (q + 1) + (xcd - r) * q) + off; }
        const int nig = WGM * nN, gid = wgid / nig, fm = gid * WGM, gsz = (nM - fm) < WGM ? (nM - fm) : WGM;
        u.pm = fm + ((wgid % nig) % gsz); u.pn = (wgid % nig) / gsz; return true;
    }
    __device__ __forceinline__ void a_ready(const Unit&) const {}
    __device__ __forceinline__ void done(const Unit&) const {}
};

__device__ __forceinline__ unsigned cvt_pk_bf16(float lo, float hi) { unsigned r; asm volatile("v_cvt_pk_bf16_f32 %0, %1, %2" : "=v"(r) : "v"(lo), "v"(hi)); return r; }
typedef float f32x2 __attribute__((ext_vector_type(2)));
template <class Epi, class Sched, bool ALIGN_EPI = false, bool SP2 = false>
__device__ __forceinline__ void gemm_phase(PG8_LAS unsigned char* lds, const Gemm g, const Sched& S, const Epi& E) {
    int tid_l = threadIdx.x; asm volatile("" : "+v"(tid_l)); const int tid = tid_l, wid = __builtin_amdgcn_readfirstlane(tid >> 6), lane = tid & 63, wr = wid >> 2, wc = wid & 3, fr = lane & 15, fq = lane >> 4;
    int K_l = g.K; asm volatile("" : "+s"(K_l)); const int K = K_l, nt = K / BK;
    unsigned voffA[2], voffB[2];
#pragma unroll
    for (int i = 0; i < 2; ++i) { int R, C; stage_rc(tid * 16 + i * 8192, R, C); const int Rb = Epi::PERM ? ((R & ~31) + perm32(R & 31)) : R;
        voffA[i] = (unsigned)(R * g.lda + C) * 2u; voffB[i] = (unsigned)(Rb * g.ldb + C) * 2u; }
    const size_t kstep = (size_t)(BK * 2);
    const size_t hstepA = (size_t)HALF * g.lda * 2, hstepB = (size_t)HALF * g.ldb * 2;
    const size_t tstepA = 2 * hstepA, tstepB = 2 * hstepB;
    const unsigned ldsw = (unsigned)wid * 1024u;
    const int aoff = lds_byte(wr * 64 + fr, fq * 8), boff = lds_byte(wc * 32 + fr, fq * 8);
#define PG8_SA(b, h) (((b) * 2 + (h)) * HTB)
#define PG8_SB(b, h) ((4 + (b) * 2 + (h)) * HTB)
#define PG8_STAGE(bufoff, gbase, voff) do { _Pragma("unroll") for (int _i = 0; _i < 2; ++_i) \
        __builtin_amdgcn_global_load_lds((const unsigned*)((const char*)(gbase) + (voff)[_i]), (PG8_LAS unsigned*)(lds + (bufoff) + ldsw + _i * 8192), 16, 0, 0); } while (0)
#define PG8_LDA(dst, b, h) do { _Pragma("unroll") for (int m = 0; m < 4; ++m) _Pragma("unroll") for (int k = 0; k < 2; ++k) dst[m][k] = *(const PG8_LAS bf16x8*)(lds + PG8_SA(b, h) + aoff + m * 2048 + k * 1024); } while (0)
#define PG8_LDB(dst, b, h) do { _Pragma("unroll") for (int n = 0; n < 2; ++n) _Pragma("unroll") for (int k = 0; k < 2; ++k) dst[n][k] = *(const PG8_LAS bf16x8*)(lds + PG8_SB(b, h) + boff + n * 2048 + k * 1024); } while (0)
#define PG8_MMA(ai, bj, At, Bt) do { __builtin_amdgcn_s_setprio(1); _Pragma("unroll") for (int m = 0; m < 4; ++m) _Pragma("unroll") for (int n = 0; n < 2; ++n) _Pragma("unroll") for (int k = 0; k < 2; ++k) \
        acc[ai][bj][m][n] = __builtin_amdgcn_mfma_f32_16x16x32_bf16(Bt[n][k], At[m][k], acc[ai][bj][m][n], 0, 0, 0); __builtin_amdgcn_s_setprio(0); } while (0)
#define PG8_WAIT_V(n) asm volatile("s_waitcnt vmcnt(" #n ")" ::: "memory")
#define PG8_WAIT_L(n) asm volatile("s_waitcnt lgkmcnt(" #n ")" ::: "memory")
#define PG8_BAR __builtin_amdgcn_s_barrier()
#define PG8_SCHED __builtin_amdgcn_sched_barrier(0)
    Unit cur, nxt; int ui = 0;
    if (!S.next(0, cur)) return;
    f32x4 acc[2][2][4][2];
#pragma unroll
    for (int a = 0; a < 2; ++a)
#pragma unroll
        for (int b = 0; b < 2; ++b)
#pragma unroll
            for (int m = 0; m < 4; ++m)
#pragma unroll
                for (int n = 0; n < 2; ++n) acc[a][b][m][n] = (f32x4){0.f, 0.f, 0.f, 0.f};
    bf16x8 At[4][2], B0[2][2], B1[2][2];
    const char* cA = (const char*)g.A + (size_t)cur.pm * tstepA; const char* cB = (const char*)g.Bt + (size_t)cur.pn * tstepB;
    S.a_ready(cur);
    if constexpr (SP2) {
        PG8_STAGE(PG8_SB(0, 0), cB, voffB); PG8_STAGE(PG8_SB(0, 1), cB + hstepB, voffB); PG8_STAGE(PG8_SA(0, 0), cA, voffA); PG8_STAGE(PG8_SA(0, 1), cA + hstepA, voffA);
        if (wr == 1) PG8_BAR;
        PG8_WAIT_V(2); PG8_BAR;
        PG8_STAGE(PG8_SB(1, 0), cB + kstep, voffB); PG8_STAGE(PG8_SA(1, 0), cA + kstep, voffA); PG8_STAGE(PG8_SB(1, 1), cB + hstepB + kstep, voffB);
        PG8_WAIT_V(6); PG8_BAR;
    } else {
        PG8_STAGE(PG8_SB(0, 0), cB, voffB); PG8_STAGE(PG8_SA(0, 0), cA, voffA); PG8_STAGE(PG8_SB(0, 1), cB + hstepB, voffB); PG8_STAGE(PG8_SA(0, 1), cA + hstepA, voffA);
        if (wr == 1) PG8_BAR;
        PG8_WAIT_V(4); PG8_BAR;
        PG8_STAGE(PG8_SB(1, 0), cB + kstep, voffB); PG8_STAGE(PG8_SA(1, 0), cA + kstep, voffA); PG8_STAGE(PG8_SB(1, 1), cB + hstepB + kstep, voffB);
        PG8_WAIT_V(6); PG8_BAR;
    }
    for (;;) {
        const bool has_next = S.next(ui + 1, nxt);
        const char* nA = has_next ? (const char*)g.A + (size_t)nxt.pm * tstepA : cA; const char* nB = has_next ? (const char*)g.Bt + (size_t)nxt.pn * tstepB : cB;
        for (int t = 0; t < nt; t += 2) {
            const bool last = (t == nt - 2);
            const char* a1 = cA + (size_t)(t + 1) * kstep;
            const char* a2 = last ? nA : cA + (size_t)(t + 2) * kstep; const char* b2 = last ? nB : cB + (size_t)(t + 2) * kstep;
            const char* a3 = a2 + kstep; const char* b3 = b2 + kstep;
            if (last && has_next) S.a_ready(nxt);
            if constexpr (SP2) {
            PG8_LDB(B0, 0, 0); PG8_LDB(B1, 0, 1); PG8_SCHED; PG8_LDA(At, 0, 0); PG8_STAGE(PG8_SA(1, 1), a1 + hstepA, voffA);
            PG8_WAIT_V(8); PG8_WAIT_L(0); PG8_BAR; PG8_MMA(0, 0, At, B0); PG8_MMA(0, 1, At, B1); PG8_BAR; PG8_SCHED;
            PG8_LDA(At, 0, 1); PG8_STAGE(PG8_SB(0, 0), b2, voffB); PG8_STAGE(PG8_SB(0, 1), b2 + hstepB, voffB); PG8_STAGE(PG8_SA(0, 0), a2, voffA);
            PG8_WAIT_V(8); PG8_WAIT_L(0); PG8_BAR; PG8_MMA(1, 0, At, B0); PG8_MMA(1, 1, At, B1); PG8_BAR; PG8_SCHED;
            PG8_LDB(B0, 1, 0); PG8_LDB(B1, 1, 1); PG8_SCHED; PG8_LDA(At, 1, 0); PG8_STAGE(PG8_SA(0, 1), a2 + hstepA, voffA);
            PG8_WAIT_V(8); PG8_WAIT_L(0); PG8_BAR; PG8_MMA(0, 0, At, B0); PG8_MMA(0, 1, At, B1); PG8_BAR; PG8_SCHED;
            PG8_LDA(At, 1, 1); PG8_STAGE(PG8_SB(1, 0), b3, voffB); PG8_STAGE(PG8_SB(1, 1), b3 + hstepB, voffB); PG8_STAGE(PG8_SA(1, 0), a3, voffA);
            PG8_WAIT_V(8); PG8_WAIT_L(0); PG8_BAR; PG8_MMA(1, 0, At, B0); PG8_MMA(1, 1, At, B1); PG8_BAR; PG8_SCHED;
            } else {
            PG8_LDB(B0, 0, 0); PG8_SCHED; PG8_LDA(At, 0, 0); PG8_STAGE(PG8_SA(1, 1), a1 + hstepA, voffA);
            PG8_WAIT_L(8); PG8_BAR; PG8_WAIT_L(0); PG8_MMA(0, 0, At, B0); PG8_BAR; PG8_SCHED;
            PG8_LDB(B1, 0, 1); PG8_STAGE(PG8_SB(0, 0), b2, voffB);
            PG8_BAR; PG8_WAIT_L(0); PG8_MMA(0, 1, At, B1); PG8_BAR;
            PG8_LDA(At, 0, 1); PG8_STAGE(PG8_SA(0, 0), a2, voffA);
            PG8_BAR; PG8_WAIT_L(0); PG8_MMA(1, 0, At, B0); PG8_BAR; PG8_SCHED;
            PG8_STAGE(PG8_SB(0, 1), b2 + hstepB, voffB);
            PG8_WAIT_V(6); PG8_BAR; PG8_MMA(1, 1, At, B1); PG8_BAR;
            PG8_LDB(B0, 1, 0); PG8_SCHED; PG8_LDA(At, 1, 0); PG8_STAGE(PG8_SA(0, 1), a2 + hstepA, voffA);
            PG8_WAIT_L(8); PG8_BAR; PG8_WAIT_L(0); PG8_MMA(0, 0, At, B0); PG8_BAR; PG8_SCHED;
            PG8_LDB(B1, 1, 1); PG8_STAGE(PG8_SB(1, 0), b3, voffB);
            PG8_BAR; PG8_WAIT_L(0); PG8_MMA(0, 1, At, B1); PG8_BAR;
            PG8_LDA(At, 1, 1); PG8_STAGE(PG8_SA(1, 0), a3, voffA);
            PG8_BAR; PG8_WAIT_L(0); PG8_MMA(1, 0, At, B0); PG8_BAR; PG8_SCHED;
            PG8_STAGE(PG8_SB(1, 1), b3 + hstepB, voffB);
            PG8_WAIT_V(6); PG8_BAR; PG8_MMA(1, 1, At, B1); PG8_BAR;
            }
        }
        if constexpr (ALIGN_EPI) { if (wr == 0) PG8_BAR; }
        if constexpr (!Epi::AFTER_DRAIN) { E(acc, cur, wr, wc, fr, fq); S.done(cur); }
        if (!has_next) break;
#pragma unroll
        for (int a = 0; a < 2; ++a)
#pragma unroll
            for (int b = 0; b < 2; ++b)
#pragma unroll
                for (int m = 0; m < 4; ++m)
#pragma unroll
                    for (int n = 0; n < 2; ++n) acc[a][b][m][n] = (f32x4){0.f, 0.f, 0.f, 0.f};
        cur = nxt; cA = nA; cB = nB; ++ui;
        if constexpr (ALIGN_EPI) { if (wr == 1) PG8_BAR; }
    }
    PG8_WAIT_V(0);
    if constexpr (!ALIGN_EPI) { if (wr == 0) PG8_BAR; }
    PG8_BAR;
    if constexpr (Epi::AFTER_DRAIN) { E.fused(acc, cur, wr, wc, fr, fq, lds, wid, lane); S.done(cur); }
#undef PG8_SA
#undef PG8_SB
#undef PG8_STAGE
#undef PG8_LDA
#undef PG8_LDB
#undef PG8_MMA
#undef PG8_WAIT_V
#undef PG8_WAIT_L
#undef PG8_BAR
#undef PG8_SCHED
}
}

constexpr int NB = 8, SEQ = 4096, DM = 1024, T = NB * SEQ, FF = 2816, NH = 16;
constexpr int SUB = 16, NSUB = SEQ / SUB, AUGK = 384;
constexpr float EPS = 1e-6f;
constexpr size_t MiB = 1u << 20;
constexpr size_t WS_ADA = 1 * MiB;
constexpr size_t WS_KVADA = WS_ADA + 800 * 1024;
constexpr size_t WS_COS = 2 * MiB, WS_SIN = 4 * MiB;
constexpr size_t WS_QSS = 6 * MiB;
constexpr size_t WS_KSS = WS_QSS + 2 * T * 4, WS_A16 = WS_KSS + T * 4;
constexpr size_t WS_KR = 7 * MiB;
constexpr size_t WS_WGU = 10 * MiB;
constexpr size_t WS_WD = WS_WGU + 44 * MiB;
constexpr size_t WS_WGLU = WS_WD + 22 * MiB;
constexpr size_t WS_WDQ = WS_WGLU + 4 * MiB;
constexpr size_t WS_WKVA = WS_WDQ + 1 * MiB;
constexpr size_t WS_WUQ = WS_WKVA + 1 * MiB;
constexpr size_t WS_WKVB = WS_WUQ + 3 * MiB / 2;
constexpr size_t WS_WO = WS_WKVB + 1 * MiB;
constexpr size_t WS_S5WT = 89 * MiB;
constexpr size_t WS_S5WE = WS_S5WT + 24 * MiB;
constexpr size_t WS_CKV = WS_S5WT, WS_QA = WS_S5WT + 16 * MiB;
constexpr size_t WS_XN = 129 * MiB;
constexpr size_t WS_HB = 193 * MiB;
constexpr size_t WS_AUG = WS_HB, WS_EBUF = WS_HB + 96 * MiB;
constexpr size_t WS_QB = WS_HB, WS_XK = WS_HB + 96 * MiB, WS_OB = WS_XK;
constexpr size_t WS_KB = 369 * MiB, WS_VB = 433 * MiB, WS_END = 497 * MiB;
static_assert(WS_WO + 4 * MiB <= WS_S5WT && WS_S5WE + 16 * MiB <= WS_XN, "ws map");

constexpr int LDS_BYTES = 147456;
constexpr int NPHASE = 33;

typedef unsigned short bf16;
typedef unsigned v4u __attribute__((ext_vector_type(4)));
typedef unsigned v2u __attribute__((ext_vector_type(2)));
typedef float f32x4 __attribute__((ext_vector_type(4)));
typedef float f32x2 __attribute__((ext_vector_type(2)));

__device__ __forceinline__ unsigned f2bf(float f) { unsigned u = __builtin_bit_cast(unsigned, f); return (u + 0x7fffu + ((u >> 16) & 1u)) >> 16; }
typedef __bf16 bf16x2_hw __attribute__((ext_vector_type(2)));
__device__ __forceinline__ unsigned pk2(float lo, float hi) { const f32x2 v = {lo, hi}; return __builtin_bit_cast(unsigned, __builtin_convertvector(v, bf16x2_hw)); }
__device__ __forceinline__ float bflo(unsigned w) { return __builtin_bit_cast(float, w << 16); }
__device__ __forceinline__ float bfhi(unsigned w) { return __builtin_bit_cast(float, w & 0xffff0000u); }
__device__ __forceinline__ float shx(float v, int lane, int o) { return __builtin_bit_cast(float, __builtin_amdgcn_ds_bpermute((lane ^ o) << 2, __builtin_bit_cast(int, v))); }
__device__ __forceinline__ float wave_sum(float v, int lane) {
#pragma unroll
    for (int o = 1; o < 64; o <<= 1) v += shx(v, lane, o);
    return v;
}
__device__ __forceinline__ float sigm(float z) { return __builtin_amdgcn_rcpf(1.f + __expf(-z)); }
__device__ __forceinline__ float gelu_tanh(float x) { const float u = 0.7978845608028654f * (x + 0.044715f * x * x * x); return x * __builtin_amdgcn_rcpf(1.f + __expf(-2.f * u)); }
__device__ __forceinline__ f32x2 cmul(f32x2 a, f32x2 b) { return (f32x2){a.x * b.x - a.y * b.y, a.x * b.y + a.y * b.x}; }
__device__ __forceinline__ void dsincos(double x, double& s, double& c) {
    const double q = __builtin_rint(x * 0.63661977236758134308);
    double r = __builtin_fma(-q, 1.57079632679489655800, x); r = __builtin_fma(-q, 6.12323399573676603587e-17, r);
    const double r2 = r * r;
    double sp = 1.0 / 6227020800.0; sp = -1.0 / 39916800.0 + r2 * sp; sp = 1.0 / 362880.0 + r2 * sp; sp = -1.0 / 5040.0 + r2 * sp; sp = 1.0 / 120.0 + r2 * sp; sp = -1.0 / 6.0 + r2 * sp;
    const double s0 = r + r * r2 * sp;
    double cp = 1.0 / 479001600.0; cp = -1.0 / 3628800.0 + r2 * cp; cp = 1.0 / 40320.0 + r2 * cp; cp = -1.0 / 720.0 + r2 * cp; cp = 1.0 / 24.0 + r2 * cp; cp = -0.5 + r2 * cp;
    const double c0 = 1.0 + r2 * cp;
    const int n = ((int)q) & 3;
    s = (n == 0) ? s0 : (n == 1) ? c0 : (n == 2) ? -s0 : -c0;
    c = (n == 0) ? c0 : (n == 1) ? -s0 : (n == 2) ? -c0 : s0;
}

__device__ __forceinline__ int lv(int v) { asm volatile("" : "+v"(v)); return v; }
__device__ __forceinline__ int lsi(int v) { asm volatile("" : "+s"(v)); return v; }
template <class TP> __device__ __forceinline__ TP* ls(TP* p) { asm volatile("" : "+s"(p)); return p; }
struct Args { const float* in[34]; float* out; unsigned char* ws; int ph_lo, ph_hi, coop, pad; };
typedef const __attribute__((address_space(4))) Args* KArgs;
__device__ __forceinline__ KArgs kargs() { KArgs p = (KArgs)__builtin_amdgcn_kernarg_segment_ptr(); asm volatile("" : "+s"(p)); return p; }

__device__ __forceinline__ void tr_item(const float* W, int ldw, int k0, int n0, bf16* dst, int ldd, const float* kscale, float* scr, int lane) {
#pragma unroll 8
    for (int i = 0; i < 32; ++i) { const int kk = 2 * i + (lane >> 5); float v = W[(size_t)(k0 + kk) * ldw + n0 + (lane & 31)]; if (kscale) v *= kscale[k0 + kk]; scr[kk * 33 + (lane & 31)] = v; }
    const int c = lane & 7;
#pragma unroll
    for (int j = 0; j < 4; ++j) { const int n = (lane >> 3) + 8 * j; const float* s = scr + (8 * c) * 33 + n;
        v4u o; o.x = pk2(s[0 * 33], s[1 * 33]); o.y = pk2(s[2 * 33], s[3 * 33]); o.z = pk2(s[4 * 33], s[5 * 33]); o.w = pk2(s[6 * 33], s[7 * 33]);
        *(v4u*)(dst + (size_t)n * ldd + k0 + 8 * c) = o; }
}

__device__ __forceinline__ void ada_item(KArgs a, int it, float* cact, float* part, int tid) {
    const int lane = tid & 63, wave = tid >> 6;
    const int col0 = it * 128;
    const float* W; const float* bias; float* out; int ldw;
    if (col0 < 4 * 6144) { const int l = col0 / 6144, cc = col0 - l * 6144; W = a->in[3] + (size_t)l * 1024 * 6144 + cc; ldw = 6144; bias = a->in[4] + l * 6144 + cc; out = (float*)(a->ws + WS_ADA) + (size_t)l * 8 * 6144 + cc; }
    else { const int cc = col0 - 4 * 6144; W = a->in[20] + cc; ldw = 2048; bias = a->in[21] + cc; out = (float*)(a->ws + WS_KVADA) + cc; }
    float acc[8][2];
#pragma unroll
    for (int b = 0; b < 8; ++b) { acc[b][0] = 0.f; acc[b][1] = 0.f; }
    const float* wp = W + (size_t)(wave * 128) * ldw + 2 * lane;
    const float* cp = cact + wave * 128 * 8;
#pragma unroll 8
    for (int k = 0; k < 128; ++k) {
        const f32x2 w2 = *(const f32x2*)(wp + (size_t)k * ldw);
        const f32x4 c0 = *(const f32x4*)(cp + k * 8), c1 = *(const f32x4*)(cp + k * 8 + 4);
        acc[0][0] += c0.x * w2.x; acc[0][1] += c0.x * w2.y; acc[1][0] += c0.y * w2.x; acc[1][1] += c0.y * w2.y;
        acc[2][0] += c0.z * w2.x; acc[2][1] += c0.z * w2.y; acc[3][0] += c0.w * w2.x; acc[3][1] += c0.w * w2.y;
        acc[4][0] += c1.x * w2.x; acc[4][1] += c1.x * w2.y; acc[5][0] += c1.y * w2.x; acc[5][1] += c1.y * w2.y;
        acc[6][0] += c1.z * w2.x; acc[6][1] += c1.z * w2.y; acc[7][0] += c1.w * w2.x; acc[7][1] += c1.w * w2.y;
    }
#pragma unroll
    for (int b = 0; b < 8; ++b) *(f32x2*)(part + (wave * 8 + b) * 128 + 2 * lane) = (f32x2){acc[b][0], acc[b][1]};
    __syncthreads();
    for (int o = tid; o < 1024; o += 512) { const int b = o >> 7, col = o & 127; float s = bias[col];
#pragma unroll
        for (int w = 0; w < 8; ++w) s += part[(w * 8 + b) * 128 + col];
        out[(size_t)b * ldw + col] = s; }
    __syncthreads();
}

__device__ __forceinline__ void s5prep_item(KArgs a, int l, int g, unsigned char* sm, int tid) {
    f32x2* apw = (f32x2*)sm;
    f32x2* bbv = (f32x2*)(sm + 8704);
    f32x2* ccv = (f32x2*)(sm + 16896);
    float* Kt = (float*)(sm + 25088);
    f32x2* fv = (f32x2*)(sm + 41472);
    const int lg = l * 64 + g;
    const float* lam_re = a->in[10] + lg * 64; const float* lam_im = a->in[11] + lg * 64;
    const float* b_re = a->in[13] + (size_t)lg * 64 * 16; const float* b_im = a->in[14] + (size_t)lg * 64 * 16;
    const float* c_re = a->in[15] + (size_t)lg * 16 * 64; const float* c_im = a->in[16] + (size_t)lg * 16 * 64;
    const float* dsk = a->in[17] + l * 1024 + g * 16;
    if (tid < 64) {
        const int n = tid; const double dt = exp((double)a->in[12][lg]); const double lr = lam_re[n], li = lam_im[n];
        const double mag = exp(lr * dt); double s, c; dsincos(li * dt, s, c); const double ar = mag * c, ai = mag * s;
        double pr = 1.0, pi = 0.0;
        for (int k = 0; k <= 16; ++k) { apw[k * 64 + n] = (f32x2){(float)pr, (float)pi}; const double tr = pr * ar - pi * ai, ti = pr * ai + pi * ar; pr = tr; pi = ti; }
        ((f32x2*)(a->ws + WS_A16))[lg * 64 + n] = apw[16 * 64 + n];
        const double den = lr * lr + li * li, nr = ar - 1.0, ni = ai;
        fv[n] = (f32x2){(float)((nr * lr + ni * li) / den), (float)((ni * lr - nr * li) / den)};
    }
    __syncthreads();
    for (int i = tid; i < 1024; i += 512) { const int n = i >> 4; bbv[i] = cmul(fv[n], (f32x2){b_re[i], b_im[i]}); ccv[i] = (f32x2){c_re[i], c_im[i]}; }
    __syncthreads();
    { const int lag = tid >> 5, p = (tid >> 1) & 15, qh = tid & 1; float acc[8];
#pragma unroll
        for (int q = 0; q < 8; ++q) acc[q] = 0.f;
        for (int n = 0; n < 64; ++n) { const f32x2 w = cmul(ccv[p * 64 + n], apw[lag * 64 + n]);
#pragma unroll
            for (int q = 0; q < 8; ++q) { const f32x2 bq = bbv[n * 16 + qh * 8 + q]; acc[q] += w.x * bq.x - w.y * bq.y; } }
#pragma unroll
        for (int q = 0; q < 8; ++q) Kt[(lag * 16 + p) * 16 + qh * 8 + q] = acc[q]; }
    __syncthreads();
    bf16* WT = (bf16*)(a->ws + WS_S5WT) + (size_t)lg * 256 * AUGK;
    for (int ch = tid; ch < 256 * 48; ch += 512) { const int row = ch / 48, cc = ch - row * 48, t = row >> 4, p = row & 15; float v[8];
        if (cc < 32) { const int s = cc >> 1, qh = cc & 1;
#pragma unroll
            for (int q = 0; q < 8; ++q) { float x = (s <= t) ? Kt[((t - s) * 16 + p) * 16 + qh * 8 + q] : 0.f; if (s == t && qh * 8 + q == p) x += dsk[p]; v[q] = x; } }
        else { const int n0 = (cc - 32) * 4;
#pragma unroll
            for (int k = 0; k < 4; ++k) { const f32x2 w = cmul(ccv[p * 64 + n0 + k], apw[(t + 1) * 64 + n0 + k]); v[2 * k] = w.x; v[2 * k + 1] = -w.y; } }
        v4u o; o.x = pk2(v[0], v[1]); o.y = pk2(v[2], v[3]); o.z = pk2(v[4], v[5]); o.w = pk2(v[6], v[7]);
        *(v4u*)(WT + (size_t)row * AUGK + cc * 8) = o; }
    bf16* WE = (bf16*)(a->ws + WS_S5WE) + (size_t)lg * 256 * 256;
    for (int ch = tid; ch < 256 * 32; ch += 512) { const int row = ch >> 5, cc = ch & 31, s = cc >> 1, qh = cc & 1; float v[8];
        if (row < 128) { const int n = row >> 1, im = row & 1; const f32x2 ap = apw[(15 - s) * 64 + n];
#pragma unroll
            for (int q = 0; q < 8; ++q) { const f32x2 pr = cmul(ap, bbv[n * 16 + qh * 8 + q]); v[q] = im ? pr.y : pr.x; } }
        else {
#pragma unroll
            for (int q = 0; q < 8; ++q) v[q] = 0.f; }
        v4u o; o.x = pk2(v[0], v[1]); o.y = pk2(v[2], v[3]); o.z = pk2(v[4], v[5]); o.w = pk2(v[6], v[7]);
        *(v4u*)(WE + (size_t)row * 256 + cc * 8) = o; }
    __syncthreads();
}

__device__ __forceinline__ void phase0(KArgs a, unsigned char* lds, int G_) { const int G = lsi(G_);
    const int tid = lv(threadIdx.x), lane = tid & 63, wave = tid >> 6;
    float* cact = (float*)lds; float* part = (float*)(lds + 32768);
    for (int i = tid; i < 8192; i += 512) { const int b = i >> 10, k = i & 1023; const float v = a->in[1][i]; cact[k * 8 + b] = v / (1.f + __expf(-v)); }
    __syncthreads();
    for (int it = lsi(blockIdx.x); it < 208 + 128; it += G) {
        if (it < 208) ada_item(a, it, cact, part, tid);
        else { const int r = it - 208; s5prep_item(a, r >> 6, r & 63, lds + 65536, tid); }
    }
    __syncthreads();
    float* scr = (float*)(lds + wave * 16384);
    const int gw = lsi(blockIdx.x) * 8 + wave, NGW = G * 8;
    unsigned char* ws = a->ws;
    constexpr int I_GU = 16 * 88, I_D = 44 * 32, I_SQ = 16 * 32, I_DQ = 16 * 8, I_KVA = 16 * 9, I_UQ = 4 * 48, I_KVB = 4 * 64;
    constexpr int NTR = 8 * I_GU + 4 * I_D + 2 * I_SQ + 2 * I_DQ + I_KVA + 2 * I_UQ + I_KVB + 2 * I_SQ;
    for (int it = gw; it < NTR; it += NGW) {
        int r = it;
        if (r < 8 * I_GU) { const int up = r >= 4 * I_GU; if (up) r -= 4 * I_GU; const int l = r / I_GU; r -= l * I_GU; const int kb = r / 88, n0 = (r % 88) * 32;
            tr_item(a->in[up ? 8 : 7] + (size_t)l * 1024 * FF, FF, kb * 64, n0, (bf16*)(ws + WS_WGU) + ((size_t)l * 5632 + (n0 >> 7) * 256 + up * 128 + (n0 & 127)) * 1024, 1024, nullptr, scr, lane); continue; }
        r -= 8 * I_GU;
        if (r < 4 * I_D) { const int l = r / I_D; r -= l * I_D; const int kb = r / 32, n0 = (r % 32) * 32;
            tr_item(a->in[9] + (size_t)l * FF * 1024, 1024, kb * 64, n0, (bf16*)(ws + WS_WD) + ((size_t)l * 1024 + n0) * FF, FF, nullptr, scr, lane); continue; }
        r -= 4 * I_D;
        if (r < 2 * I_SQ) { const int l = r / I_SQ; r -= l * I_SQ; const int kb = r / 32, n0 = (r % 32) * 32;
            tr_item(a->in[18] + (size_t)l * 1024 * 1024, 1024, kb * 64, n0, (bf16*)(ws + WS_WGLU) + ((size_t)l * 1024 + n0) * 1024, 1024, nullptr, scr, lane); continue; }
        r -= 2 * I_SQ;
        if (r < 2 * I_DQ) { const int l = r / I_DQ; r -= l * I_DQ; const int kb = r / 8, n0 = (r % 8) * 32;
            tr_item(a->in[28] + (size_t)l * 1024 * 256, 256, kb * 64, n0, (bf16*)(ws + WS_WDQ) + ((size_t)l * 256 + n0) * 1024, 1024, nullptr, scr, lane); continue; }
        r -= 2 * I_DQ;
        if (r < I_KVA) { const int kb = r / 9, n0 = (r % 9) * 32;
            tr_item(a->in[23], 288, kb * 64, n0, (bf16*)(ws + WS_WKVA) + (size_t)n0 * 1024, 1024, nullptr, scr, lane); continue; }
        r -= I_KVA;
        if (r < 2 * I_UQ) { const int l = r / I_UQ; r -= l * I_UQ; const int kb = r / 48, n0 = (r % 48) * 32; const int hh = n0 / 96, db = (n0 - hh * 96) >> 5;
            const int drow = (db < 2) ? (256 * (hh >> 2) + 128 * db + 32 * (hh & 3)) : (1024 + 256 * (hh >> 3) + 128 * ((hh & 7) >> 2) + 32 * (hh & 3));
            tr_item(a->in[30] + (size_t)l * 256 * 1536, 1536, kb * 64, n0, (bf16*)(ws + WS_WUQ) + ((size_t)l * 1536 + drow) * 256, 256, a->in[29] + l * 256, scr, lane); continue; }
        r -= 2 * I_UQ;
        if (r < I_KVB) { const int kb = r / 64, n0 = (r % 64) * 32; const int hh = n0 >> 7, db = (n0 & 127) >> 5;
            const int drow = (db < 2) ? (256 * (hh >> 2) + 128 * db + 32 * (hh & 3)) : (1024 + hh * 64 + (db - 2) * 32);
            tr_item(a->in[25], 2048, kb * 64, n0, (bf16*)(ws + WS_WKVB) + (size_t)drow * 256, 256, a->in[24], scr, lane); continue; }
        r -= I_KVB;
        { const int l = r / I_SQ; r -= l * I_SQ; const int kb = r / 32, n0 = (r % 32) * 32;
            tr_item(a->in[33] + (size_t)l * 1024 * 1024, 1024, kb * 64, n0, (bf16*)(ws + WS_WO) + ((size_t)l * 1024 + n0) * 1024, 1024, nullptr, scr, lane); }
    }
    const int gt = lsi(blockIdx.x) * 512 + tid, NT_ = G * 512;
    const int* pos = (const int*)a->in[2];
    for (int idx = gt; idx < T * 16; idx += NT_) { const int row = idx >> 4, i = idx & 15;
        const double b4 = (i & 3) == 0 ? 1.0 : (i & 3) == 1 ? 0.56234132519034908 : (i & 3) == 2 ? 0.31622776601683794 : 0.17782794100389228;
        const double p10 = (i >> 2) == 0 ? 1.0 : (i >> 2) == 1 ? 0.1 : (i >> 2) == 2 ? 0.01 : 0.001;
        double s, c; dsincos((double)pos[row] * (b4 * p10), s, c);
        ((float*)(ws + WS_COS))[idx] = (float)c; ((float*)(ws + WS_SIN))[idx] = (float)s; }
    for (int idx = gt; idx < 3 * T; idx += NT_) ((float*)(ws + WS_QSS))[idx] = 0.f;
    for (int idx = gt; idx < 224 * 1024 / 2; idx += NT_) ((unsigned*)((bf16*)(ws + WS_WKVA) + 288 * 1024))[idx] = 0u;
}

__device__ __forceinline__ void s5_norm_phase(KArgs a, int l, const float* xin, unsigned char* lds, int G_) { const int G = lsi(G_);
    const int tid = lv(threadIdx.x), lane = tid & 63, wave = tid >> 6;
    bf16* stage = (bf16*)lds;
    const float* ng = a->in[5] + l * 1024;
    bf16* AUG = (bf16*)(a->ws + WS_AUG);
    for (int it = lsi(blockIdx.x); it < NB * NSUB; it += G) {
        const int b = it >> 8, c = it & 255;
        const float* ada = (const float*)(a->ws + WS_ADA) + ((size_t)l * 8 + b) * 6144;
        f32x4 mul[4], add[4];
#pragma unroll
        for (int j = 0; j < 4; ++j) { const int ch = 4 * lane + 256 * j; const f32x4 gg = *(const f32x4*)(ng + ch), sc = *(const f32x4*)(ada + 1024 + ch); mul[j] = gg * (sc + 1.0f); add[j] = *(const f32x4*)(ada + ch); }
#pragma unroll
        for (int tt = 0; tt < 2; ++tt) { const int tok = 2 * wave + tt; const float* xr = xin + ((size_t)b * SEQ + c * 16 + tok) * 1024;
            f32x4 v[4]; float ss = 0.f;
#pragma unroll
            for (int j = 0; j < 4; ++j) { v[j] = *(const f32x4*)(xr + 4 * lane + 256 * j); ss += (v[j].x * v[j].x + v[j].y * v[j].y) + (v[j].z * v[j].z + v[j].w * v[j].w); }
            const float rstd = rsqrtf(wave_sum(ss, lane) * (1.f / 1024.f) + EPS);
#pragma unroll
            for (int j = 0; j < 4; ++j) { const f32x4 h = v[j] * rstd * mul[j] + add[j]; *(v2u*)(stage + tok * 1024 + 4 * lane + 256 * j) = (v2u){pk2(h.x, h.y), pk2(h.z, h.w)}; } }
        __syncthreads();
        { const int g = tid >> 3, part = tid & 7; bf16* dst = AUG + ((size_t)g * 2048 + b * 256 + c) * AUGK;
#pragma unroll
            for (int k = 0; k < 4; ++k) { const int chunk = part * 4 + k, s = chunk >> 1, qh = chunk & 1; *(v4u*)(dst + chunk * 8) = *(const v4u*)(stage + s * 1024 + g * 16 + qh * 8); } }
        __syncthreads();
    }
}
__device__ __forceinline__ void norm_phase(const float* x, const float* g1, const float* sh1, const float* sc1, int bstride1, bf16* out1,
                                           const float* g2, const float* sh2, const float* sc2, int bstride2, bf16* out2, int G_) { const int G = lsi(G_);
    const int tid = lv(threadIdx.x), lane = tid & 63, wave = tid >> 6;
    for (int rb = lsi(blockIdx.x) * 8 + wave; rb < T / 16; rb += G * 8) {
        const int b = rb >> 8;
        f32x4 mul[4], add[4], mul2[4], add2[4];
#pragma unroll
        for (int j = 0; j < 4; ++j) { const int ch = 4 * lane + 256 * j; mul[j] = *(const f32x4*)(g1 + ch) * (*(const f32x4*)(sc1 + (size_t)b * bstride1 + ch) + 1.0f); add[j] = *(const f32x4*)(sh1 + (size_t)b * bstride1 + ch);
            if (out2) { mul2[j] = *(const f32x4*)(g2 + ch) * (*(const f32x4*)(sc2 + (size_t)b * bstride2 + ch) + 1.0f); add2[j] = *(const f32x4*)(sh2 + (size_t)b * bstride2 + ch); } }
        for (int r4 = 0; r4 < 16; r4 += 4) {
            f32x4 v[4][4]; float ss[4];
#pragma unroll
            for (int q = 0; q < 4; ++q) { const float* xr = x + ((size_t)rb * 16 + r4 + q) * 1024; ss[q] = 0.f;
#pragma unroll
                for (int j = 0; j < 4; ++j) v[q][j] = *(const f32x4*)(xr + 4 * lane + 256 * j); }
#pragma unroll
            for (int q = 0; q < 4; ++q)
#pragma unroll
                for (int j = 0; j < 4; ++j) ss[q] += (v[q][j].x * v[q][j].x + v[q][j].y * v[q][j].y) + (v[q][j].z * v[q][j].z + v[q][j].w * v[q][j].w);
#pragma unroll
            for (int o = 1; o < 64; o <<= 1) {
                const float t0 = shx(ss[0], lane, o), t1 = shx(ss[1], lane, o), t2 = shx(ss[2], lane, o), t3 = shx(ss[3], lane, o);
                ss[0] += t0; ss[1] += t1; ss[2] += t2; ss[3] += t3; }
#pragma unroll
            for (int q = 0; q < 4; ++q) { const size_t row = (size_t)rb * 16 + r4 + q; const float rstd = rsqrtf(ss[q] * (1.f / 1024.f) + EPS);
#pragma unroll
                for (int j = 0; j < 4; ++j) { const f32x4 h = v[q][j] * rstd * mul[j] + add[j]; *(v2u*)(out1 + row * 1024 + 4 * lane + 256 * j) = (v2u){pk2(h.x, h.y), pk2(h.z, h.w)}; }
                if (out2) {
#pragma unroll
                    for (int j = 0; j < 4; ++j) { const f32x4 h = v[q][j] * rstd * mul2[j] + add2[j]; *(v2u*)(out2 + row * 1024 + 4 * lane + 256 * j) = (v2u){pk2(h.x, h.y), pk2(h.z, h.w)}; } } }
        }
    }
}
__device__ __forceinline__ void carry_phase(KArgs a, int l, int G_) { const int G = lsi(G_);
    const int tid = lv(threadIdx.x), lane = tid & 63, wave = tid >> 6;
    const float* EB = (const float*)(a->ws + WS_EBUF); bf16* AUG = (bf16*)(a->ws + WS_AUG);
    const int nn = lane >> 4, j = lane & 15;
    for (int L = lsi(blockIdx.x); L < 512; L += G)
    for (int nq = wave; nq < 16; nq += 8) {
        const int b = L & 7, g = L >> 3, n = nq * 4 + nn;
        const f32x2 a16 = ((const f32x2*)(a->ws + WS_A16))[(l * 64 + g) * 64 + n];
        const f32x4* ep = (const f32x4*)(EB + ((((size_t)(g * 8 + b) * 64 + n) * 256) + j * 16) * 2);
        f32x4 e[8];
#pragma unroll
        for (int i = 0; i < 8; ++i) e[i] = ep[i];
        f32x2 t = {0.f, 0.f};
#pragma unroll
        for (int i = 0; i < 8; ++i) { t = cmul(a16, t) + (f32x2){e[i].x, e[i].y}; t = cmul(a16, t) + (f32x2){e[i].z, e[i].w}; }
        f32x2 Ad = a16;
#pragma unroll
        for (int k = 0; k < 4; ++k) Ad = cmul(Ad, Ad);
#pragma unroll
        for (int d = 1; d < 16; d <<= 1) { const int sl = ((j >= d) ? lane - d : lane) << 2; const float tx_ = t.x, ty_ = t.y; const float orr = __builtin_bit_cast(float, __builtin_amdgcn_ds_bpermute(sl, __builtin_bit_cast(int, tx_))), oi = __builtin_bit_cast(float, __builtin_amdgcn_ds_bpermute(sl, __builtin_bit_cast(int, ty_)));
            if (j >= d) { t.x += Ad.x * orr - Ad.y * oi; t.y += Ad.x * oi + Ad.y * orr; }
            Ad = cmul(Ad, Ad); }
        f32x2 cur; { const int sl = ((j >= 1) ? lane - 1 : lane) << 2; const float tx_ = t.x, ty_ = t.y; cur.x = __builtin_bit_cast(float, __builtin_amdgcn_ds_bpermute(sl, __builtin_bit_cast(int, tx_))); cur.y = __builtin_bit_cast(float, __builtin_amdgcn_ds_bpermute(sl, __builtin_bit_cast(int, ty_))); } if (j == 0) cur = (f32x2){0.f, 0.f};
        bf16* op = AUG + ((size_t)g * 2048 + b * 256 + j * 16) * AUGK + 256 + 2 * n;
#pragma unroll
        for (int i = 0; i < 8; ++i) {
            *(unsigned*)(op + (size_t)(2 * i) * AUGK) = pk2(cur.x, cur.y); cur = cmul(a16, cur) + (f32x2){e[i].x, e[i].y};
            *(unsigned*)(op + (size_t)(2 * i + 1) * AUGK) = pk2(cur.x, cur.y); cur = cmul(a16, cur) + (f32x2){e[i].z, e[i].w}; }
    }
}

using pg8::Unit;
typedef const f32x4 (&AccRef)[2][2][4][2];
struct GroupOrder {
    int G, c;
    __device__ __forceinline__ bool next(int i, Unit& u) const { const int L = i * G + c; if (L >= 512) return false; u.pm = L; u.pn = L >> 3; return true; }
    __device__ __forceinline__ void a_ready(const Unit&) const {}
    __device__ __forceinline__ void done(const Unit&) const {}
};
struct EpiE { static constexpr bool PERM = false, AFTER_DRAIN = false; float* E;
    __device__ __forceinline__ void operator()(AccRef acc, const Unit& u, int wr, int wc, int fr, int fq) const { fr = lv(fr); fq = lv(fq);
        float* base = E + (size_t)((u.pn * 8 + (u.pm & 7)) * 64) * 512;
#pragma unroll
        for (int ai = 0; ai < 2; ++ai)
#pragma unroll
            for (int m = 0; m < 4; ++m) { const int c = ai * 128 + wr * 64 + m * 16 + fr;
#pragma unroll
                for (int n = 0; n < 2; ++n) { const int ns = 16 * wc + 8 * n + 2 * fq; const f32x4 v = acc[ai][0][m][n];
                    *(f32x2*)(base + ((size_t)ns * 256 + c) * 2) = (f32x2){v.x, v.y}; *(f32x2*)(base + ((size_t)(ns + 1) * 256 + c) * 2) = (f32x2){v.z, v.w}; } }
    }
};
struct EpiY { static constexpr bool PERM = true, AFTER_DRAIN = false; bf16* Gd;
    __device__ __forceinline__ void operator()(AccRef acc, const Unit& u, int wr, int wc, int fr, int fq) const { fr = lv(fr); fq = lv(fq);
        const int g = u.pn, b = u.pm & 7;
#pragma unroll
        for (int bj = 0; bj < 2; ++bj) { const int tc0 = 128 * bj + 32 * wc + 8 * fq, t = tc0 >> 4, p0 = tc0 & 15;
#pragma unroll
            for (int ai = 0; ai < 2; ++ai)
#pragma unroll
                for (int m = 0; m < 4; ++m) { const int r = ai * 128 + wr * 64 + m * 16 + fr; const size_t tok = (size_t)b * SEQ + r * 16 + t;
                    const f32x4 v0 = acc[ai][bj][m][0], v1 = acc[ai][bj][m][1];
                    v4u w; w.x = pk2(gelu_tanh(v0.x), gelu_tanh(v0.y)); w.y = pk2(gelu_tanh(v0.z), gelu_tanh(v0.w)); w.z = pk2(gelu_tanh(v1.x), gelu_tanh(v1.y)); w.w = pk2(gelu_tanh(v1.z), gelu_tanh(v1.w));
                    *(v4u*)(Gd + tok * 1024 + g * 16 + p0) = w; } }
    }
};
struct EpiGlu { static constexpr bool PERM = false, AFTER_DRAIN = false; const bf16* Gd; const float* bglu; const float* gate; const float* xin; float* xout;
    __device__ __forceinline__ void operator()(AccRef acc, const Unit& u, int wr, int wc, int fr, int fq) const { fr = lv(fr); fq = lv(fq);
        const int b = u.pm >> 4; f32x4 gt[2][2], bg[2][2];
#pragma unroll
        for (int bj = 0; bj < 2; ++bj)
#pragma unroll
            for (int n = 0; n < 2; ++n) { const int col = u.pn * 256 + 128 * bj + 32 * wc + 16 * n + 4 * fq; bg[bj][n] = *(const f32x4*)(bglu + col); gt[bj][n] = *(const f32x4*)(gate + (size_t)b * 6144 + col); }
#pragma unroll
        for (int ai = 0; ai < 2; ++ai)
#pragma unroll
            for (int mh = 0; mh < 2; ++mh) { f32x4 xv[2][2][2]; v2u gw[2][2][2];
                const size_t o0 = (size_t)(u.pm * 256 + ai * 128 + wr * 64 + mh * 32 + fr) * 1024 + u.pn * 256 + 32 * wc + 4 * fq;
#pragma unroll
                for (int m = 0; m < 2; ++m)
#pragma unroll
                    for (int bj = 0; bj < 2; ++bj)
#pragma unroll
                        for (int n = 0; n < 2; ++n) { const size_t off = o0 + (size_t)m * 16 * 1024 + 128 * bj + 16 * n; xv[m][bj][n] = *(const f32x4*)(xin + off); gw[m][bj][n] = *(const v2u*)(Gd + off); }
                asm volatile("" ::: "memory");
#pragma unroll
                for (int m = 0; m < 2; ++m)
#pragma unroll
                    for (int bj = 0; bj < 2; ++bj)
#pragma unroll
                        for (int n = 0; n < 2; ++n) { const size_t off = o0 + (size_t)m * 16 * 1024 + 128 * bj + 16 * n; const v2u g2 = gw[m][bj][n];
                            const f32x4 gv = {bflo(g2.x), bfhi(g2.x), bflo(g2.y), bfhi(g2.y)};
                            const f32x4 z = acc[ai][bj][2 * mh + m][n] + bg[bj][n]; const f32x4 mix = {gv.x * sigm(z.x), gv.y * sigm(z.y), gv.z * sigm(z.z), gv.w * sigm(z.w)};
                            *(f32x4*)(xout + off) = xv[m][bj][n] + gt[bj][n] * mix; }
                asm volatile("" ::: "memory"); }
    }
};
struct EpiRes { static constexpr bool PERM = false, AFTER_DRAIN = false; const float* gate; float* x;
    __device__ __forceinline__ void operator()(AccRef acc, const Unit& u, int wr, int wc, int fr, int fq) const { fr = lv(fr); fq = lv(fq);
        const int b = u.pm >> 4; f32x4 gt[2][2];
#pragma unroll
        for (int bj = 0; bj < 2; ++bj)
#pragma unroll
            for (int n = 0; n < 2; ++n) gt[bj][n] = *(const f32x4*)(gate + (size_t)b * 6144 + u.pn * 256 + 128 * bj + 32 * wc + 16 * n + 4 * fq);
#pragma unroll
        for (int ai = 0; ai < 2; ++ai) { f32x4 xv[4][2][2];
            float* xb = x + (size_t)(u.pm * 256 + ai * 128 + wr * 64 + fr) * 1024 + u.pn * 256 + 32 * wc + 4 * fq;
#pragma unroll
            for (int m = 0; m < 4; ++m)
#pragma unroll
                for (int bj = 0; bj < 2; ++bj)
#pragma unroll
                    for (int n = 0; n < 2; ++n) xv[m][bj][n] = *(const f32x4*)(xb + (size_t)m * 16 * 1024 + 128 * bj + 16 * n);
            asm volatile("" ::: "memory");
#pragma unroll
            for (int m = 0; m < 4; ++m)
#pragma unroll
                for (int bj = 0; bj < 2; ++bj)
#pragma unroll
                    for (int n = 0; n < 2; ++n) *(f32x4*)(xb + (size_t)m * 16 * 1024 + 128 * bj + 16 * n) = xv[m][bj][n] + gt[bj][n] * acc[ai][bj][m][n];
            asm volatile("" ::: "memory"); }
    }
};
__device__ __forceinline__ float sq4(f32x4 v);
struct EpiNone { static constexpr bool PERM = false, AFTER_DRAIN = false; float* sink;
    __device__ __forceinline__ void operator()(AccRef acc, const Unit& u, int wr, int wc, int fr, int fq) const { if (sink) { float s = 0.f;
#pragma unroll
        for (int ai = 0; ai < 2; ++ai)
#pragma unroll
            for (int bj = 0; bj < 2; ++bj)
#pragma unroll
                for (int m = 0; m < 4; ++m)
#pragma unroll
                    for (int n = 0; n < 2; ++n) s += sq4(acc[ai][bj][m][n]);
        if (s == 123.456f) sink[0] = s; } }
};
__device__ __forceinline__ float sq4(f32x4 v);
__device__ __forceinline__ void silu2(float g1, float g2, float u1, float u2, float& o1, float& o2) {
    const float a = 1.f + fminf(__expf(-g1), 1e18f), b = 1.f + fminf(__expf(-g2), 1e18f);
    const float r = __builtin_amdgcn_rcpf(a * b);
    o1 = g1 * u1 * (r * b); o2 = g2 * u2 * (r * a);
}
struct EpiGU { static constexpr bool PERM = true, AFTER_DRAIN = false; bf16* H;
    __device__ __forceinline__ void operator()(AccRef acc, const Unit& u, int wr, int wc, int fr, int fq) const { fr = lv(fr); fq = lv(fq);
#pragma unroll
        for (int ai = 0; ai < 2; ++ai)
#pragma unroll
            for (int m = 0; m < 4; ++m) { const size_t row = (size_t)(u.pm * 256 + ai * 128 + wr * 64 + m * 16 + fr);
                const f32x4 g0 = acc[ai][0][m][0], g1 = acc[ai][0][m][1], u0 = acc[ai][1][m][0], u1 = acc[ai][1][m][1];
                float h[8];
                silu2(g0.x, g0.y, u0.x, u0.y, h[0], h[1]); silu2(g0.z, g0.w, u0.z, u0.w, h[2], h[3]);
                silu2(g1.x, g1.y, u1.x, u1.y, h[4], h[5]); silu2(g1.z, g1.w, u1.z, u1.w, h[6], h[7]);
                v4u w; w.x = pk2(h[0], h[1]); w.y = pk2(h[2], h[3]); w.z = pk2(h[4], h[5]); w.w = pk2(h[6], h[7]);
                *(v4u*)(H + row * FF + u.pn * 128 + 32 * wc + 8 * fq) = w; }
    }
};
__device__ __forceinline__ float sq4(f32x4 v) { return (v.x * v.x + v.y * v.y) + (v.z * v.z + v.w * v.w); }
__device__ __forceinline__ float quad_sum_(float s, int lane) { s += shx(s, lane, 16); s += shx(s, lane, 32); return s; }
#define quad_sum(s) quad_sum_((s), fr + 16 * fq)
struct EpiDq { static constexpr bool PERM = true, AFTER_DRAIN = false; bf16* QA; float* SS;
    __device__ __forceinline__ void operator()(AccRef acc, const Unit& u, int wr, int wc, int fr, int fq) const { fr = lv(fr); fq = lv(fq);
#pragma unroll
        for (int ai = 0; ai < 2; ++ai)
#pragma unroll
            for (int m = 0; m < 4; ++m) { const size_t row = (size_t)(u.pm * 256 + ai * 128 + wr * 64 + m * 16 + fr); float ss = 0.f;
#pragma unroll
                for (int bj = 0; bj < 2; ++bj) { const f32x4 v0 = acc[ai][bj][m][0], v1 = acc[ai][bj][m][1]; ss += sq4(v0) + sq4(v1);
                    *(v4u*)(QA + row * 256 + 128 * bj + 32 * wc + 8 * fq) = (v4u){pk2(v0.x, v0.y), pk2(v0.z, v0.w), pk2(v1.x, v1.y), pk2(v1.z, v1.w)}; }
                ss = quad_sum(ss); if (fq == 0) atomicAdd(SS + row, ss); }
    }
};
struct EpiKva { static constexpr bool PERM = false, AFTER_DRAIN = false; bf16* CKV; float* SS; bf16* KR; const float* gkr; const float* COS; const float* SIN;
    __device__ __forceinline__ void operator()(AccRef acc, const Unit& u, int wr, int wc, int fr, int fq) const { fr = lv(fr); fq = lv(fq);
        if (u.pn == 0) {
#pragma unroll
            for (int ai = 0; ai < 2; ++ai)
#pragma unroll
                for (int m = 0; m < 4; ++m) { const size_t row = (size_t)(u.pm * 256 + ai * 128 + wr * 64 + m * 16 + fr); float ss = 0.f;
#pragma unroll
                    for (int bj = 0; bj < 2; ++bj)
#pragma unroll
                        for (int n = 0; n < 2; ++n) { const f32x4 v = acc[ai][bj][m][n]; ss += sq4(v); *(v2u*)(CKV + row * 256 + 128 * bj + 32 * wc + 16 * n + 4 * fq) = (v2u){pk2(v.x, v.y), pk2(v.z, v.w)}; }
                    ss = quad_sum(ss); if (fq == 0) atomicAdd(SS + row, ss); }
        } else if (wc == 0) {
            const f32x4 g1 = *(const f32x4*)(gkr + 4 * fq), g2 = *(const f32x4*)(gkr + 16 + 4 * fq);
#pragma unroll
            for (int ai = 0; ai < 2; ++ai) { f32x4 cs[4], sn[4];
#pragma unroll
                for (int m = 0; m < 4; ++m) { const size_t row = (size_t)(u.pm * 256 + ai * 128 + wr * 64 + m * 16 + fr); cs[m] = *(const f32x4*)(COS + row * 16 + 4 * fq); sn[m] = *(const f32x4*)(SIN + row * 16 + 4 * fq); }
                asm volatile("" ::: "memory");
#pragma unroll
                for (int m = 0; m < 4; ++m) { const size_t row = (size_t)(u.pm * 256 + ai * 128 + wr * 64 + m * 16 + fr);
                    const f32x4 x1 = acc[ai][0][m][0], x2 = acc[ai][0][m][1];
                    const float rstd = rsqrtf(quad_sum(sq4(x1) + sq4(x2)) * (1.f / 32.f) + EPS);
                    const f32x4 y1 = x1 * rstd * g1, y2 = x2 * rstd * g2, o1 = y1 * cs[m] - y2 * sn[m], o2 = y1 * sn[m] + y2 * cs[m];
                    *(v2u*)(KR + row * 32 + 4 * fq) = (v2u){pk2(o1.x, o1.y), pk2(o1.z, o1.w)}; *(v2u*)(KR + row * 32 + 16 + 4 * fq) = (v2u){pk2(o2.x, o2.y), pk2(o2.z, o2.w)}; }
                asm volatile("" ::: "memory"); }
        }
    }
};
constexpr float QSC = 0.10206207261596577f * 1.4426950408889634f;
struct EpiUq { static constexpr bool PERM = false, AFTER_DRAIN = false; const float* SS; const float* gn; const float* gr; const float* COS; const float* SIN; bf16* QB;
    __device__ __forceinline__ void operator()(AccRef acc, const Unit& u, int wr, int wc, int fr, int fq) const { fr = lv(fr); fq = lv(fq);
        const int b = u.pm >> 4; float ssv[2][4];
#pragma unroll
        for (int ai = 0; ai < 2; ++ai)
#pragma unroll
            for (int m = 0; m < 4; ++m) ssv[ai][m] = SS[(size_t)(u.pm * 256 + ai * 128 + wr * 64 + m * 16 + fr)];
        if (u.pn < 4) { const int hh = 4 * u.pn + wc; f32x4 g[2][2];
#pragma unroll
            for (int bj = 0; bj < 2; ++bj)
#pragma unroll
                for (int n = 0; n < 2; ++n) g[bj][n] = *(const f32x4*)(gn + 32 * bj + 16 * n + 4 * fq) * QSC;
            asm volatile("" ::: "memory");
#pragma unroll
            for (int ai = 0; ai < 2; ++ai)
#pragma unroll
                for (int m = 0; m < 4; ++m) { const int rowi = u.pm * 256 + ai * 128 + wr * 64 + m * 16 + fr; const int sq_ = rowi & (SEQ - 1);
                    const float rq = rsqrtf(ssv[ai][m] * (1.f / 256.f) + EPS); float ss = 0.f; f32x4 v[2][2];
#pragma unroll
                    for (int bj = 0; bj < 2; ++bj)
#pragma unroll
                        for (int n = 0; n < 2; ++n) { v[bj][n] = acc[ai][bj][m][n] * rq; ss += sq4(v[bj][n]); }
                    const float rh = rsqrtf(quad_sum(ss) * (1.f / 64.f) + EPS);
                    bf16* dst = QB + (((size_t)b * NH + hh) * SEQ + sq_) * 96;
#pragma unroll
                    for (int bj = 0; bj < 2; ++bj)
#pragma unroll
                        for (int n = 0; n < 2; ++n) { const f32x4 o = v[bj][n] * rh * g[bj][n]; *(v2u*)(dst + 32 * bj + 16 * n + 4 * fq) = (v2u){pk2(o.x, o.y), pk2(o.z, o.w)}; } }
        } else {
            const f32x4 g1 = *(const f32x4*)(gr + 4 * fq) * QSC, g2 = *(const f32x4*)(gr + 16 + 4 * fq) * QSC;
#pragma unroll
            for (int ai = 0; ai < 2; ++ai) { f32x4 cs[4], sn[4];
#pragma unroll
                for (int m = 0; m < 4; ++m) { const size_t row = (size_t)(u.pm * 256 + ai * 128 + wr * 64 + m * 16 + fr); cs[m] = *(const f32x4*)(COS + row * 16 + 4 * fq); sn[m] = *(const f32x4*)(SIN + row * 16 + 4 * fq); }
                asm volatile("" ::: "memory");
#pragma unroll
                for (int m = 0; m < 4; ++m) { const int rowi = u.pm * 256 + ai * 128 + wr * 64 + m * 16 + fr; const int sq_ = rowi & (SEQ - 1);
                    const float rq = rsqrtf(ssv[ai][m] * (1.f / 256.f) + EPS);
#pragma unroll
                    for (int bj = 0; bj < 2; ++bj) { const int hh = 8 * (u.pn - 4) + 4 * bj + wc;
                        const f32x4 x1 = acc[ai][bj][m][0] * rq, x2 = acc[ai][bj][m][1] * rq;
                        const float rh = rsqrtf(quad_sum(sq4(x1) + sq4(x2)) * (1.f / 32.f) + EPS);
                        const f32x4 y1 = x1 * rh * g1, y2 = x2 * rh * g2, o1 = y1 * cs[m] - y2 * sn[m], o2 = y1 * sn[m] + y2 * cs[m];
                        bf16* dst = QB + (((size_t)b * NH + hh) * SEQ + sq_) * 96 + 64;
                        *(v2u*)(dst + 4 * fq) = (v2u){pk2(o1.x, o1.y), pk2(o1.z, o1.w)}; *(v2u*)(dst + 16 + 4 * fq) = (v2u){pk2(o2.x, o2.y), pk2(o2.z, o2.w)}; } }
                asm volatile("" ::: "memory"); }
        }
    }
};
struct EpiKvb { static constexpr bool PERM = false, AFTER_DRAIN = false; const float* SS; const float* gk; bf16* KB; bf16* VB;
    __device__ __forceinline__ void operator()(AccRef acc, const Unit& u, int wr, int wc, int fr, int fq) const { fr = lv(fr); fq = lv(fq);
        const int b = u.pm >> 4; float ssv[2][4]; f32x4 g[2][2];
#pragma unroll
        for (int ai = 0; ai < 2; ++ai)
#pragma unroll
            for (int m = 0; m < 4; ++m) ssv[ai][m] = SS[(size_t)(u.pm * 256 + ai * 128 + wr * 64 + m * 16 + fr)];
#pragma unroll
        for (int bj = 0; bj < 2; ++bj)
#pragma unroll
            for (int n = 0; n < 2; ++n) g[bj][n] = *(const f32x4*)(gk + 32 * bj + 16 * n + 4 * fq);
        asm volatile("" ::: "memory");
#pragma unroll
        for (int ai = 0; ai < 2; ++ai)
#pragma unroll
            for (int m = 0; m < 4; ++m) { const int rowi = u.pm * 256 + ai * 128 + wr * 64 + m * 16 + fr; const int sq_ = rowi & (SEQ - 1);
                const float rc = rsqrtf(ssv[ai][m] * (1.f / 256.f) + EPS);
                if (u.pn < 4) { const int hh = 4 * u.pn + wc; float ss = 0.f; f32x4 v[2][2];
#pragma unroll
                    for (int bj = 0; bj < 2; ++bj)
#pragma unroll
                        for (int n = 0; n < 2; ++n) { v[bj][n] = acc[ai][bj][m][n] * rc; ss += sq4(v[bj][n]); }
                    const float rh = rsqrtf(quad_sum(ss) * (1.f / 64.f) + EPS);
                    bf16* dst = KB + (((size_t)b * NH + hh) * SEQ + sq_) * 64;
#pragma unroll
                    for (int bj = 0; bj < 2; ++bj)
#pragma unroll
                        for (int n = 0; n < 2; ++n) { const f32x4 o = v[bj][n] * rh * g[bj][n]; *(v2u*)(dst + 32 * bj + 16 * n + 4 * fq) = (v2u){pk2(o.x, o.y), pk2(o.z, o.w)}; }
                } else {
#pragma unroll
                    for (int bj = 0; bj < 2; ++bj)
#pragma unroll
                        for (int n = 0; n < 2; ++n) { const int col = 256 * (u.pn - 4) + 128 * bj + 32 * wc + 16 * n + 4 * fq, hh = col >> 6, dv = col & 63;
                            const f32x4 o = acc[ai][bj][m][n] * rc; *(v2u*)(VB + (((size_t)b * NH + hh) * SEQ + sq_) * 64 + dv) = (v2u){pk2(o.x, o.y), pk2(o.z, o.w)}; }
                } }
    }
};

namespace att {
using bf16x8 = __attribute__((ext_vector_type(8))) short;
using s16x4 = __attribute__((ext_vector_type(4))) short;
using f32x16 = __attribute__((ext_vector_type(16))) float;
using u32x4 = __attribute__((ext_vector_type(4))) unsigned;
constexpr int QBLK = 32, KVBLK = 64;
constexpr float SCALE = 0.10206207261596577f;
constexpr float THR = 6.f;
constexpr int SHM_V = 64 * 64 * 2, SHM_K = 64 * 256;
#define KSWZ(row, colB) ((row) * 256 + ((colB) ^ (((row) & 7) << 4)))
#define SBAR() __builtin_amdgcn_sched_barrier(0)
__device__ __forceinline__ int crow(int r, int hi) { return (r & 3) + 8 * (r >> 2) + 4 * hi; }
__device__ __forceinline__ unsigned cvtpk(float lo, float hi) { unsigned r; asm volatile("v_cvt_pk_bf16_f32 %0, %1, %2" : "=v"(r) : "v"(lo), "v"(hi)); return r; }
__device__ __forceinline__ void partialSM(f32x16& p0, f32x16& p1, float& m_reg, f32x16& negm, float& alpha) {
    constexpr float THRL = THR * 1.4426950408889634f;
    float pmax = p0[0];
#pragma unroll
    for (int r = 1; r < 16; ++r) pmax = fmaxf(pmax, p0[r]);
#pragma unroll
    for (int r = 0; r < 16; ++r) pmax = fmaxf(pmax, p1[r]);
    { auto rr = __builtin_amdgcn_permlane32_swap(__float_as_uint(pmax), __float_as_uint(pmax), false, false); pmax = fmaxf(__uint_as_float(rr[0]), __uint_as_float(rr[1])); }
    if (__builtin_expect(__all(pmax <= THRL), 1)) { alpha = 1.f; }
    else { const float dl = fmaxf(pmax, 0.f); m_reg += dl; alpha = __builtin_amdgcn_exp2f(-dl);
#pragma unroll
        for (int r = 0; r < 16; ++r) { p0[r] -= dl; p1[r] -= dl; }
#pragma unroll
        for (int r = 0; r < 16; ++r) negm[r] = -m_reg; }
#pragma unroll
    for (int r = 0; r < 16; ++r) p0[r] = __builtin_amdgcn_exp2f(p0[r]);
}
__device__ __forceinline__ void finishSM(f32x16& p0, f32x16& p1, float alpha, float& l_reg, bf16x8& pa0, bf16x8& pa1, bf16x8& pa2, bf16x8& pa3) {
#pragma unroll
    for (int r = 0; r < 16; ++r) p1[r] = __builtin_amdgcn_exp2f(p1[r]);
    float ps = 0;
#pragma unroll
    for (int r = 0; r < 16; ++r) ps += p0[r];
#pragma unroll
    for (int r = 0; r < 16; ++r) ps += p1[r];
    { auto rr = __builtin_amdgcn_permlane32_swap(__float_as_uint(ps), __float_as_uint(ps), false, false); ps = __uint_as_float(rr[0]) + __uint_as_float(rr[1]); }
    l_reg = l_reg * alpha + ps;
#define PK4(P, BASE, OUT) do { unsigned a0 = cvtpk(P[BASE + 0], P[BASE + 1]), a1 = cvtpk(P[BASE + 2], P[BASE + 3]);   \
    unsigned b0 = cvtpk(P[BASE + 4], P[BASE + 5]), b1 = cvtpk(P[BASE + 6], P[BASE + 7]);                              \
    auto r0 = __builtin_amdgcn_permlane32_swap(a0, b0, false, false); auto r1 = __builtin_amdgcn_permlane32_swap(a1, b1, false, false); \
    u32x4 w = {r0[0], r1[0], r0[1], r1[1]}; OUT = *reinterpret_cast<bf16x8*>(&w); } while (0)
    PK4(p0, 0, pa0); PK4(p0, 8, pa1); PK4(p1, 0, pa2); PK4(p1, 8, pa3);
#undef PK4
}
__device__ __forceinline__ void qkt(f32x16& p0, f32x16& p1, const char* Ks, const bf16x8* qr, int r32, int hi, const f32x16& cin) {
    p0 = cin; p1 = cin;
#pragma unroll
    for (int d0 = 0; d0 < 6; ++d0) { const int cb = (d0 * 16 + hi * 8) * 2;
        const bf16x8 b0 = *reinterpret_cast<const bf16x8*>(Ks + KSWZ(r32, cb));
        const bf16x8 b1 = *reinterpret_cast<const bf16x8*>(Ks + KSWZ(32 + r32, cb));
        p0 = __builtin_amdgcn_mfma_f32_32x32x16_bf16(b0, qr[d0], p0, 0, 0, 0);
        p1 = __builtin_amdgcn_mfma_f32_32x32x16_bf16(b1, qr[d0], p1, 0, 0, 0); }
}
__device__ __forceinline__ int v_st(int k, int c) { const int kk = (k & ~0xC) | ((k & 4) << 1) | ((k & 8) >> 1); return ((kk >> 3) * 2 + (c >> 5)) * 512 + ((kk & 7) * 32 + (c & 31)) * 2; }
__device__ __forceinline__ int v_rd_base(int lane) { return ((lane & 3) << 3) | (((lane >> 2) & 3) << 6) | (((lane >> 4) & 1) << 5) | (((lane >> 5) & 1) << 8); }
constexpr int v_rd_off(int d0, int ks, int half) { return d0 * 512 + ks * 2048 + half * 1024; }
template <int OFF> __device__ __forceinline__ s16x4 tr_read(int vb) { s16x4 r; asm volatile("ds_read_b64_tr_b16 %0, %1 offset:%2" : "=&v"(r) : "v"(vb), "i"(OFF) : "memory"); return r; }
template <int D0> __device__ __forceinline__ void pv_one(f32x16& od, int vb, bf16x8 pa0, bf16x8 pa1, bf16x8 pa2, bf16x8 pa3) {
    const s16x4 l0 = tr_read<v_rd_off(D0, 0, 0)>(vb), h0 = tr_read<v_rd_off(D0, 0, 1)>(vb), l1 = tr_read<v_rd_off(D0, 1, 0)>(vb), h1 = tr_read<v_rd_off(D0, 1, 1)>(vb);
    const s16x4 l2 = tr_read<v_rd_off(D0, 2, 0)>(vb), h2 = tr_read<v_rd_off(D0, 2, 1)>(vb), l3 = tr_read<v_rd_off(D0, 3, 0)>(vb), h3 = tr_read<v_rd_off(D0, 3, 1)>(vb);
    asm volatile("s_waitcnt lgkmcnt(0)" ::: "memory"); SBAR();
#define PK(L, H) (bf16x8){L[0], L[1], L[2], L[3], H[0], H[1], H[2], H[3]}
    od = __builtin_amdgcn_mfma_f32_32x32x16_bf16(pa0, PK(l0, h0), od, 0, 0, 0);
    od = __builtin_amdgcn_mfma_f32_32x32x16_bf16(pa1, PK(l1, h1), od, 0, 0, 0);
    od = __builtin_amdgcn_mfma_f32_32x32x16_bf16(pa2, PK(l2, h2), od, 0, 0, 0);
    od = __builtin_amdgcn_mfma_f32_32x32x16_bf16(pa3, PK(l3, h3), od, 0, 0, 0);
#undef PK
}
__device__ __forceinline__ void pv_d0(f32x16* o, int vb, bf16x8 pa0, bf16x8 pa1, bf16x8 pa2, bf16x8 pa3) { pv_one<0>(o[0], vb, pa0, pa1, pa2, pa3); pv_one<1>(o[1], vb, pa0, pa1, pa2, pa3); }

__device__ __forceinline__ void attn_unit(const bf16* __restrict__ Qb, const bf16* __restrict__ Kh, const bf16* __restrict__ KRb, const bf16* __restrict__ Vh, bf16* __restrict__ Ob, int NT, char* lds) {
    const int tid = lv(threadIdx.x), wid = tid >> 6, lane = tid & 63, r32 = lane & 31, hi = lane >> 5;
    char* V_lds = lds; char* K_lds = lds + 2 * SHM_V;
    float* ws = (float*)(lds + 2 * SHM_V + 2 * SHM_K) + wid * 64; float* li_l = ws; float* al_l = ws + 32;
    float m_reg = 0.f, l_reg = 0; f32x16 o[2] = {}; bf16x8 qr[6]; f32x16 negm = {}; f32x16 negbig; _Pragma("unroll") for (int r = 0; r < 16; ++r) negbig[r] = -1e30f;
    const bf16* Qw = Qb + (long)(wid * QBLK + r32) * 96 + hi * 8;
#pragma unroll
    for (int d0 = 0; d0 < 6; ++d0) qr[d0] = *reinterpret_cast<const bf16x8*>(Qw + d0 * 16);
    const int sr = tid >> 4, kc = tid & 15; const bool kact = kc < 12;
    const bf16* ksrc = (kc < 8) ? (Kh + kc * 8) : kact ? (KRb + (kc - 8) * 8) : (Kh + (kc & 7) * 8); const int kstr = (kc >= 8 && kact) ? 32 : 64;
    const int vr = tid >> 3, vc = (tid & 7) * 8; const int vst = v_st(vr, vc);
    const int kw0 = kact ? KSWZ(sr, kc * 16) : (2 * SHM_K + 2048 + tid * 32), kw1 = kact ? KSWZ(32 + sr, kc * 16) : (2 * SHM_K + 2048 + tid * 32 + 16);
    const int vb0 = (int)(uintptr_t)V_lds + v_rd_base(lane);
    struct { bf16x8 vs, ks0, ks1; } sr_[2];
#define SLOAD(i, k0) do { sr_[i].vs = *reinterpret_cast<const bf16x8*>(Vh + (long)((k0) + vr) * 64 + vc); \
    sr_[i].ks0 = *reinterpret_cast<const bf16x8*>(ksrc + (long)((k0) + sr) * kstr); sr_[i].ks1 = *reinterpret_cast<const bf16x8*>(ksrc + (long)((k0) + 32 + sr) * kstr); } while (0)
#define SWRITE(b, i) do { *(bf16x8*)(V_lds + (b) * SHM_V + vst) = sr_[i].vs; \
    *(bf16x8*)(K_lds + (b) * SHM_K + kw0) = sr_[i].ks0; *(bf16x8*)(K_lds + (b) * SHM_K + kw1) = sr_[i].ks1; } while (0)
#define SWAIT() asm volatile("s_waitcnt vmcnt(3)" ::: "memory")
#define RESC(a) do { if (__any((a) < 1.f)) { if (hi == 0) al_l[r32] = (a); asm volatile("s_waitcnt lgkmcnt(0)" ::: "memory"); \
    _Pragma("unroll") for (int d = 0; d < 2; ++d) _Pragma("unroll") for (int r = 0; r < 16; ++r) o[d][r] *= al_l[crow(r, hi)]; } } while (0)
#define MASKED(t) ((t) - (NT - 4) > wq)
#define CIN(t) (MASKED(t) ? negbig : negm)
    f32x16 pA0, pA1, pB0, pB1; float alA, alB; bf16x8 pa0, pa1, pa2, pa3; const int wq = __builtin_amdgcn_readfirstlane(wid >> 1);
    sr_[0].ks0 = bf16x8{}; sr_[0].ks1 = bf16x8{}; sr_[1].ks0 = bf16x8{}; sr_[1].ks1 = bf16x8{};
    SLOAD(0, 0); asm volatile("s_waitcnt vmcnt(0)" ::: "memory"); SWRITE(0, 0); __syncthreads();
    qkt(pA0, pA1, K_lds, qr, r32, hi, negm); partialSM(pA0, pA1, m_reg, negm, alA);
    SLOAD(1, KVBLK); SLOAD(0, 2 * KVBLK);
    SWAIT(); SWRITE(1, 1); __syncthreads();
#define BODY(j, CINB, CINA) do { \
        SBAR(); qkt(pB0, pB1, K_lds + SHM_K, qr, r32, hi, CINB); \
        finishSM(pA0, pA1, alA, l_reg, pa0, pa1, pa2, pa3); SBAR(); \
        SLOAD(1, ((j) + 2) * KVBLK); SBAR(); \
        pv_d0(o, vb0, pa0, pa1, pa2, pa3); partialSM(pB0, pB1, m_reg, negm, alB); \
        __syncthreads(); SWAIT(); SWRITE(0, 0); \
        RESC(alB); __syncthreads(); \
        SBAR(); qkt(pA0, pA1, K_lds, qr, r32, hi, CINA); \
        finishSM(pB0, pB1, alB, l_reg, pa0, pa1, pa2, pa3); SBAR(); \
        SLOAD(0, (((j) + 3 < NT) ? (j) + 3 : NT - 1) * KVBLK); SBAR(); \
        pv_d0(o, vb0 + SHM_V, pa0, pa1, pa2, pa3); partialSM(pA0, pA1, m_reg, negm, alA); \
        __syncthreads(); SWAIT(); SWRITE(1, 1); \
        RESC(alA); __syncthreads(); } while (0)
    int j = 1;
    for (; j + 5 < NT; j += 2) BODY(j, negm, negm);
    for (; j + 1 < NT; j += 2) BODY(j, CIN(j), CIN(j + 1));
#undef BODY
    SBAR(); qkt(pB0, pB1, K_lds + SHM_K, qr, r32, hi, CIN(NT - 1));
    finishSM(pA0, pA1, alA, l_reg, pa0, pa1, pa2, pa3); SBAR();
    pv_d0(o, vb0, pa0, pa1, pa2, pa3); partialSM(pB0, pB1, m_reg, negm, alB);
    __syncthreads(); RESC(alB);
    finishSM(pB0, pB1, alB, l_reg, pa0, pa1, pa2, pa3); SBAR();
    pv_d0(o, vb0 + SHM_V, pa0, pa1, pa2, pa3);
    if (hi == 0) li_l[r32] = l_reg; asm volatile("s_waitcnt lgkmcnt(0)" ::: "memory");
    float rli[16];
#pragma unroll
    for (int r = 0; r < 16; ++r) rli[r] = __builtin_amdgcn_rcpf(li_l[crow(r, hi)]);
    bf16* Ow = Ob + (long)(wid * QBLK) * 1024;
#pragma unroll
    for (int r = 0; r < 16; ++r) { const int orow = crow(r, hi);
#pragma unroll
        for (int d0 = 0; d0 < 2; ++d0) Ow[(long)orow * 1024 + d0 * 32 + r32] = (bf16)f2bf(o[d0][r] * rli[r]); }
    asm volatile("s_waitcnt vmcnt(0)" ::: "memory");
    __syncthreads();
#undef SLOAD
#undef SWRITE
#undef SWAIT
#undef RESC
#undef MASKED
#undef CIN
}
#undef KSWZ
#undef SBAR
}

__device__ __forceinline__ void attn_phase(KArgs a, unsigned char* lds, int G_) { const int G = lsi(G_);
    const int bx = lsi(blockIdx.x); const int vcu = (G % 8 == 0) ? (bx % 8) * (G / 8) + bx / 8 : bx;
    const bf16* QB = (const bf16*)(a->ws + WS_QB); const bf16* KB = (const bf16*)(a->ws + WS_KB); const bf16* VB = (const bf16*)(a->ws + WS_VB);
    const bf16* KR = (const bf16*)(a->ws + WS_KR); bf16* OB = (bf16*)(a->ws + WS_OB);
    for (int p = vcu; p < 1024; p += G) { const int bh = p >> 3, s = p & 7, b = bh >> 4, h = bh & 15;
        for (int half = 0; half < 2; ++half) { const int qb = half ? 15 - s : s;
            att::attn_unit(QB + ((size_t)bh * SEQ + qb * 256) * 96, KB + (size_t)bh * SEQ * 64, KR + (size_t)b * SEQ * 32, VB + (size_t)bh * SEQ * 64,
                           OB + ((size_t)b * SEQ + qb * 256) * 1024 + h * 64, 4 * (qb + 1), (char*)lds); } }
}

#define LAS __attribute__((address_space(3)))
#define XB_TMO      128
#define XB_XCNT(j)  (256  + 64 * (j))
#define XB_XSUB(j)  (1280 + 64 * (j))
#define XB_XGEN(j)  (2304 + 64 * (j))
#define XB_TOP      3328
#define XB_TOPGEN   3392
#define XCD_BAR_WORDS 3456
#define XB_SPIN_CAP (1u << 18)

__device__ __forceinline__ unsigned xb_ld(unsigned* p)              { return __hip_atomic_load(p, __ATOMIC_RELAXED, __HIP_MEMORY_SCOPE_AGENT); }
__device__ __forceinline__ unsigned xb_add(unsigned* p, unsigned v) { return __hip_atomic_fetch_add(p, v, __ATOMIC_RELAXED, __HIP_MEMORY_SCOPE_AGENT); }
__device__ __forceinline__ unsigned xb_xcc_id() { return (unsigned)__builtin_amdgcn_s_getreg((3 << 11) | 20) & 0xFu; }
#define XB_SPIN(cond, bar) do { unsigned _sp = 0; while (cond) { __builtin_amdgcn_s_sleep(1); \
    if ((++_sp & 255u) == 0u) { if (xb_ld(&(bar)[XB_TMO])) break; if (_sp > XB_SPIN_CAP) { atomicAdd(&(bar)[XB_TMO], 1u); break; } } } } while (0)

struct XcdBarrier {
    unsigned* bar; unsigned x;
    volatile LAS unsigned* st;
};

__device__ __forceinline__ XcdBarrier xcd_barrier_post(unsigned* bar, volatile LAS unsigned* st) {
    XcdBarrier b; b.bar = bar; b.x = xb_xcc_id(); b.st = st;
    if (threadIdx.x == 0) (void)xb_add(&bar[XB_XCNT(b.x)], 1u);
    return b;
}
__device__ __forceinline__ void xcd_barrier_complete(unsigned* bar, unsigned x, unsigned& nloc, unsigned& nx) {
    const unsigned G = gridDim.x * gridDim.y * gridDim.z;
    unsigned sum, cnt, mine, sp = 0u;
    for (;;) {
        sum = 0u; cnt = 0u; mine = 0u;
#pragma unroll
        for (unsigned j = 0; j < 16; ++j) { const unsigned c = xb_ld(&bar[XB_XCNT(j)]); sum += c; cnt += (c > 0u) ? 1u : 0u; mine = (j == x) ? c : mine; }
        if (sum == G) break;
        __builtin_amdgcn_s_sleep(1);
        if ((++sp & 255u) == 0u) { if (xb_ld(&bar[XB_TMO])) break; if (sp > XB_SPIN_CAP) { atomicAdd(&bar[XB_TMO], 1u); break; } }
    }
    nloc = mine > 0u ? mine : 1u; nx = cnt > 0u ? cnt : 1u;
}

__device__ __forceinline__ void xcd_barrier(const XcdBarrier& b) {
    asm volatile("s_waitcnt vmcnt(0)" ::: "memory");
    __syncthreads();
    if (threadIdx.x == 0) {
        unsigned* bar = b.bar;
        __builtin_amdgcn_s_waitcnt(0);
        unsigned nloc = b.st[0], nx = b.st[1];
        if (nloc == 0u) { xcd_barrier_complete(bar, b.x, nloc, nx); b.st[0] = nloc; b.st[1] = nx; }
        const unsigned old = xb_add(&bar[XB_XSUB(b.x)], 1u);
        const unsigned gen = old / nloc;
        if (old + 1u == (gen + 1u) * nloc) {
            __builtin_amdgcn_fence(__ATOMIC_RELEASE, "agent");
            asm volatile("s_waitcnt vmcnt(0)" ::: "memory");
            const unsigned og = xb_add(&bar[XB_TOP], 1u);
            const unsigned tg = og / nx;
            if (og + 1u == (tg + 1u) * nx) xb_add(&bar[XB_TOPGEN], 1u);
            else XB_SPIN(xb_ld(&bar[XB_TOPGEN]) == tg, bar);
            __builtin_amdgcn_fence(__ATOMIC_ACQUIRE, "agent");
            xb_add(&bar[XB_XGEN(b.x)], 1u);
            asm volatile("s_waitcnt vmcnt(0)" ::: "memory");
        } else {
            XB_SPIN(xb_ld(&bar[XB_XGEN(b.x)]) == gen, bar);
            __builtin_amdgcn_fence(__ATOMIC_ACQUIRE, "agent");
            asm volatile("s_waitcnt vmcnt(0)" ::: "memory");
        }
    }
    __syncthreads();
}

__global__ void __launch_bounds__(512, 2) yoco_fwd(Args a_unused) {
    extern __shared__ __attribute__((aligned(16))) unsigned char lds[];
    cg::grid_group grid = cg::this_grid();
    KArgs a0 = kargs();
    volatile LAS unsigned* MISC = (volatile LAS unsigned*)((LAS unsigned char*)lds + 131072 + 320);
    if (threadIdx.x < 32) MISC[threadIdx.x] = 0u;
    __syncthreads();
    XcdBarrier xbar = xcd_barrier_post((unsigned*)(a0->ws) + 4096, MISC + 8);
    const int G = gridDim.x, lo = a0->ph_lo, hi = a0->ph_hi;
    PG8_LAS unsigned char* ldsl = (PG8_LAS unsigned char*)lds;
#define WSL() KArgs a = kargs(); unsigned char* ws = a->ws; float* xo = a->out; const float* ada = (const float*)(ws + WS_ADA) + (size_t)l * 8 * 6144; const float* xin = (l == 0) ? a->in[0] : xo; (void)ada; (void)xin; (void)xo; const int Gl = lsi(G), bxl = lsi((int)blockIdx.x); (void)Gl; (void)bxl
#ifndef REP_ATT
#define REP_ATT 1
#endif
#ifndef REP_UP
#define REP_UP 1
#endif
#ifndef REP_NORM
#define REP_NORM 1
#endif
#ifndef REP_SYNC
#define REP_SYNC 1
#endif
#ifndef REP_S5
#define REP_S5 1
#endif
#ifndef REP_PROJ
#define REP_PROJ 1
#endif
#ifndef REP_RES
#define REP_RES 1
#endif
#ifndef REP_KL
#define REP_KL 0
#endif
#ifndef REP_P0
#define REP_P0 1
#endif
#define IN(k) (lo <= (k) && (k) < hi)
#define SEAM(k) do { if (IN(k) && IN((k) + 1)) for (int rep_ = 0; rep_ < REP_SYNC; ++rep_) { if (a0->coop == 2) grid.sync(); xcd_barrier(xbar); } } while (0)
    if (IN(0)) for (int rep = 0; rep < REP_P0; ++rep) { phase0(kargs(), lds, G); __syncthreads(); }
    SEAM(0);
    for (int l = 0; l < 4; ++l) {
        const int pb = 1 + 8 * l;
        if (l < 2) {
            if (IN(pb + 0)) for (int rep = 0; rep < REP_NORM; ++rep) { WSL(); s5_norm_phase(a, l, xin, lds, G); }
            SEAM(pb + 0);
            if (IN(pb + 1)) for (int rep = 0; rep < REP_S5; ++rep) { WSL(); pg8::Gemm g{(const bf16*)(ws + WS_AUG), (const bf16*)(ws + WS_S5WE) + (size_t)l * 64 * 256 * 256, 64 * 2048, 256, 256, AUGK, 256};
                GroupOrder S{Gl, bxl}; EpiE E{(float*)(ws + WS_EBUF)};
                pg8::gemm_phase<EpiE, GroupOrder, true, true>(ldsl, g, S, E); }
            if (IN(pb + 1)) { asm volatile("s_waitcnt vmcnt(0)" ::: "memory"); __syncthreads(); carry_phase(kargs(), l, G); asm volatile("s_waitcnt vmcnt(0)" ::: "memory"); __syncthreads(); }
            if (IN(pb + 1)) for (int rep = 0; rep < REP_S5; ++rep) { WSL(); pg8::Gemm g{(const bf16*)(ws + WS_AUG), (const bf16*)(ws + WS_S5WT) + (size_t)l * 64 * 256 * AUGK, 64 * 2048, 256, AUGK, AUGK, AUGK};
                GroupOrder S{Gl, bxl}; EpiY E{(bf16*)(ws + WS_XN)};
                pg8::gemm_phase<EpiY, GroupOrder, true, true>(ldsl, g, S, E); }
            SEAM(pb + 3);
            if (IN(pb + 4)) for (int rep = 0; rep < REP_RES; ++rep) { WSL(); pg8::Gemm g{(const bf16*)(ws + WS_XN), (const bf16*)(ws + WS_WGLU) + (size_t)l * 1024 * 1024, T, 1024, 1024, 1024, 1024};
                pg8::StaticOrder S; S.init(T, 1024, Gl, bxl); EpiGlu E{(const bf16*)(ws + WS_XN), a->in[19] + l * 1024, rep ? (const float*)(ws + 262144) : ada + 2048, rep ? xo : xin, xo};
                pg8::gemm_phase<EpiGlu, pg8::StaticOrder, true, true>(ldsl, g, S, E); }
            SEAM(pb + 4);
        } else {
            const int j = l - 2;
            if (IN(pb + 0)) for (int rep = 0; rep < REP_NORM; ++rep) { WSL(); const float* kva = (const float*)(ws + WS_KVADA);
                norm_phase(xo, a->in[5] + l * 1024, ada, ada + 1024, 6144, (bf16*)(ws + WS_XN), a->in[22], kva, kva + 1024, 2048, (j == 0) ? (bf16*)(ws + WS_XK) : nullptr, G); }
            SEAM(pb + 0);
            if (IN(pb + 1)) { WSL();
                { pg8::Gemm g{(const bf16*)(ws + WS_XN), (const bf16*)(ws + WS_WDQ) + (size_t)j * 256 * 1024, T, 256, 1024, 1024, 1024};
                  pg8::StaticOrder S; S.init(T, 256, Gl, bxl); EpiDq E{(bf16*)(ws + WS_QA), (float*)(ws + WS_QSS) + (size_t)j * T};
                  pg8::gemm_phase<EpiDq, pg8::StaticOrder, true, true>(ldsl, g, S, E); }
                if (j == 0) { pg8::Gemm g{(const bf16*)(ws + WS_XK), (const bf16*)(ws + WS_WKVA), T, 512, 1024, 1024, 1024};
                  pg8::StaticOrder S; S.init(T, 512, Gl, bxl); EpiKva E{(bf16*)(ws + WS_CKV), (float*)(ws + WS_KSS), (bf16*)(ws + WS_KR), a->in[27], (const float*)(ws + WS_COS), (const float*)(ws + WS_SIN)};
                  pg8::gemm_phase<EpiKva, pg8::StaticOrder, true, true>(ldsl, g, S, E); }
            }
            SEAM(pb + 1);
            if (IN(pb + 2)) for (int rep = 0; rep < REP_PROJ; ++rep) { WSL();
                { pg8::Gemm g{(const bf16*)(ws + WS_QA), (const bf16*)(ws + WS_WUQ) + (size_t)j * 1536 * 256, T, 1536, 256, 256, 256};
                  pg8::StaticOrder S; S.init(T, 1536, Gl, bxl);
                  EpiUq E{(const float*)(ws + WS_QSS) + (size_t)j * T, a->in[31] + j * 64, a->in[32] + j * 32, (const float*)(ws + WS_COS), (const float*)(ws + WS_SIN), (bf16*)(ws + WS_QB)};
                  pg8::gemm_phase<EpiUq, pg8::StaticOrder, true, true>(ldsl, g, S, E); }
                if (j == 0) { pg8::Gemm g{(const bf16*)(ws + WS_CKV), (const bf16*)(ws + WS_WKVB), T, 2048, 256, 256, 256};
                  pg8::StaticOrder S; S.init(T, 2048, Gl, bxl); EpiKvb E{(const float*)(ws + WS_KSS), a->in[26], (bf16*)(ws + WS_KB), (bf16*)(ws + WS_VB)};
                  pg8::gemm_phase<EpiKvb, pg8::StaticOrder, true, true>(ldsl, g, S, E); }
            }
            SEAM(pb + 2);
            if (IN(pb + 3)) for (int rep = 0; rep < REP_ATT; ++rep) attn_phase(kargs(), lds, G);
            SEAM(pb + 3);
            if (IN(pb + 4)) for (int rep = 0; rep < REP_RES; ++rep) { WSL(); pg8::Gemm g{(const bf16*)(ws + WS_OB), (const bf16*)(ws + WS_WO) + (size_t)j * 1024 * 1024, T, 1024, 1024, 1024, 1024};
                pg8::StaticOrder S; S.init(T, 1024, Gl, bxl); EpiRes E{rep ? (const float*)(ws + 262144) : ada + 2048, xo};
                pg8::gemm_phase<EpiRes, pg8::StaticOrder, true, true>(ldsl, g, S, E); }
            SEAM(pb + 4);
        }
        if (IN(pb + 5)) for (int rep = 0; rep < REP_NORM; ++rep) { WSL(); norm_phase(xo, a->in[6] + l * 1024, ada + 3072, ada + 4096, 6144, (bf16*)(ws + WS_XN), nullptr, nullptr, nullptr, 0, nullptr, G); }
        SEAM(pb + 5);
        if (IN(pb + 6)) for (int rep = 0; rep < REP_UP; ++rep) { WSL(); pg8::Gemm g{(const bf16*)(ws + WS_XN), (const bf16*)(ws + WS_WGU) + (size_t)l * 5632 * 1024, T, 5632, 1024, 1024, 1024};
            pg8::StaticOrder S; S.init(T, 5632, Gl, bxl); EpiGU E{(bf16*)(ws + WS_HB)};
            pg8::gemm_phase<EpiGU, pg8::StaticOrder, true, true>(ldsl, g, S, E); }
        SEAM(pb + 6);
        if (IN(pb + 7)) for (int rep = 0; rep < REP_RES; ++rep) { WSL(); pg8::Gemm g{(const bf16*)(ws + WS_HB), (const bf16*)(ws + WS_WD) + (size_t)l * 1024 * FF, T, 1024, FF, FF, FF};
            pg8::StaticOrder S; S.init(T, 1024, Gl, bxl); EpiRes E{rep ? (const float*)(ws + 262144) : ada + 5120, xo};
            pg8::gemm_phase<EpiRes, pg8::StaticOrder, true, true>(ldsl, g, S, E); }
        if (IN(pb + 7)) for (int rep = 0; rep < REP_KL; ++rep) { WSL(); pg8::Gemm g{(const bf16*)(ws + WS_HB), (const bf16*)(ws + WS_WD) + (size_t)l * 1024 * FF, T, 1024, FF, FF, FF};
            pg8::StaticOrder S; S.init(T, 1024, Gl, bxl); EpiNone E{(float*)(ws + 262144)};
            pg8::gemm_phase<EpiNone, pg8::StaticOrder, true, true>(ldsl, g, S, E); }
        SEAM(pb + 7);
    }
#undef IN
#undef SEAM
}

#ifndef MK_PER_PHASE
#define MK_PER_PHASE 0
#endif
extern "C" void kernel_launch(void* const* d_in, const int* in_sizes, int n_in, void* d_out, int out_size, void* d_ws, size_t ws_size, hipStream_t stream) {
    static int grid = 0;
    if (grid == 0) {
        if (n_in != 34 || out_size != T * DM || ws_size < WS_END) { fprintf(stderr, "kernel_launch: unexpected shapes (n_in %d out %d ws %zu)\n", n_in, out_size, ws_size); grid = -1; return; }
        int dev = 0, cus = 0, per_cu = 0;
        if (hipGetDevice(&dev) != hipSuccess || hipDeviceGetAttribute(&cus, hipDeviceAttributeMultiprocessorCount, dev) != hipSuccess) { grid = -1; return; }
        if (hipFuncSetAttribute((const void*)yoco_fwd, hipFuncAttributeMaxDynamicSharedMemorySize, LDS_BYTES) != hipSuccess) { fprintf(stderr, "kernel_launch: hipFuncSetAttribute failed\n"); grid = -1; return; }
        if (hipOccupancyMaxActiveBlocksPerMultiprocessor(&per_cu, (const void*)yoco_fwd, 512, LDS_BYTES) != hipSuccess || per_cu < 1) per_cu = 1;
        (void)hipGetLastError();
        grid = cus * per_cu;
    }
    if (grid < 0) return;
    Args ha{};
    for (int i = 0; i < 34; ++i) ha.in[i] = (const float*)d_in[i];
    ha.out = (float*)d_out; ha.ws = (unsigned char*)d_ws;
#if MK_PER_PHASE
    for (int ph = 0; ph < NPHASE; ++ph) { ha.ph_lo = ph; ha.ph_hi = ph + 1; ha.coop = 0;
        hipLaunchKernelGGL(yoco_fwd, dim3(grid), dim3(512), LDS_BYTES, stream, ha); }
#else
    (void)hipMemsetAsync(d_ws, 0, 524288, stream);
    ha.ph_lo = 0; ha.ph_hi = NPHASE; ha.coop = 1;
    void* args[] = {&ha};
    const hipError_t e = hipLaunchCooperativeKernel((const void*)yoco_fwd, dim3(grid), dim3(512), args, LDS_BYTES, stream);
    if (e != hipSuccess) fprintf(stderr, "kernel_launch: cooperative launch failed: %s (grid %d)\n", hipGetErrorString(e), grid);
#endif
}
```
